# Optimizing an MI355X kernel written in HIP

```python
import math
import jax, jax.numpy as jnp
from jax import lax
import numpy as np

D_MODEL = 1024
BATCH = 1
SEQ = 16384
DEPTH = 2
DEC_BATCH = 32
DEC_SEQ = 1
PAST_LEN = 16384
PAGE_SIZE = 128

N_MIXERS = 2
N_POOL_LAYERS = (DEPTH + 1) // 2
N_ATTN_LAYERS = DEPTH // 2
D_FF = 2816
RMS_EPS = 1e-6
POOL_WINDOWS = (2, 4, 8, 16)
N_POOL_GROUPS = 4
POOL_GROUP_DIM = D_MODEL // N_POOL_GROUPS
POOL_STATE_LEN = max(POOL_WINDOWS) - 1
ATTN_WINDOWS = (128, 512, 2048)
ATTN_DILATIONS = (1, 4, 16)
N_ATTN_GROUPS = 3
HEAD_DIM = 64
HEADS_PER_GROUP = D_MODEL // 128
GROUP_WIDTH = HEADS_PER_GROUP * HEAD_DIM
QKV_WIDTH = N_ATTN_GROUPS * 3 * GROUP_WIDTH
N_ATTN_HEADS = N_ATTN_GROUPS * HEADS_PER_GROUP
Q_BLOCK = 128
ATTN_SCALE = HEAD_DIM ** -0.5
N_BUCKETS = 32
MAX_EXACT = N_BUCKETS // 2
MAX_DISTANCE = 2048
NEG_INF = -1e30

kernel_name = 'pool_dilated_attn_macaron_step'


def _rmsnorm(x, g):
    xf = x.astype(jnp.float32)
    y = xf * lax.rsqrt(jnp.mean(xf * xf, axis=-1, keepdims=True) + RMS_EPS)
    return (y * g.astype(jnp.float32)).astype(x.dtype)


def _ffn_half(x, g, w_gate, w_up, w_down):
    h = _rmsnorm(x, g)
    return x + 0.5 * ((jax.nn.silu(h @ w_gate) * (h @ w_up)) @ w_down)


def _t5_bucket(dist):
    distf = jnp.maximum(dist, 1).astype(jnp.float32)
    log_b = MAX_EXACT + (jnp.log(distf / MAX_EXACT) / math.log(MAX_DISTANCE / MAX_EXACT)
                         * (N_BUCKETS - MAX_EXACT)).astype(jnp.int32)
    log_b = jnp.minimum(log_b, N_BUCKETS - 1)
    return jnp.where(dist < MAX_EXACT, dist, log_b)


def _group_bias(rel_bias, g):
    n_keys = ATTN_WINDOWS[g] // ATTN_DILATIONS[g] + 1
    dist = jnp.arange(n_keys, dtype=jnp.int32) * ATTN_DILATIONS[g]
    tab = rel_bias[:, g * HEADS_PER_GROUP:(g + 1) * HEADS_PER_GROUP]
    return jnp.take(tab, _t5_bucket(dist), axis=0).T.astype(jnp.float32)


def _softmax_lse(s, valid):
    s = jnp.where(valid, s, NEG_INF)
    m = jnp.max(s, axis=-1, keepdims=True)
    e = jnp.exp(s - m)
    den = jnp.sum(e, axis=-1, keepdims=True)
    return e / den, (m + jnp.log(den))[..., 0]


def _pool_mixer(h, prefix, pos0, w_in, w_group, scale, w_out):
    B, T, D = h.shape
    u = h @ w_in
    cat = jnp.concatenate([prefix.astype(u.dtype), u], axis=1)
    c = jnp.pad(jnp.cumsum(cat.astype(jnp.float32), axis=1), ((0, 0), (1, 0), (0, 0)))
    end = c[:, POOL_STATE_LEN + 1:]
    pos = pos0 + jnp.arange(T)
    means = []
    for g, w in enumerate(POOL_WINDOWS):
        sl = slice(g * POOL_GROUP_DIM, (g + 1) * POOL_GROUP_DIM)
        start = c[:, POOL_STATE_LEN + 1 - w:POOL_STATE_LEN + 1 - w + T, sl]
        count = jnp.minimum(w, pos + 1).astype(jnp.float32)[None, :, None]
        means.append((end[..., sl] - start) / count)
    z = (jnp.concatenate(means, axis=-1) - u.astype(jnp.float32)).astype(u.dtype)
    z = jnp.einsum('btgc,gcd->btgd', z.reshape(B, T, N_POOL_GROUPS, POOL_GROUP_DIM), w_group)
    y = (z.reshape(B, T, D) * scale) @ w_out
    return y, cat[:, -POOL_STATE_LEN:]


def _dilated_attn_prompt(q, k, v, bias, window, dil):
    B, S, H, E = q.shape
    n_win = window // dil
    span = dil * Q_BLOCK
    sp = -(-S // span) * span
    nb = sp // span

    def to_blocks(a):
        a = jnp.pad(a, ((0, 0), (0, sp - S), (0, 0), (0, 0)))
        return a.reshape(B, nb, Q_BLOCK, dil, H, E).transpose(0, 3, 1, 2, 4, 5)

    def with_prev(a):
        prev = jnp.pad(a, ((0, 0), (0, 0), (1, 0), (0, 0), (0, 0), (0, 0)))[:, :, :-1]
        return jnp.concatenate([prev, a], axis=3)

    qb = to_blocks(q)
    kk = with_prev(to_blocks(k))
    vv = with_prev(to_blocks(v))
    a_idx = jnp.arange(Q_BLOCK)[:, None]
    b_idx = jnp.arange(2 * Q_BLOCK)[None, :]
    j = Q_BLOCK + a_idx - b_idx
    band = (j >= 0) & (j <= n_win)
    n_idx = jnp.arange(nb)[:, None, None]
    valid = band[None] & ((n_idx > 0) | (b_idx[None] >= Q_BLOCK))
    bias_qk = bias[:, jnp.clip(j, 0, n_win)]
    s = jnp.einsum('brnqhe,brnkhe->brnhqk', qb, kk).astype(jnp.float32) * ATTN_SCALE + bias_qk
    p, lse = _softmax_lse(s, valid[None, None, :, None])
    o = jnp.einsum('brnhqk,brnkhe->brnqhe', p, vv.astype(jnp.float32))
    o = o.transpose(0, 2, 3, 1, 4, 5).reshape(B, sp, H, E)[:, :S]
    lse = lse.transpose(0, 2, 4, 1, 3).reshape(B, sp, H)[:, :S]
    return o, lse


def _dilated_attn_step(q, k_new, v_new, k_buf, v_buf, bias, window, dil):
    T = q.shape[1]
    L = k_buf.shape[1]
    n_win = window // dil
    k_all = jnp.concatenate([k_buf.astype(k_new.dtype), k_new], axis=1)
    v_all = jnp.concatenate([v_buf.astype(v_new.dtype), v_new], axis=1)
    idx = L + jnp.arange(T)[:, None] - dil * jnp.arange(n_win + 1)[None, :]
    valid = idx >= 0
    kg = jnp.take(k_all, jnp.maximum(idx, 0), axis=1)
    vg = jnp.take(v_all, jnp.maximum(idx, 0), axis=1)
    s = jnp.einsum('bthe,btjhe->bhtj', q, kg).astype(jnp.float32) * ATTN_SCALE + bias[None, :, None, :]
    p, lse = _softmax_lse(s, valid[None, None])
    o = jnp.einsum('bhtj,btjhe->bthe', p, vg.astype(jnp.float32))
    return o, lse.transpose(0, 2, 1), k_all[:, T:], v_all[:, T:]


def _merge_groups(outs, lses, w_out, dtype):
    alpha = jax.nn.softmax(jnp.stack(lses, axis=0), axis=0)
    o = jnp.sum(alpha[..., None] * jnp.stack(outs, axis=0), axis=0)
    B, T = o.shape[:2]
    return o.reshape(B, T, GROUP_WIDTH).astype(dtype) @ w_out


def _qkv(h, w_qkv):
    B, T, _ = h.shape
    return (h @ w_qkv).reshape(B, T, N_ATTN_GROUPS, 3, HEADS_PER_GROUP, HEAD_DIM)


def setup_inputs(seed: int = 0) -> dict:
    key = jax.random.key(seed)
    ks = jax.random.split(key, 40)
    f32 = jnp.float32

    def nrm(k, shape, scale):
        return jax.random.normal(k, shape, f32) * scale

    inp = {}
    inp['x_prompt'] = nrm(ks[0], (BATCH, SEQ, D_MODEL), 1.0)
    inp['x_sample'] = nrm(ks[1], (DEC_BATCH, DEC_SEQ, D_MODEL), 1.0)
    inp['state_pool'] = nrm(ks[2], (N_POOL_LAYERS, DEC_BATCH, POOL_STATE_LEN, D_MODEL), 1.0)
    for g, w in enumerate(ATTN_WINDOWS):
        L = min(w, PAST_LEN)
        shp = (N_ATTN_LAYERS, DEC_BATCH, L, HEADS_PER_GROUP, HEAD_DIM)
        inp['cache_k_w%d' % w] = nrm(ks[3 + 2 * g], shp, 1.0)
        inp['cache_v_w%d' % w] = nrm(ks[4 + 2 * g], shp, 1.0)
    inp['ffn1_norm'] = 1.0 + nrm(ks[10], (DEPTH, D_MODEL), 0.05)
    inp['ffn1_w_gate'] = nrm(ks[11], (DEPTH, D_MODEL, D_FF), D_MODEL ** -0.5)
    inp['ffn1_w_up'] = nrm(ks[12], (DEPTH, D_MODEL, D_FF), D_MODEL ** -0.5)
    inp['ffn1_w_down'] = nrm(ks[13], (DEPTH, D_FF, D_MODEL), D_FF ** -0.5)
    inp['mix_norm'] = 1.0 + nrm(ks[14], (DEPTH, D_MODEL), 0.05)
    inp['pool_w_in'] = nrm(ks[15], (N_POOL_LAYERS, D_MODEL, D_MODEL), D_MODEL ** -0.5)
    inp['pool_w_group'] = nrm(ks[16], (N_POOL_LAYERS, N_POOL_GROUPS, POOL_GROUP_DIM, POOL_GROUP_DIM), POOL_GROUP_DIM ** -0.5)
    inp['pool_scale'] = 1.0 + nrm(ks[17], (N_POOL_LAYERS, D_MODEL), 0.05)
    inp['pool_w_out'] = nrm(ks[18], (N_POOL_LAYERS, D_MODEL, D_MODEL), D_MODEL ** -0.5)
    inp['attn_w_qkv'] = nrm(ks[19], (N_ATTN_LAYERS, D_MODEL, QKV_WIDTH), D_MODEL ** -0.5)
    inp['attn_w_out'] = nrm(ks[20], (N_ATTN_LAYERS, GROUP_WIDTH, D_MODEL), GROUP_WIDTH ** -0.5)
    inp['rel_bias'] = nrm(ks[21], (N_BUCKETS, N_ATTN_HEADS), 0.3)
    inp['ffn2_norm'] = 1.0 + nrm(ks[22], (DEPTH, D_MODEL), 0.05)
    inp['ffn2_w_gate'] = nrm(ks[23], (DEPTH, D_MODEL, D_FF), D_MODEL ** -0.5)
    inp['ffn2_w_up'] = nrm(ks[24], (DEPTH, D_MODEL, D_FF), D_MODEL ** -0.5)
    inp['ffn2_w_down'] = nrm(ks[25], (DEPTH, D_FF, D_MODEL), D_FF ** -0.5)
    inp['final_norm'] = 1.0 + nrm(ks[26], (D_MODEL,), 0.05)
    return inp


def reference(x_prompt, x_sample, state_pool, cache_k_w128, cache_v_w128, cache_k_w512, cache_v_w512,
              cache_k_w2048, cache_v_w2048, ffn1_norm, ffn1_w_gate, ffn1_w_up, ffn1_w_down, mix_norm,
              pool_w_in, pool_w_group, pool_scale, pool_w_out, attn_w_qkv, attn_w_out, rel_bias,
              ffn2_norm, ffn2_w_gate, ffn2_w_up, ffn2_w_down, final_norm):
    cache_k = (cache_k_w128, cache_k_w512, cache_k_w2048)
    cache_v = (cache_v_w128, cache_v_w512, cache_v_w2048)
    biases = [_group_bias(rel_bias, g) for g in range(N_ATTN_GROUPS)]
    xp, xs = x_prompt, x_sample
    S = xp.shape[1]
    pool_p, pool_s = [], []
    kp = [[] for _ in range(N_ATTN_GROUPS)]
    vp = [[] for _ in range(N_ATTN_GROUPS)]
    ksn = [[] for _ in range(N_ATTN_GROUPS)]
    vsn = [[] for _ in range(N_ATTN_GROUPS)]
    for i in range(DEPTH):
        xp = _ffn_half(xp, ffn1_norm[i], ffn1_w_gate[i], ffn1_w_up[i], ffn1_w_down[i])
        xs = _ffn_half(xs, ffn1_norm[i], ffn1_w_gate[i], ffn1_w_up[i], ffn1_w_down[i])
        hp = _rmsnorm(xp, mix_norm[i])
        hs = _rmsnorm(xs, mix_norm[i])
        li = i // N_MIXERS
        if i % N_MIXERS == 0:
            zeros = jnp.zeros((hp.shape[0], POOL_STATE_LEN, D_MODEL), hp.dtype)
            yp, st_p = _pool_mixer(hp, zeros, 0, pool_w_in[li], pool_w_group[li], pool_scale[li], pool_w_out[li])
            ys, st_s = _pool_mixer(hs, state_pool[li], PAST_LEN, pool_w_in[li], pool_w_group[li],
                                   pool_scale[li], pool_w_out[li])
            pool_p.append(st_p)
            pool_s.append(st_s)
        else:
            qkv_p = _qkv(hp, attn_w_qkv[li])
            qkv_s = _qkv(hs, attn_w_qkv[li])
            outs_p, lses_p, outs_s, lses_s = [], [], [], []
            for g in range(N_ATTN_GROUPS):
                w, d = ATTN_WINDOWS[g], ATTN_DILATIONS[g]
                q, k, v = qkv_p[:, :, g, 0], qkv_p[:, :, g, 1], qkv_p[:, :, g, 2]
                o, lse = _dilated_attn_prompt(q, k, v, biases[g], w, d)
                outs_p.append(o)
                lses_p.append(lse)
                Lp = min(w, S)
                kp[g].append(k[:, S - Lp:])
                vp[g].append(v[:, S - Lp:])
                o, lse, kb, vb = _dilated_attn_step(qkv_s[:, :, g, 0], qkv_s[:, :, g, 1], qkv_s[:, :, g, 2],
                                                    cache_k[g][li], cache_v[g][li], biases[g], w, d)
                outs_s.append(o)
                lses_s.append(lse)
                ksn[g].append(kb)
                vsn[g].append(vb)
            yp = _merge_groups(outs_p, lses_p, attn_w_out[li], hp.dtype)
            ys = _merge_groups(outs_s, lses_s, attn_w_out[li], hs.dtype)
        xp = xp + yp
        xs = xs + ys
        xp = _ffn_half(xp, ffn2_norm[i], ffn2_w_gate[i], ffn2_w_up[i], ffn2_w_down[i])
        xs = _ffn_half(xs, ffn2_norm[i], ffn2_w_gate[i], ffn2_w_up[i], ffn2_w_down[i])
    y_prompt = _rmsnorm(xp, final_norm)
    y_sample = _rmsnorm(xs, final_norm)
    return (y_prompt, y_sample, jnp.stack(pool_p), jnp.stack(pool_s),
            jnp.stack(kp[0]), jnp.stack(vp[0]), jnp.stack(ksn[0]), jnp.stack(vsn[0]),
            jnp.stack(kp[1]), jnp.stack(vp[1]), jnp.stack(ksn[1]), jnp.stack(vsn[1]),
            jnp.stack(kp[2]), jnp.stack(vp[2]), jnp.stack(ksn[2]), jnp.stack(vsn[2]))
```

```cpp
#include <hip/hip_runtime.h>
#include <hip/hip_cooperative_groups.h>
#include <cstdio>
#include <cstdint>
namespace cg = cooperative_groups;

#ifndef MK_MULTI
#define MK_MULTI 1
#endif

#define LAS __attribute__((address_space(3)))
typedef unsigned short bf16_t;
typedef short bf16x8 __attribute__((ext_vector_type(8)));
typedef float f32x4 __attribute__((ext_vector_type(4)));
typedef float f32x2 __attribute__((ext_vector_type(2)));
typedef unsigned u32x4 __attribute__((ext_vector_type(4)));
typedef unsigned u32x2 __attribute__((ext_vector_type(2)));

constexpr int D = 1024, S = 16384, NS = 32, FF = 2816, MP = 16640, NPANEL = 65, MV = S + NS;
constexpr int QKVW = 4608;
constexpr float EPS = 1e-6f;

__device__ __forceinline__ unsigned f2bf(float f) { unsigned u = __builtin_bit_cast(unsigned, f); return (u + 0x7fffu + ((u >> 16) & 1u)) >> 16; }
__device__ __forceinline__ unsigned pk2(float lo, float hi) { return f2bf(lo) | (f2bf(hi) << 16); }
__device__ __forceinline__ float bf2f(unsigned short b) { return __builtin_bit_cast(float, ((unsigned)b) << 16); }
__device__ __forceinline__ float bflo(unsigned w) { return __builtin_bit_cast(float, w << 16); }
__device__ __forceinline__ float bfhi(unsigned w) { return __builtin_bit_cast(float, w & 0xffff0000u); }
#define LDS_WAIT() asm volatile("s_waitcnt lgkmcnt(0)" ::: "memory")
#define VM_WAIT() asm volatile("s_waitcnt vmcnt(0)" ::: "memory")

namespace pg8 {
constexpr int BM = 256, BK = 64, HALF = 128, HTB = HALF * BK * 2, STAGE_BYTES = 8 * HTB, NXCD = 8, WGM = 8;
__host__ __device__ __forceinline__ int lds_byte(int r, int c) { const int st = (r >> 4) * 2 + (c >> 5), rr = r & 15, cc = c & 31, ob = rr * 64 + cc * 2; return st * 1024 + (ob ^ (((ob >> 9) & 1) << 5)); }
__host__ __device__ __forceinline__ void stage_rc(int b, int& R, int& C) { const int st = b / 1024, sb = b % 1024, swz = sb ^ (((sb >> 9) & 1) << 5); R = (st >> 1) * 16 + swz / 64; C = (st & 1) * 32 + (swz % 64) / 2; }
__host__ __device__ __forceinline__ int perm32(int rho) { const int n = rho >> 4, i = rho & 15; return 8 * (i >> 2) + 4 * n + (i & 3); }

struct Unit { int pm, pn; };
struct Gemm { const bf16_t* A; const bf16_t* Bt; int lda, ldb, K, a_pn; };

struct StaticOrder {
    int nM, nN, nwg, G, c;
    __device__ void init(int nM_, int nN_, int G_, int c_) { nM = nM_; nN = nN_; nwg = nM * nN; G = G_; c = c_; }
    __device__ bool next(int i, Unit& u) const {
        const long L = (long)i * G + c; if (L >= nwg) return false;
        int wgid = (int)L; { const int q = nwg / NXCD, r = nwg % NXCD, xcd = wgid % NXCD, off = wgid / NXCD; wgid = (xcd < r ? xcd * (q + 1) : r * (q + 1) + (xcd - r) * q) + off; }
        const int nig = WGM * nN, gid = wgid / nig, fm = gid * WGM, gsz = (nM - fm) < WGM ? (nM - fm) : WGM;
        u.pm = fm + ((wgid % nig) % gsz); u.pn = (wgid % nig) / gsz; return true;
    }
    __device__ __forceinline__ void a_ready(const Unit&) const {}
    __device__ __forceinline__ void done(const Unit&) const {}
};

__device__ __forceinline__ unsigned cvt_pk_bf16(float lo, float hi) { unsigned r; asm volatile("v_cvt_pk_bf16_f32 %0, %1, %2" : "=v"(r) : "v"(lo), "v"(hi)); return r; }

template <class Epi, class Sched>
__device__ __forceinline__ void gemm_phase(LAS unsigned char* lds, const Gemm g, const Sched& S, const Epi& E) {
    const int tid = threadIdx.x, wid = __builtin_amdgcn_readfirstlane(tid >> 6), lane = tid & 63, wr = wid >> 2, wc = wid & 3, fr = lane & 15, fq = lane >> 4;
    const int K = g.K, nt = K / BK;
    unsigned voffA[2], voffB[2];
#pragma unroll
    for (int i = 0; i < 2; ++i) { int R, C; stage_rc(tid * 16 + i * 8192, R, C); const int Rb = (R & ~31) + perm32(R & 31);
        voffA[i] = (unsigned)(R * g.lda + C) * 2u; voffB[i] = (unsigned)(Rb * g.ldb + C) * 2u; }
    const size_t kstep = (size_t)(BK * 2);
    const size_t hstepA = (size_t)HALF * g.lda * 2, hstepB = (size_t)HALF * g.ldb * 2;
    const size_t tstepA = 2 * hstepA, tstepB = 2 * hstepB;
    const unsigned ldsw = (unsigned)wid * 1024u;
    const int aoff = lds_byte(wr * 64 + fr, fq * 8), boff = lds_byte(wc * 32 + fr, fq * 8);
#define PG8_SA(b, h) (((b) * 2 + (h)) * HTB)
#define PG8_SB(b, h) ((4 + (b) * 2 + (h)) * HTB)
#define PG8_STAGE(bufoff, gbase, voff) do { _Pragma("unroll") for (int _i = 0; _i < 2; ++_i) \
        __builtin_amdgcn_global_load_lds((const unsigned*)((const char*)(gbase) + (voff)[_i]), (LAS unsigned*)(lds + (bufoff) + ldsw + _i * 8192), 16, 0, 0); } while (0)
#define PG8_LDA(dst, b, h) do { _Pragma("unroll") for (int m = 0; m < 4; ++m) _Pragma("unroll") for (int k = 0; k < 2; ++k) dst[m][k] = *(const LAS bf16x8*)(lds + PG8_SA(b, h) + aoff + m * 2048 + k * 1024); } while (0)
#define PG8_LDB(dst, b, h) do { _Pragma("unroll") for (int n = 0; n < 2; ++n) _Pragma("unroll") for (int k = 0; k < 2; ++k) dst[n][k] = *(const LAS bf16x8*)(lds + PG8_SB(b, h) + boff + n * 2048 + k * 1024); } while (0)
#define PG8_MMA(ai, bj, At, Bt) do { __builtin_amdgcn_s_setprio(1); _Pragma("unroll") for (int m = 0; m < 4; ++m) _Pragma("unroll") for (int n = 0; n < 2; ++n) _Pragma("unroll") for (int k = 0; k < 2; ++k) \
        acc[ai][bj][m][n] = __builtin_amdgcn_mfma_f32_16x16x32_bf16(Bt[n][k], At[m][k], acc[ai][bj][m][n], 0, 0, 0); __builtin_amdgcn_s_setprio(0); } while (0)
#define PG8_WAIT_V(n) asm volatile("s_waitcnt vmcnt(" #n ")" ::: "memory")
#define PG8_WAIT_L(n) asm volatile("s_waitcnt lgkmcnt(" #n ")" ::: "memory")
#define PG8_BAR __builtin_amdgcn_s_barrier()
#define PG8_SCHED __builtin_amdgcn_sched_barrier(0)
    Unit cur, nxt; int ui = 0;
    if (!S.next(0, cur)) return;
    f32x4 acc[2][2][4][2];
#pragma unroll
    for (int a = 0; a < 2; ++a)
#pragma unroll
        for (int b = 0; b < 2; ++b)
#pragma unroll
            for (int m = 0; m < 4; ++m)
#pragma unroll
                for (int n = 0; n < 2; ++n) acc[a][b][m][n] = (f32x4){0.f, 0.f, 0.f, 0.f};
    bf16x8 At[4][2], B0[2][2], B1[2][2];
    const char* cA = (const char*)g.A + (size_t)cur.pm * tstepA + (size_t)cur.pn * g.a_pn * 2; const char* cB = (const char*)g.Bt + (size_t)cur.pn * tstepB;
    S.a_ready(cur);
    PG8_STAGE(PG8_SB(0, 0), cB, voffB); PG8_STAGE(PG8_SB(0, 1), cB + hstepB, voffB); PG8_STAGE(PG8_SA(0, 0), cA, voffA); PG8_STAGE(PG8_SA(0, 1), cA + hstepA, voffA);
    if (wr == 1) PG8_BAR;
    PG8_WAIT_V(2); PG8_BAR;
    PG8_STAGE(PG8_SB(1, 0), cB + kstep, voffB); PG8_STAGE(PG8_SA(1, 0), cA + kstep, voffA); PG8_STAGE(PG8_SB(1, 1), cB + hstepB + kstep, voffB);
    PG8_WAIT_V(6); PG8_BAR;
    for (;;) {
        const bool has_next = S.next(ui + 1, nxt);
        const char* nA = has_next ? (const char*)g.A + (size_t)nxt.pm * tstepA + (size_t)nxt.pn * g.a_pn * 2 : cA; const char* nB = has_next ? (const char*)g.Bt + (size_t)nxt.pn * tstepB : cB;
#pragma nounroll
        for (int t = 0; t < nt; t += 2) {
            const bool last = (t == nt - 2);
            const char* a1 = cA + (size_t)(t + 1) * kstep;
            const char* a2 = last ? nA : cA + (size_t)(t + 2) * kstep; const char* b2 = last ? nB : cB + (size_t)(t + 2) * kstep;
            const char* a3 = a2 + kstep; const char* b3 = b2 + kstep;
            if (last && has_next) S.a_ready(nxt);
            PG8_LDB(B0, 0, 0); PG8_LDB(B1, 0, 1); PG8_SCHED; PG8_LDA(At, 0, 0); PG8_STAGE(PG8_SA(1, 1), a1 + hstepA, voffA);
            PG8_WAIT_V(8); PG8_WAIT_L(0); PG8_BAR; PG8_MMA(0, 0, At, B0); PG8_MMA(0, 1, At, B1); PG8_BAR; PG8_SCHED;
            PG8_LDA(At, 0, 1); PG8_STAGE(PG8_SB(0, 0), b2, voffB); PG8_STAGE(PG8_SB(0, 1), b2 + hstepB, voffB); PG8_STAGE(PG8_SA(0, 0), a2, voffA);
            PG8_WAIT_V(8); PG8_WAIT_L(0); PG8_BAR; PG8_MMA(1, 0, At, B0); PG8_MMA(1, 1, At, B1); PG8_BAR; PG8_SCHED;
            PG8_LDB(B0, 1, 0); PG8_LDB(B1, 1, 1); PG8_SCHED; PG8_LDA(At, 1, 0); PG8_STAGE(PG8_SA(0, 1), a2 + hstepA, voffA);
            PG8_WAIT_V(8); PG8_WAIT_L(0); PG8_BAR; PG8_MMA(0, 0, At, B0); PG8_MMA(0, 1, At, B1); PG8_BAR; PG8_SCHED;
            PG8_LDA(At, 1, 1); PG8_STAGE(PG8_SB(1, 0), b3, voffB); PG8_STAGE(PG8_SB(1, 1), b3 + hstepB, voffB); PG8_STAGE(PG8_SA(1, 0), a3, voffA);
            PG8_WAIT_V(8); PG8_WAIT_L(0); PG8_BAR; PG8_MMA(1, 0, At, B0); PG8_MMA(1, 1, At, B1); PG8_BAR; PG8_SCHED;
        }
        if (wr == 0) PG8_BAR;
        E(acc, cur, wr, wc, fr, fq); S.done(cur);
        if (!has_next) break;
#pragma unroll
        for (int a = 0; a < 2; ++a)
#pragma unroll
            for (int b = 0; b < 2; ++b)
#pragma unroll
                for (int m = 0; m < 4; ++m)
#pragma unroll
                    for (int n = 0; n < 2; ++n) acc[a][b][m][n] = (f32x4){0.f, 0.f, 0.f, 0.f};
        cur = nxt; cA = nA; cB = nB; ++ui;
        if (wr == 1) PG8_BAR;
    }
    PG8_WAIT_V(0);
    PG8_BAR;
#undef PG8_SA
#undef PG8_SB
#undef PG8_STAGE
#undef PG8_LDA
#undef PG8_LDB
#undef PG8_MMA
#undef PG8_WAIT_V
#undef PG8_WAIT_L
#undef PG8_BAR
#undef PG8_SCHED
}
}
using pg8::Unit;
using pg8::cvt_pk_bf16;

constexpr size_t MiB = 1u << 20;
constexpr size_t al(size_t x) { return (x + 4095) & ~(size_t)4095; }
constexpr size_t WS_CTL = 0;
constexpr size_t WS_WGU = 1 * MiB;
constexpr size_t SZ_WGU = (size_t)2 * FF * D * 2;
constexpr size_t WS_WD = WS_WGU + 4 * SZ_WGU;
constexpr size_t SZ_WD = (size_t)D * FF * 2;
constexpr size_t WS_WIN = WS_WD + 4 * SZ_WD;
constexpr size_t WS_WGRP = WS_WIN + (size_t)D * D * 2;
constexpr size_t WS_WPO = WS_WGRP + (size_t)D * 256 * 2;
constexpr size_t WS_WQKV = WS_WPO + (size_t)D * D * 2;
constexpr size_t WS_WAO = WS_WQKV + (size_t)QKVW * D * 2;
constexpr size_t WS_BIAS = WS_WAO + (size_t)D * 512 * 2;
constexpr size_t WS_PART = al(WS_BIAS + 3 * 8 * 132 * 4);
constexpr size_t WS_XB = al(WS_PART + (size_t)MP * 16 * 4);
constexpr size_t WS_XF = WS_XB + (size_t)MP * D * 2;
constexpr size_t WS_ACT = WS_XF + (size_t)MP * D * 4;
constexpr size_t WS_U = WS_ACT + (size_t)MP * FF * 2;
constexpr size_t WS_Z = WS_U + (size_t)MP * D * 2;
constexpr size_t WS_Z2 = WS_Z + (size_t)MP * D * 2;
constexpr size_t WS_QKV = WS_Z2 + (size_t)MP * D * 2;
constexpr size_t WS_O = WS_QKV + (size_t)MP * QKVW * 2;
constexpr size_t WS_END = WS_O + (size_t)MP * 512 * 2;

constexpr size_t O_YP = 0, O_YS = (size_t)S * D, O_PSP = O_YS + (size_t)NS * D, O_PSS = O_PSP + 15 * D, O_KV0 = O_PSS + (size_t)NS * 15 * D;
__host__ __device__ constexpr size_t kv_group_base(int g) {
    size_t o = O_KV0;
    for (int i = 0; i < g; ++i) { const size_t W = (size_t)128 << (2 * i); o += 2 * W * 512 + 2 * (size_t)NS * W * 512; }
    return o;
}
constexpr size_t OUT_TOTAL = kv_group_base(3);

struct RowPart { const float* part; };
__device__ __forceinline__ float rstd_of(const float* part, int row) {
    const f32x4* p = (const f32x4*)(part + (size_t)row * 16);
    const f32x4 a = p[0], b = p[1], c = p[2], d = p[3];
    const float s = ((a.x + a.y) + (a.z + a.w)) + ((b.x + b.y) + (b.z + b.w)) + ((c.x + c.y) + (c.z + c.w)) + ((d.x + d.y) + (d.z + d.w));
    return __builtin_amdgcn_rsqf(s * (1.0f / D) + EPS);
}
__device__ __forceinline__ float silu_mul(float g, float u) { return g * __builtin_amdgcn_rcpf(1.0f + __expf(-g)) * u; }

struct EpiGU {
    bf16_t* act; const float* part;
    __device__ __forceinline__ void operator()(const f32x4 (&acc)[2][2][4][2], const Unit& u, int wr, int wc, int fr, int fq) const {
        const int row0 = u.pm * 256 + wr * 64 + fr, hc = u.pn * 128 + wc * 32 + 8 * fq;
#pragma unroll
        for (int ai = 0; ai < 2; ++ai)
#pragma unroll
            for (int m = 0; m < 4; ++m) {
                const int row = row0 + ai * 128 + m * 16; const float rs = rstd_of(part, row);
                const f32x4 g0 = acc[ai][0][m][0] * rs, g1 = acc[ai][0][m][1] * rs, u0 = acc[ai][1][m][0] * rs, u1 = acc[ai][1][m][1] * rs;
                u32x4 w;
                w.x = cvt_pk_bf16(silu_mul(g0[0], u0[0]), silu_mul(g0[1], u0[1])); w.y = cvt_pk_bf16(silu_mul(g0[2], u0[2]), silu_mul(g0[3], u0[3]));
                w.z = cvt_pk_bf16(silu_mul(g1[0], u1[0]), silu_mul(g1[1], u1[1])); w.w = cvt_pk_bf16(silu_mul(g1[2], u1[2]), silu_mul(g1[3], u1[3]));
                *(u32x4*)(act + (size_t)row * FF + hc) = w;
            }
    }
};
template <bool LAST> struct EpiRes {
    const float* xlo; const float* xhi; float* xo; bf16_t* xb; float* part;
    __device__ __forceinline__ void operator()(const f32x4 (&acc)[2][2][4][2], const Unit& u, int wr, int wc, int fr, int fq) const {
        const int row0 = u.pm * 256 + wr * 64 + fr, col0 = u.pn * 256 + wc * 32 + 8 * fq;
#pragma unroll
        for (int ai = 0; ai < 2; ++ai)
#pragma unroll
            for (int m = 0; m < 4; ++m) {
                const int row = row0 + ai * 128 + m * 16;
                const float* xi = (row < S ? xlo : xhi) + (size_t)row * D + col0;
                float ss = 0.f;
#pragma unroll
                for (int bj = 0; bj < 2; ++bj) {
                    const f32x4 a0 = *(const f32x4*)(xi + bj * 128), a1 = *(const f32x4*)(xi + bj * 128 + 4);
                    const f32x4 v0 = a0 + acc[ai][bj][m][0], v1 = a1 + acc[ai][bj][m][1];
                    ss += (v0[0] * v0[0] + v0[1] * v0[1]) + (v0[2] * v0[2] + v0[3] * v0[3]) + (v1[0] * v1[0] + v1[1] * v1[1]) + (v1[2] * v1[2] + v1[3] * v1[3]);
                    if (!LAST || row < MV) { float* o = xo + (size_t)row * D + col0 + bj * 128; *(f32x4*)o = v0; *(f32x4*)(o + 4) = v1; }
                    if (!LAST) { u32x4 w; w.x = cvt_pk_bf16(v0[0], v0[1]); w.y = cvt_pk_bf16(v0[2], v0[3]); w.z = cvt_pk_bf16(v1[0], v1[1]); w.w = cvt_pk_bf16(v1[2], v1[3]);
                        *(u32x4*)(xb + (size_t)row * D + col0 + bj * 128) = w; }
                }
                ss += __shfl_xor(ss, 16); ss += __shfl_xor(ss, 32);
                if (fq == 0) part[(size_t)row * 16 + u.pn * 4 + wc] = ss;
            }
    }
};
struct EpiU {
    bf16_t* ub; const float* part; float* psp; float* pss;
    __device__ __forceinline__ void operator()(const f32x4 (&acc)[2][2][4][2], const Unit& u, int wr, int wc, int fr, int fq) const {
        const int row0 = u.pm * 256 + wr * 64 + fr, col0 = u.pn * 256 + wc * 32 + 8 * fq;
#pragma unroll
        for (int ai = 0; ai < 2; ++ai)
#pragma unroll
            for (int m = 0; m < 4; ++m) {
                const int row = row0 + ai * 128 + m * 16; const float rs = rstd_of(part, row);
                float* po = nullptr;
                if (row >= S - 15 && row < S) po = psp + (size_t)(row - (S - 15)) * D; else if (row >= S && row < MV) po = pss + ((size_t)(row - S) * 15 + 14) * D;
#pragma unroll
                for (int bj = 0; bj < 2; ++bj) {
                    const f32x4 v0 = acc[ai][bj][m][0] * rs, v1 = acc[ai][bj][m][1] * rs;
                    u32x4 w; w.x = cvt_pk_bf16(v0[0], v0[1]); w.y = cvt_pk_bf16(v0[2], v0[3]); w.z = cvt_pk_bf16(v1[0], v1[1]); w.w = cvt_pk_bf16(v1[2], v1[3]);
                    *(u32x4*)(ub + (size_t)row * D + col0 + bj * 128) = w;
                    if (po) { *(f32x4*)(po + col0 + bj * 128) = v0; *(f32x4*)(po + col0 + bj * 128 + 4) = v1; }
                }
            }
    }
};
struct EpiPlain {
    bf16_t* o;
    __device__ __forceinline__ void operator()(const f32x4 (&acc)[2][2][4][2], const Unit& u, int wr, int wc, int fr, int fq) const {
        const int row0 = u.pm * 256 + wr * 64 + fr, col0 = u.pn * 256 + wc * 32 + 8 * fq;
#pragma unroll
        for (int ai = 0; ai < 2; ++ai)
#pragma unroll
            for (int m = 0; m < 4; ++m) {
                const int row = row0 + ai * 128 + m * 16;
#pragma unroll
                for (int bj = 0; bj < 2; ++bj) {
                    const f32x4 v0 = acc[ai][bj][m][0], v1 = acc[ai][bj][m][1];
                    u32x4 w; w.x = cvt_pk_bf16(v0[0], v0[1]); w.y = cvt_pk_bf16(v0[2], v0[3]); w.z = cvt_pk_bf16(v1[0], v1[1]); w.w = cvt_pk_bf16(v1[2], v1[3]);
                    *(u32x4*)(o + (size_t)row * D + col0 + bj * 128) = w;
                }
            }
    }
};
struct EpiQKV {
    bf16_t* qkv; const float* part; float* out;
    __device__ __forceinline__ void operator()(const f32x4 (&acc)[2][2][4][2], const Unit& u, int wr, int wc, int fr, int fq) const {
        const int row0 = u.pm * 256 + wr * 64 + fr, colt = u.pn * 256, col0 = colt + wc * 32 + 8 * fq;
        const int g = colt / 1536, s = (colt % 1536) / 512;
        const int W = 128 << (2 * g);
        const size_t gb = kv_group_base(g);
        const size_t o_p = gb + (s == 2 ? (size_t)W * 512 : 0), o_s = gb + 2 * (size_t)W * 512 + (s == 2 ? (size_t)NS * W * 512 : 0);
#pragma unroll
        for (int ai = 0; ai < 2; ++ai)
#pragma unroll
            for (int m = 0; m < 4; ++m) {
                const int row = row0 + ai * 128 + m * 16; const float rs = rstd_of(part, row);
                float* po = nullptr;
                if (s != 0) { if (row >= S - W && row < S) po = out + o_p + (size_t)(row - (S - W)) * 512; else if (row >= S && row < MV) po = out + o_s + ((size_t)(row - S) * W + (W - 1)) * 512; }
#pragma unroll
                for (int bj = 0; bj < 2; ++bj) {
                    const f32x4 v0 = acc[ai][bj][m][0] * rs, v1 = acc[ai][bj][m][1] * rs;
                    u32x4 w; w.x = cvt_pk_bf16(v0[0], v0[1]); w.y = cvt_pk_bf16(v0[2], v0[3]); w.z = cvt_pk_bf16(v1[0], v1[1]); w.w = cvt_pk_bf16(v1[2], v1[3]);
                    *(u32x4*)(qkv + (size_t)row * QKVW + col0 + bj * 128) = w;
                    if (po) { const int he = (col0 + bj * 128) % 512; *(f32x4*)(po + he) = v0; *(f32x4*)(po + he + 4) = v1; }
                }
            }
    }
};

struct Args { const float* in[26]; float* out; unsigned char* ws; int ph_lo, ph_hi; };

constexpr int NWAVES = 8, NTHR = 512;
constexpr int LDS_BYTES = 147456;

__device__ __forceinline__ void tr_item(const float* W, int ldw, int k0, int n0, bf16_t* dst, int ldd, const float* kscale, const float* nscale, float f, LAS float* scr, int lane) {
#pragma unroll 8
    for (int i = 0; i < 32; ++i) { const int kk = 2 * i + (lane >> 5); float v = W[(size_t)(k0 + kk) * ldw + n0 + (lane & 31)]; if (kscale) v *= kscale[k0 + kk]; scr[kk * 33 + (lane & 31)] = v; }
    LDS_WAIT(); asm volatile("" ::: "memory");
    const int c = lane & 7;
#pragma unroll
    for (int j = 0; j < 4; ++j) { const int n = (lane >> 3) + 8 * j; const LAS float* s = scr + (8 * c) * 33 + n; const float fn = nscale ? f * nscale[n0 + n] : f;
        u32x4 o; o.x = pk2(s[0 * 33] * fn, s[1 * 33] * fn); o.y = pk2(s[2 * 33] * fn, s[3 * 33] * fn); o.z = pk2(s[4 * 33] * fn, s[5 * 33] * fn); o.w = pk2(s[6 * 33] * fn, s[7 * 33] * fn);
        *(u32x4*)(dst + (size_t)n * ldd + k0 + 8 * c) = o; }
    LDS_WAIT(); asm volatile("" ::: "memory");
}
__device__ __forceinline__ float wave_sum(float v) {
#pragma unroll
    for (int o = 1; o < 64; o <<= 1) v += __shfl_xor(v, o);
    return v;
}
__device__ __forceinline__ float wave_max(float v) {
#pragma unroll
    for (int o = 1; o < 64; o <<= 1) v = fmaxf(v, __shfl_xor(v, o));
    return v;
}
__device__ __forceinline__ int t5_bucket(int dist) {
    if (dist < 16) return dist;
    const int b = 16 + (int)(log((double)dist / 16.0) / log(128.0) * 16.0);
    return b < 31 ? b : 31;
}

__global__ void __launch_bounds__(NTHR, 2) fwd_kernel(Args args) {
    extern __shared__ __attribute__((aligned(16))) unsigned char lds_raw[];
    LAS unsigned char* lds = (LAS unsigned char*)lds_raw;
    const int tid = threadIdx.x, lane = tid & 63, wave = __builtin_amdgcn_readfirstlane(tid >> 6);
    const int G = gridDim.x, bx = blockIdx.x;
    const int gw = bx * NWAVES + wave, NGW = G * NWAVES;
    const size_t gt = (size_t)bx * NTHR + tid, NGT = (size_t)G * NTHR;
    unsigned char* ws = args.ws; float* out = args.out;
    bf16_t* Wgu = (bf16_t*)(ws + WS_WGU); bf16_t* Wd = (bf16_t*)(ws + WS_WD); bf16_t* Win = (bf16_t*)(ws + WS_WIN); bf16_t* Wgrp = (bf16_t*)(ws + WS_WGRP);
    bf16_t* Wpo = (bf16_t*)(ws + WS_WPO); bf16_t* Wqkv = (bf16_t*)(ws + WS_WQKV); bf16_t* Wao = (bf16_t*)(ws + WS_WAO);
    float* biasT = (float*)(ws + WS_BIAS); float* part = (float*)(ws + WS_PART);
    bf16_t* xb = (bf16_t*)(ws + WS_XB); float* xf = (float*)(ws + WS_XF); bf16_t* act = (bf16_t*)(ws + WS_ACT);
    bf16_t* ub = (bf16_t*)(ws + WS_U); bf16_t* zb = (bf16_t*)(ws + WS_Z); bf16_t* z2b = (bf16_t*)(ws + WS_Z2); bf16_t* qkv = (bf16_t*)(ws + WS_QKV); bf16_t* ob = (bf16_t*)(ws + WS_O);
    const float* x_prompt = args.in[0]; const float* x_sample = args.in[1]; const float* state_pool = args.in[2];
    const int lo = args.ph_lo, hi = args.ph_hi;
#if MK_MULTI
#define GRID_BAR() do {} while (0)
#else
    cg::grid_group grid = cg::this_grid();
#define GRID_BAR() grid.sync()
#endif
#ifndef PHASE_MASK
#define PHASE_MASK 0x1ffff
#endif
#define IN(k) (((PHASE_MASK >> (k)) & 1) && lo <= (k) && (k) < hi)
#define SEAM(k) do { if (IN(k) && IN((k) + 1)) GRID_BAR(); } while (0)

    if (IN(0)) {
        LAS float* scr = (LAS float*)(lds + wave * 16384);
        constexpr int I_GU = 16 * 88, I_D = 44 * 32, I_IN = 16 * 32, I_GRP = 4 * 8, I_QKV = 16 * 144, I_AO = 8 * 32;
        constexpr int NIT = 8 * I_GU + 4 * I_D + I_IN + 4 * I_GRP + I_IN + I_QKV + I_AO;
        for (int it = gw; it < NIT; it += NGW) {
            int r = it;
            if (r < 8 * I_GU) {
                const int f = r / (2 * I_GU), up = (r / I_GU) & 1, q = r % I_GU, kb = q / 88, nb = q % 88, n0 = nb * 32, layer = f >> 1, second = f & 1;
                const float* W = args.in[(second ? 22 : 10) + up] + (size_t)layer * D * FF;
                const float* gn = args.in[second ? 21 : 9] + layer * D;
                bf16_t* dst = Wgu + (size_t)f * 2 * FF * D + (size_t)((n0 / 128) * 256 + (n0 % 128) + up * 128) * D;
                tr_item(W, FF, kb * 64, n0, dst, D, gn, nullptr, 1.0f, scr, lane); continue; }
            r -= 8 * I_GU;
            if (r < 4 * I_D) { const int f = r / I_D, q = r % I_D, kb = q / 32, nb = q % 32, layer = f >> 1, second = f & 1;
                const float* W = args.in[(second ? 22 : 10) + 2] + (size_t)layer * FF * D;
                tr_item(W, D, kb * 64, nb * 32, Wd + (size_t)f * D * FF + (size_t)(nb * 32) * FF, FF, nullptr, nullptr, 0.5f, scr, lane); continue; }
            r -= 4 * I_D;
            if (r < I_IN) { const int kb = r / 32, nb = r % 32; tr_item(args.in[14], D, kb * 64, nb * 32, Win + (size_t)(nb * 32) * D, D, args.in[13], nullptr, 1.0f, scr, lane); continue; }
            r -= I_IN;
            if (r < 4 * I_GRP) { const int gq = r / I_GRP, q = r % I_GRP, kb = q / 8, nb = q % 8;
                tr_item(args.in[15] + (size_t)gq * 256 * 256, 256, kb * 64, nb * 32, Wgrp + (size_t)(gq * 256 + nb * 32) * 256, 256, nullptr, args.in[16] + gq * 256, 1.0f, scr, lane); continue; }
            r -= 4 * I_GRP;
            if (r < I_IN) { const int kb = r / 32, nb = r % 32; tr_item(args.in[17], D, kb * 64, nb * 32, Wpo + (size_t)(nb * 32) * D, D, nullptr, nullptr, 1.0f, scr, lane); continue; }
            r -= I_IN;
            if (r < I_QKV) { const int kb = r / 144, nb = r % 144, n0 = nb * 32; const float f = ((n0 % 1536) < 512) ? 0.125f : 1.0f;
                tr_item(args.in[18], QKVW, kb * 64, n0, Wqkv + (size_t)n0 * D, D, args.in[13] + D, nullptr, f, scr, lane); continue; }
            r -= I_QKV;
            { const int kb = r / 32, nb = r % 32; tr_item(args.in[19], D, kb * 64, nb * 32, Wao + (size_t)(nb * 32) * 512, 512, nullptr, nullptr, 1.0f, scr, lane); }
        }
        for (int row = gw; row < MP; row += NGW) {
            f32x4 v[4]; float s = 0.f;
            if (row < MV) { const f32x4* xr = (const f32x4*)(row < S ? x_prompt + (size_t)row * D : x_sample + (size_t)(row - S) * D) + lane;
#pragma unroll
                for (int j = 0; j < 4; ++j) { v[j] = xr[64 * j]; s += (v[j].x * v[j].x + v[j].y * v[j].y) + (v[j].z * v[j].z + v[j].w * v[j].w); } }
            else {
#pragma unroll
                for (int j = 0; j < 4; ++j) v[j] = (f32x4){0.f, 0.f, 0.f, 0.f}; }
            s = wave_sum(s);
            u32x2* o8 = (u32x2*)(xb + (size_t)row * D) + lane;
#pragma unroll
            for (int j = 0; j < 4; ++j) { u32x2 w; w.x = pk2(v[j].x, v[j].y); w.y = pk2(v[j].z, v[j].w); o8[64 * j] = w; }
            if (row >= S) { f32x4* xo = (f32x4*)(xf + (size_t)row * D) + lane;
#pragma unroll
                for (int j = 0; j < 4; ++j) xo[64 * j] = v[j]; }
            if (lane < 16) part[(size_t)row * 16 + lane] = (lane == 0) ? s : 0.f;
        }
        for (size_t i = gt; i < 3 * 8 * 132; i += NGT) { const int j = (int)(i % 132), gh = (int)(i / 132), g = gh / 8, h = gh % 8;
            biasT[i] = (j <= 128) ? args.in[20][t5_bucket(j * (1 << (2 * g))) * 24 + g * 8 + h] : 0.f; }
        for (size_t i = gt; i < (size_t)NS * 14 * (D / 4); i += NGT) { const size_t b = i / (14 * (D / 4)), rem = i % (14 * (D / 4));
            ((f32x4*)(out + O_PSS + b * 15 * D))[rem] = ((const f32x4*)(state_pool + b * 15 * D + D))[rem]; }
    }
    SEAM(0);

#define GEMM_PHASE(EPI_T, EPI_INIT, Aptr, LDA_, Bptr, LDB_, K_, NN_, APN_) do { \
        pg8::Gemm g{(const bf16_t*)(Aptr), (const bf16_t*)(Bptr), (LDA_), (LDB_), (K_), (APN_)}; pg8::StaticOrder So; So.init(NPANEL, (NN_), G, bx); \
        EPI_T E EPI_INIT; pg8::gemm_phase<EPI_T, pg8::StaticOrder>(lds, g, So, E); } while (0)

    if (IN(1)) GEMM_PHASE(EpiGU, ({act, part}), xb, D, Wgu, D, D, 22, 0);
    SEAM(1);
    if (IN(2)) GEMM_PHASE(EpiRes<false>, ({x_prompt, xf, xf, xb, part}), act, FF, Wd, FF, FF, 4, 0);
    SEAM(2);
    if (IN(3)) GEMM_PHASE(EpiU, ({ub, part, out + O_PSP, out + O_PSS}), xb, D, Win, D, D, 4, 0);
    SEAM(3);
    if (IN(4)) {
        for (size_t i = gt; i < (size_t)MP * 128; i += NGT) {
            const int row = (int)(i >> 7), ch = (int)(i & 127) * 8, gq = ch >> 8, w = 2 << gq;
            float a[8]; u32x4 o = {0u, 0u, 0u, 0u};
            if (row < MV) {
                const u32x4 cur = *(const u32x4*)(ub + (size_t)row * D + ch);
                float c[8] = {bflo(cur.x), bfhi(cur.x), bflo(cur.y), bfhi(cur.y), bflo(cur.z), bfhi(cur.z), bflo(cur.w), bfhi(cur.w)};
#pragma unroll
                for (int e = 0; e < 8; ++e) a[e] = c[e];
                float cnt;
                if (row < S) { cnt = (float)(w < row + 1 ? w : row + 1);
                    for (int k = 1; k < w; ++k) if (row - k >= 0) { const u32x4 p = *(const u32x4*)(ub + (size_t)(row - k) * D + ch);
                        a[0] += bflo(p.x); a[1] += bfhi(p.x); a[2] += bflo(p.y); a[3] += bfhi(p.y); a[4] += bflo(p.z); a[5] += bfhi(p.z); a[6] += bflo(p.w); a[7] += bfhi(p.w); } }
                else { cnt = (float)w; const float* sp = state_pool + (size_t)(row - S) * 15 * D + ch;
                    for (int k = 1; k < w; ++k) { const f32x4 p0 = *(const f32x4*)(sp + (size_t)(15 - k) * D), p1 = *(const f32x4*)(sp + (size_t)(15 - k) * D + 4);
                        a[0] += p0.x; a[1] += p0.y; a[2] += p0.z; a[3] += p0.w; a[4] += p1.x; a[5] += p1.y; a[6] += p1.z; a[7] += p1.w; } }
                const float ic = 1.0f / cnt;
                o.x = pk2(a[0] * ic - c[0], a[1] * ic - c[1]); o.y = pk2(a[2] * ic - c[2], a[3] * ic - c[3]); o.z = pk2(a[4] * ic - c[4], a[5] * ic - c[5]); o.w = pk2(a[6] * ic - c[6], a[7] * ic - c[7]);
            }
            *(u32x4*)(zb + (size_t)row * D + ch) = o;
        }
    }
    SEAM(4);
    if (IN(5)) GEMM_PHASE(EpiPlain, ({z2b}), zb, D, Wgrp, 256, 256, 4, 256);
    SEAM(5);
    if (IN(6)) GEMM_PHASE(EpiRes<false>, ({xf, xf, xf, xb, part}), z2b, D, Wpo, D, D, 4, 0);
    SEAM(6);
    if (IN(7)) GEMM_PHASE(EpiGU, ({act, part}), xb, D, Wgu + (size_t)1 * 2 * FF * D, D, D, 22, 0);
    SEAM(7);
    if (IN(8)) GEMM_PHASE(EpiRes<false>, ({xf, xf, xf, xb, part}), act, FF, Wd + (size_t)1 * D * FF, FF, FF, 4, 0);
    SEAM(8);
    if (IN(9)) GEMM_PHASE(EpiGU, ({act, part}), xb, D, Wgu + (size_t)2 * 2 * FF * D, D, D, 22, 0);
    SEAM(9);
    if (IN(10)) GEMM_PHASE(EpiRes<false>, ({xf, xf, xf, xb, part}), act, FF, Wd + (size_t)2 * D * FF, FF, FF, 4, 0);
    SEAM(10);
    if (IN(11)) GEMM_PHASE(EpiQKV, ({qkv, part, out}), xb, D, Wqkv, D, D, 18, 0);
    SEAM(11);
#ifndef NO_P12
    if (IN(12)) {
        const int kq = lane >> 3, dc = lane & 7;
        for (int it = gw; it < MV * 8; it += NGW) {
            const int row = it >> 3, h = it & 7;
            float og[3][8]; float lse[3];
#pragma unroll
            for (int g = 0; g < 3; ++g) {
                const int d = 1 << (2 * g), W = 128 << (2 * g);
                const float* ck = args.in[3 + 2 * g]; const float* cv = args.in[4 + 2 * g];
                float q[64];
                { const u32x4* qp = (const u32x4*)(qkv + (size_t)row * QKVW + g * 1536 + h * 64);
#pragma unroll
                  for (int c = 0; c < 8; ++c) { const u32x4 t = qp[c]; q[8 * c] = bflo(t.x); q[8 * c + 1] = bfhi(t.x); q[8 * c + 2] = bflo(t.y); q[8 * c + 3] = bfhi(t.y); q[8 * c + 4] = bflo(t.z); q[8 * c + 5] = bfhi(t.z); q[8 * c + 6] = bflo(t.w); q[8 * c + 7] = bfhi(t.w); } }
                float sc[3];
#pragma unroll
                for (int rnd = 0; rnd < 3; ++rnd) {
                    const int j = lane + 64 * rnd; float s = -1e30f;
                    if (j <= 128) {
                        if (row < S) { const int kt = row - j * d;
                            if (kt >= 0) { const u32x4* kp = (const u32x4*)(qkv + (size_t)kt * QKVW + g * 1536 + 512 + h * 64); float a = 0.f;
#pragma unroll
                                for (int c = 0; c < 8; ++c) { const u32x4 t = kp[c]; a += q[8 * c] * bflo(t.x) + q[8 * c + 1] * bfhi(t.x) + q[8 * c + 2] * bflo(t.y) + q[8 * c + 3] * bfhi(t.y) + q[8 * c + 4] * bflo(t.z) + q[8 * c + 5] * bfhi(t.z) + q[8 * c + 6] * bflo(t.w) + q[8 * c + 7] * bfhi(t.w); }
                                s = a + biasT[(g * 8 + h) * 132 + j]; } }
                        else { float a = 0.f;
                            if (j == 0) { const u32x4* kp = (const u32x4*)(qkv + (size_t)row * QKVW + g * 1536 + 512 + h * 64);
#pragma unroll
                                for (int c = 0; c < 8; ++c) { const u32x4 t = kp[c]; a += q[8 * c] * bflo(t.x) + q[8 * c + 1] * bfhi(t.x) + q[8 * c + 2] * bflo(t.y) + q[8 * c + 3] * bfhi(t.y) + q[8 * c + 4] * bflo(t.z) + q[8 * c + 5] * bfhi(t.z) + q[8 * c + 6] * bflo(t.w) + q[8 * c + 7] * bfhi(t.w); } }
                            else { const f32x4* kp = (const f32x4*)(ck + (((size_t)(row - S) * W + (W - j * d)) * 8 + h) * 64);
#pragma unroll
                                for (int c = 0; c < 16; ++c) { const f32x4 t = kp[c]; a += q[4 * c] * t.x + q[4 * c + 1] * t.y + q[4 * c + 2] * t.z + q[4 * c + 3] * t.w; } }
                            s = a + biasT[(g * 8 + h) * 132 + j]; }
                    }
                    sc[rnd] = s;
                }
                const float mx = wave_max(fmaxf(fmaxf(sc[0], sc[1]), sc[2]));
                float p[3]; float sum = 0.f;
#pragma unroll
                for (int rnd = 0; rnd < 3; ++rnd) { p[rnd] = (sc[rnd] > -1e29f) ? __expf(sc[rnd] - mx) : 0.f; sum += p[rnd]; }
                sum = wave_sum(sum);
                lse[g] = mx + __logf(sum);
                const float inv = 1.0f / sum;
                float o[8] = {0.f, 0.f, 0.f, 0.f, 0.f, 0.f, 0.f, 0.f};
#pragma unroll
                for (int i = 0; i < 17; ++i) {
                    const int j = kq + 8 * i;
                    const int src = j & 63, rnd = j >> 6;
                    const float p0 = __shfl(p[0], src), p1 = __shfl(p[1], src), p2 = __shfl(p[2], src);
                    const float pj = (rnd == 0) ? p0 : ((rnd == 1) ? p1 : p2);
                    if (j <= 128 && pj != 0.f) {
                        if (row < S || j == 0) { const int kt = (row < S) ? row - j * d : row;
                            const u32x4 t = *(const u32x4*)(qkv + (size_t)kt * QKVW + g * 1536 + 1024 + h * 64 + 8 * dc);
                            o[0] += pj * bflo(t.x); o[1] += pj * bfhi(t.x); o[2] += pj * bflo(t.y); o[3] += pj * bfhi(t.y); o[4] += pj * bflo(t.z); o[5] += pj * bfhi(t.z); o[6] += pj * bflo(t.w); o[7] += pj * bfhi(t.w); }
                        else { const f32x4* vp = (const f32x4*)(cv + (((size_t)(row - S) * W + (W - j * d)) * 8 + h) * 64 + 8 * dc); const f32x4 t0 = vp[0], t1 = vp[1];
                            o[0] += pj * t0.x; o[1] += pj * t0.y; o[2] += pj * t0.z; o[3] += pj * t0.w; o[4] += pj * t1.x; o[5] += pj * t1.y; o[6] += pj * t1.z; o[7] += pj * t1.w; }
                    }
                }
#pragma unroll
                for (int e = 0; e < 8; ++e) { float v = o[e]; v += __shfl_xor(v, 8); v += __shfl_xor(v, 16); v += __shfl_xor(v, 32); og[g][e] = v * inv; }
            }
            const float mm = fmaxf(fmaxf(lse[0], lse[1]), lse[2]);
            const float w0 = __expf(lse[0] - mm), w1 = __expf(lse[1] - mm), w2 = __expf(lse[2] - mm), iw = 1.0f / (w0 + w1 + w2);
            if (kq == 0) { float r[8];
#pragma unroll
                for (int e = 0; e < 8; ++e) r[e] = (w0 * og[0][e] + w1 * og[1][e] + w2 * og[2][e]) * iw;
                u32x4 w; w.x = pk2(r[0], r[1]); w.y = pk2(r[2], r[3]); w.z = pk2(r[4], r[5]); w.w = pk2(r[6], r[7]);
                *(u32x4*)(ob + (size_t)row * 512 + h * 64 + 8 * dc) = w; }
        }
        for (size_t i = gt; i < (size_t)(MP - MV) * 64; i += NGT) ((u32x4*)(ob + (size_t)MV * 512))[i] = (u32x4){0u, 0u, 0u, 0u};
    }
#endif
    SEAM(12);
    if (IN(13)) GEMM_PHASE(EpiRes<false>, ({xf, xf, xf, xb, part}), ob, 512, Wao, 512, 512, 4, 0);
    SEAM(13);
    if (IN(14)) GEMM_PHASE(EpiGU, ({act, part}), xb, D, Wgu + (size_t)3 * 2 * FF * D, D, D, 22, 0);
    SEAM(14);
    if (IN(15)) GEMM_PHASE(EpiRes<true>, ({xf, xf, out, xb, part}), act, FF, Wd + (size_t)3 * D * FF, FF, FF, 4, 0);
    SEAM(15);
    if (IN(16)) {
        const float* gf = args.in[25];
        for (int row = gw; row < MV; row += NGW) {
            const float rs = rstd_of(part, row);
            f32x4* xr = (f32x4*)(out + (size_t)row * D) + lane; const f32x4* gr = (const f32x4*)gf + lane;
#pragma unroll
            for (int j = 0; j < 4; ++j) { const f32x4 v = xr[64 * j], gg = gr[64 * j]; xr[64 * j] = v * rs * gg; }
        }
#pragma unroll
        for (int g = 0; g < 3; ++g) {
            const size_t W = (size_t)128 << (2 * g), gb = kv_group_base(g), per = (W - 1) * 128;
#pragma unroll
            for (int kv = 0; kv < 2; ++kv) {
                const f32x4* src = (const f32x4*)args.in[3 + 2 * g + kv]; f32x4* dst = (f32x4*)(out + gb + 2 * W * 512 + (size_t)kv * NS * W * 512);
                for (size_t i = gt; i < (size_t)NS * per; i += NGT) { const size_t b = i / per, r = i % per; dst[b * W * 128 + r] = src[b * W * 128 + 128 + r]; }
            }
        }
    }
}

extern "C" void kernel_launch(void* const* d_in, const int* in_sizes, int n_in, void* d_out, int out_size, void* d_ws, size_t ws_size, hipStream_t stream) {
    static int grid = 0;
    if (grid == 0) {
        if (n_in != 26 || (size_t)out_size != OUT_TOTAL || ws_size < WS_END) { fprintf(stderr, "kernel_launch: unexpected shapes: n_in %d out %d (want %zu) ws %zu (need %zu)\n", n_in, out_size, (size_t)OUT_TOTAL, ws_size, (size_t)WS_END); grid = -1; return; }
        int dev = 0, cus = 0, per_cu = 0;
        hipGetDevice(&dev); hipDeviceGetAttribute(&cus, hipDeviceAttributeMultiprocessorCount, dev);
        hipFuncSetAttribute((const void*)fwd_kernel, hipFuncAttributeMaxDynamicSharedMemorySize, LDS_BYTES);
        hipOccupancyMaxActiveBlocksPerMultiprocessor(&per_cu, (const void*)fwd_kernel, NTHR, LDS_BYTES);
        if (per_cu < 1) { fprintf(stderr, "kernel_launch: occupancy query says %d blocks per CU\n", per_cu); per_cu = 1; }
        grid = cus;
        (void)hipGetLastError();
    }
    if (grid < 0) return;
    Args a{};
    for (int i = 0; i < 26; ++i) a.in[i] = (const float*)d_in[i];
    a.out = (float*)d_out; a.ws = (unsigned char*)d_ws;
#if MK_MULTI
    for (int p = 0; p < 17; ++p) { a.ph_lo = p; a.ph_hi = p + 1; hipLaunchKernelGGL(fwd_kernel, dim3(grid), dim3(NTHR), LDS_BYTES, stream, a); }
#else
    a.ph_lo = 0; a.ph_hi = 17;
    void* kargs[] = {&a};
    hipError_t e = hipLaunchCooperativeKernel((const void*)fwd_kernel, dim3(grid), dim3(NTHR), kargs, LDS_BYTES, stream);
    if (e != hipSuccess) fprintf(stderr, "cooperative launch failed: %s (grid %d)\n", hipGetErrorString(e), grid);
#endif
}
```

```cpp
#include <hip/hip_runtime.h>
#include <hip/hip_cooperative_groups.h>
#include <cstdio>
#include <cstdint>
namespace cg = cooperative_groups;


#define LAS __attribute__((address_space(3)))
typedef unsigned short bf16_t;
typedef short bf16x8 __attribute__((ext_vector_type(8)));
typedef float f32x4 __attribute__((ext_vector_type(4)));
typedef float f32x2 __attribute__((ext_vector_type(2)));
typedef unsigned u32x4 __attribute__((ext_vector_type(4)));
typedef unsigned u32x2 __attribute__((ext_vector_type(2)));

constexpr int D = 1024, S = 16384, NS = 32, FF = 2816, MP = 16640, NPANEL = 65, MV = S + NS;
constexpr int QKVW = 4608;
constexpr int MPV = MP + 128;
constexpr float EPS = 1e-6f;

__device__ __forceinline__ unsigned f2bf(float f) { unsigned u = __builtin_bit_cast(unsigned, f); return (u + 0x7fffu + ((u >> 16) & 1u)) >> 16; }
__device__ __forceinline__ unsigned pk2(float lo, float hi) { return f2bf(lo) | (f2bf(hi) << 16); }
__device__ __forceinline__ float bf2f(unsigned short b) { return __builtin_bit_cast(float, ((unsigned)b) << 16); }
__device__ __forceinline__ float bflo(unsigned w) { return __builtin_bit_cast(float, w << 16); }
__device__ __forceinline__ float bfhi(unsigned w) { return __builtin_bit_cast(float, w & 0xffff0000u); }
#define LDS_WAIT() asm volatile("s_waitcnt lgkmcnt(0)" ::: "memory")
#define VM_WAIT() asm volatile("s_waitcnt vmcnt(0)" ::: "memory")
typedef __amdgpu_buffer_rsrc_t rsrc_t;
__device__ __forceinline__ rsrc_t mkrs(const void* p, size_t bytes) { return __builtin_amdgcn_make_buffer_rsrc((void*)p, 0, (int)bytes, 0x00020000); }
#define ST16(rs, off, v) __builtin_amdgcn_raw_buffer_store_b128((v), (rs), (unsigned)(off), 0, 16)
#define ST8(rs, off, v) __builtin_amdgcn_raw_buffer_store_b64((v), (rs), (unsigned)(off), 0, 16)
#define ST4(rs, off, v) __builtin_amdgcn_raw_buffer_store_b32((v), (rs), (unsigned)(off), 0, 16)
#define F4U(v) __builtin_bit_cast(u32x4, (v))
#define RLX_AGENT __ATOMIC_RELAXED, __HIP_MEMORY_SCOPE_AGENT

namespace pg8 {
constexpr int BM = 256, BK = 64, HALF = 128, HTB = HALF * BK * 2, STAGE_BYTES = 8 * HTB, NXCD = 8, WGM = 8;
__host__ __device__ __forceinline__ int lds_byte(int r, int c) { const int st = (r >> 4) * 2 + (c >> 5), rr = r & 15, cc = c & 31, ob = rr * 64 + cc * 2; return st * 1024 + (ob ^ (((ob >> 9) & 1) << 5)); }
__host__ __device__ __forceinline__ void stage_rc(int b, int& R, int& C) { const int st = b / 1024, sb = b % 1024, swz = sb ^ (((sb >> 9) & 1) << 5); R = (st >> 1) * 16 + swz / 64; C = (st & 1) * 32 + (swz % 64) / 2; }
__host__ __device__ __forceinline__ int perm32(int rho) { const int n = rho >> 4, i = rho & 15; return 8 * (i >> 2) + 4 * n + (i & 3); }
__host__ __device__ __forceinline__ int sigma_row(int d, int v) { const int q = 256 / d; return (v % q) * d + v / q; }

struct Unit { int pm, pn; };
struct Gemm { const bf16_t* A; const bf16_t* Bt; int lda, ldb, K, a_pn, bsig; };

#define FLOW_SPIN_CAP (1u << 21)
__device__ __forceinline__ void flow_poll1(const unsigned* c, unsigned need) {
    unsigned sp = 0;
    while ((unsigned)__builtin_amdgcn_readfirstlane(__hip_atomic_load(c, RLX_AGENT)) < need) { __builtin_amdgcn_s_sleep(2); if (++sp > FLOW_SPIN_CAP) break; }
}
__device__ __forceinline__ void flow_publish(unsigned* c) {
    asm volatile("s_waitcnt vmcnt(0)" ::: "memory");
    if ((threadIdx.x & 63) == 0) __hip_atomic_fetch_add(c, 1u, RLX_AGENT);
}
struct FlowOrder {
    int nM, nN, wgm, base, nx;
    unsigned* head;
    LAS unsigned* slot;
    unsigned claimed;
    const unsigned* wdep; unsigned wneed;
    const unsigned* dep; unsigned need, need64; int dep_pn, dep_shift;
    unsigned* pub; int pub_pn;
    __device__ __forceinline__ void init(int nM_, int nN_, int wgm_, int xcd, unsigned* qbase, int& qi, LAS unsigned* slot_) {
        nM = nM_; nN = nN_; wgm = wgm_;
        const int nwg = nM * nN, q = nwg / NXCD, r = nwg % NXCD;
        nx = q + (xcd < r ? 1 : 0); base = xcd < r ? xcd * (q + 1) : r * (q + 1) + (xcd - r) * q;
        head = qbase + (size_t)(qi * NXCD + xcd) * 64; ++qi; slot = slot_; claimed = 0u;
        wdep = nullptr; wneed = 0; dep = nullptr; need = 0; need64 = 0; dep_pn = 0; dep_shift = 0; pub = nullptr; pub_pn = 0;
    }
    __device__ __forceinline__ bool decode(unsigned l, Unit& u) const {
        if (l >= (unsigned)nx) return false;
        const int wgid = base + (int)l, nig = wgm * nN, gid = wgid / nig, fm = gid * wgm, gsz = (nM - fm) < wgm ? (nM - fm) : wgm;
        u.pm = fm + ((wgid % nig) % gsz); u.pn = (wgid % nig) / gsz; return true;
    }
    __device__ __forceinline__ bool next_blocking(Unit& u) {
        __syncthreads();
        if (threadIdx.x == 0) { const unsigned tk = __hip_atomic_fetch_add(head, 1u, RLX_AGENT);
            if (wdep) { unsigned sp = 0; while (__hip_atomic_load(wdep, RLX_AGENT) < wneed) { __builtin_amdgcn_s_sleep(2); if (++sp > FLOW_SPIN_CAP) break; } }
            *slot = tk; }
        __syncthreads();
        return decode(*slot, u);
    }
    __device__ __forceinline__ void claim_async(unsigned& r) {
        if (threadIdx.x == 0) { unsigned long long gp = (unsigned long long)head; unsigned one = 1u;
            asm volatile("global_atomic_add %0, %1, %2, off sc0" : "+v"(r) : "v"(gp), "v"(one) : "memory"); } }
    __device__ __forceinline__ void claim_take(unsigned& r) {
        if (threadIdx.x < 64) { int l; asm volatile("s_waitcnt vmcnt(8)\n\ts_nop 0\n\tv_readfirstlane_b32 %0, %1" : "=s"(l), "+v"(r) :: "memory"); claimed = (unsigned)l; } }
    __device__ __forceinline__ bool ready_next(Unit& u) {
        if (threadIdx.x < 64) {
            const unsigned l = claimed;
            Unit t; const bool ok = decode(l, t);
            if (ok && dep) { const int panel = dep_pn ? t.pn : t.pm;
                flow_poll1(dep + (size_t)(panel >> dep_shift) * 64, panel == 64 ? need64 : need);
                __builtin_amdgcn_fence(__ATOMIC_ACQUIRE, "agent");
                asm volatile("s_waitcnt vmcnt(0)" ::: "memory"); }
            if (threadIdx.x == 0) *slot = l;
        }
        asm volatile("s_waitcnt lgkmcnt(0)" ::: "memory"); __builtin_amdgcn_s_barrier(); asm volatile("" ::: "memory");
        return decode(*slot, u);
    }
    __device__ __forceinline__ void a_ready(const Unit& u) const {
        if (dep) {
            if (threadIdx.x < 64) { const int panel = dep_pn ? u.pn : u.pm;
                flow_poll1(dep + (size_t)(panel >> dep_shift) * 64, panel == 64 ? need64 : need);
                __builtin_amdgcn_fence(__ATOMIC_ACQUIRE, "agent");
                asm volatile("s_waitcnt vmcnt(0)" ::: "memory"); }
            asm volatile("" ::: "memory"); __builtin_amdgcn_s_barrier(); asm volatile("" ::: "memory");
        }
    }
    __device__ __forceinline__ void done(const Unit& u) const { if (pub) flow_publish(pub + (size_t)(pub_pn ? u.pn : u.pm) * 64); }
};

__device__ __forceinline__ unsigned cvt_pk_bf16(float lo, float hi) { unsigned r; asm volatile("v_cvt_pk_bf16_f32 %0, %1, %2" : "=v"(r) : "v"(lo), "v"(hi)); return r; }

template <class Epi, class Sched>
__device__ __forceinline__ void gemm_phase(LAS unsigned char* lds, const Gemm g, Sched& S, const Epi& E) {
    int tid = threadIdx.x; asm volatile("" : "+v"(tid));
    const int wid = __builtin_amdgcn_readfirstlane(tid >> 6), lane = tid & 63, wr = wid >> 2, wc = wid & 3, fr = lane & 15, fq = lane >> 4;
    const int K = g.K, nt = K / BK;
    unsigned voffA[2], voffB[2];
#pragma unroll
    for (int i = 0; i < 2; ++i) { int R, C; stage_rc(tid * 16 + i * 8192, R, C); const int Rb = sigma_row(g.bsig, (R & ~31) + perm32(R & 31));
        voffA[i] = (unsigned)(R * g.lda + C) * 2u; voffB[i] = (unsigned)(Rb * g.ldb + C) * 2u; }
    const size_t kstep = (size_t)(BK * 2);
    const size_t hstepA = (size_t)HALF * g.lda * 2, hstepB = (size_t)sigma_row(g.bsig, HALF) * g.ldb * 2;
    const size_t tstepA = 2 * hstepA, tstepB = (size_t)BM * g.ldb * 2;
    const unsigned ldsw = (unsigned)wid * 1024u;
    const int aoff = lds_byte(wr * 64 + fr, fq * 8), boff = lds_byte(wc * 32 + fr, fq * 8);
#define PG8_SA(b, h) (((b) * 2 + (h)) * HTB)
#define PG8_SB(b, h) ((4 + (b) * 2 + (h)) * HTB)
#define PG8_STAGE(bufoff, gbase, voff) do { _Pragma("unroll") for (int _i = 0; _i < 2; ++_i) \
        __builtin_amdgcn_global_load_lds((const unsigned*)((const char*)(gbase) + (voff)[_i]), (LAS unsigned*)(lds + (bufoff) + ldsw + _i * 8192), 16, 0, 0); } while (0)
#define PG8_LDA(dst, b, h) do { _Pragma("unroll") for (int m = 0; m < 4; ++m) _Pragma("unroll") for (int k = 0; k < 2; ++k) dst[m][k] = *(const LAS bf16x8*)(lds + PG8_SA(b, h) + aoff + m * 2048 + k * 1024); } while (0)
#define PG8_LDB(dst, b, h) do { _Pragma("unroll") for (int n = 0; n < 2; ++n) _Pragma("unroll") for (int k = 0; k < 2; ++k) dst[n][k] = *(const LAS bf16x8*)(lds + PG8_SB(b, h) + boff + n * 2048 + k * 1024); } while (0)
#define PG8_MMA(ai, bj, At, Bt) do { __builtin_amdgcn_s_setprio(1); _Pragma("unroll") for (int m = 0; m < 4; ++m) _Pragma("unroll") for (int n = 0; n < 2; ++n) _Pragma("unroll") for (int k = 0; k < 2; ++k) \
        acc[ai][bj][m][n] = __builtin_amdgcn_mfma_f32_16x16x32_bf16(Bt[n][k], At[m][k], acc[ai][bj][m][n], 0, 0, 0); __builtin_amdgcn_s_setprio(0); } while (0)
#define PG8_WAIT_V(n) asm volatile("s_waitcnt vmcnt(" #n ")" ::: "memory")
#define PG8_WAIT_L(n) asm volatile("s_waitcnt lgkmcnt(" #n ")" ::: "memory")
#define PG8_BAR __builtin_amdgcn_s_barrier()
#define PG8_SCHED __builtin_amdgcn_sched_barrier(0)
    Unit cur, nxt; int ui = 0;
    if (!S.next_blocking(cur)) return;
    f32x4 acc[2][2][4][2];
#pragma unroll
    for (int a = 0; a < 2; ++a)
#pragma unroll
        for (int b = 0; b < 2; ++b)
#pragma unroll
            for (int m = 0; m < 4; ++m)
#pragma unroll
                for (int n = 0; n < 2; ++n) acc[a][b][m][n] = (f32x4){0.f, 0.f, 0.f, 0.f};
    bf16x8 At[4][2], B0[2][2], B1[2][2];
    const char* cA = (const char*)g.A + (size_t)cur.pm * tstepA + (size_t)cur.pn * g.a_pn * 2; const char* cB = (const char*)g.Bt + (size_t)cur.pn * tstepB;
    PG8_STAGE(PG8_SB(0, 0), cB, voffB); PG8_STAGE(PG8_SB(0, 1), cB + hstepB, voffB);
    S.a_ready(cur);
    PG8_STAGE(PG8_SA(0, 0), cA, voffA); PG8_STAGE(PG8_SA(0, 1), cA + hstepA, voffA);
    if (wr == 1) PG8_BAR;
    PG8_WAIT_V(2); PG8_BAR;
    PG8_STAGE(PG8_SB(1, 0), cB + kstep, voffB); PG8_STAGE(PG8_SA(1, 0), cA + kstep, voffA); PG8_STAGE(PG8_SB(1, 1), cB + hstepB + kstep, voffB);
    PG8_WAIT_V(6); PG8_BAR;
    for (;;) {
        bool has_next = false; const char* nA = cA; const char* nB = cB;
        const int t_claim = nt >= 4 ? nt - 4 : 0;
#pragma nounroll
        for (int t = 0; t < nt; t += 2) {
            const bool last = (t == nt - 2);
            const char* a1 = cA + (size_t)(t + 1) * kstep;
            const bool claiming = (t == t_claim); unsigned ctmp = 0u;
            if (claiming) S.claim_async(ctmp);
            if (last) { has_next = S.ready_next(nxt);
                if (has_next) { nA = (const char*)g.A + (size_t)nxt.pm * tstepA + (size_t)nxt.pn * g.a_pn * 2; nB = (const char*)g.Bt + (size_t)nxt.pn * tstepB; } }
            const char* a2 = last ? nA : cA + (size_t)(t + 2) * kstep; const char* b2 = last ? nB : cB + (size_t)(t + 2) * kstep;
            const char* a3 = a2 + kstep; const char* b3 = b2 + kstep;
            PG8_LDB(B0, 0, 0); PG8_LDB(B1, 0, 1); PG8_SCHED; PG8_LDA(At, 0, 0); PG8_STAGE(PG8_SA(1, 1), a1 + hstepA, voffA);
            PG8_WAIT_V(8); PG8_WAIT_L(0); PG8_BAR; PG8_MMA(0, 0, At, B0); PG8_MMA(0, 1, At, B1); PG8_BAR; PG8_SCHED;
            PG8_LDA(At, 0, 1); PG8_STAGE(PG8_SB(0, 0), b2, voffB); PG8_STAGE(PG8_SB(0, 1), b2 + hstepB, voffB); PG8_STAGE(PG8_SA(0, 0), a2, voffA);
            PG8_WAIT_V(8); PG8_WAIT_L(0); PG8_BAR; PG8_MMA(1, 0, At, B0); PG8_MMA(1, 1, At, B1); PG8_BAR; PG8_SCHED;
            PG8_LDB(B0, 1, 0); PG8_LDB(B1, 1, 1); PG8_SCHED; PG8_LDA(At, 1, 0); PG8_STAGE(PG8_SA(0, 1), a2 + hstepA, voffA);
            PG8_WAIT_V(8); PG8_WAIT_L(0); PG8_BAR; PG8_MMA(0, 0, At, B0); PG8_MMA(0, 1, At, B1); PG8_BAR; PG8_SCHED;
            PG8_LDA(At, 1, 1); PG8_STAGE(PG8_SB(1, 0), b3, voffB); PG8_STAGE(PG8_SB(1, 1), b3 + hstepB, voffB); PG8_STAGE(PG8_SA(1, 0), a3, voffA);
            PG8_WAIT_V(8); PG8_WAIT_L(0); PG8_BAR; PG8_MMA(1, 0, At, B0); PG8_MMA(1, 1, At, B1); PG8_BAR; PG8_SCHED;
            if (claiming) S.claim_take(ctmp);
        }
        if (wr == 0) PG8_BAR;
        E(acc, cur, wr, wc, fr, fq); S.done(cur);
        if (!has_next) break;
#pragma unroll
        for (int a = 0; a < 2; ++a)
#pragma unroll
            for (int b = 0; b < 2; ++b)
#pragma unroll
                for (int m = 0; m < 4; ++m)
#pragma unroll
                    for (int n = 0; n < 2; ++n) acc[a][b][m][n] = (f32x4){0.f, 0.f, 0.f, 0.f};
        cur = nxt; cA = nA; cB = nB; ++ui;
        if (wr == 1) PG8_BAR;
    }
    PG8_WAIT_V(0);
    PG8_BAR;
#undef PG8_SA
#undef PG8_SB
#undef PG8_STAGE
#undef PG8_LDA
#undef PG8_LDB
#undef PG8_MMA
#undef PG8_WAIT_V
#undef PG8_WAIT_L
#undef PG8_BAR
#undef PG8_SCHED
}
}
using pg8::Unit;
using pg8::cvt_pk_bf16;
using pg8::flow_poll1;
using pg8::flow_publish;

constexpr size_t MiB = 1u << 20;
constexpr size_t al(size_t x) { return (x + 4095) & ~(size_t)4095; }
constexpr size_t WS_CTL = 0;
constexpr size_t WS_WGU = 1 * MiB;
constexpr size_t SZ_WGU = (size_t)2 * FF * D * 2;
constexpr size_t WS_WD = WS_WGU + 4 * SZ_WGU;
constexpr size_t SZ_WD = (size_t)D * FF * 2;
constexpr size_t WS_WIN = WS_WD + 4 * SZ_WD;
constexpr size_t WS_WGRP = WS_WIN + (size_t)D * D * 2;
constexpr size_t WS_WPO = WS_WGRP + (size_t)D * 256 * 2;
constexpr size_t WS_WQKV = WS_WPO + (size_t)D * D * 2;
constexpr size_t WS_WAO = WS_WQKV + (size_t)QKVW * D * 2;
constexpr size_t WS_BIAS = WS_WAO + (size_t)D * 512 * 2;
constexpr size_t WS_PART = al(WS_BIAS + 3 * 8 * 132 * 4);
constexpr size_t WS_XB = al(WS_PART + (size_t)MP * 4 * 4);
constexpr size_t WS_XF = WS_XB + (size_t)MP * D * 2;
constexpr size_t WS_ACT = WS_XF + (size_t)MP * D * 4;
constexpr size_t WS_U = WS_ACT + (size_t)MP * FF * 2;
constexpr size_t WS_Z = WS_U + (size_t)MP * D * 2;
constexpr size_t WS_Z2 = WS_Z + (size_t)MP * D * 2;
constexpr size_t WS_QK = WS_Z2 + (size_t)MP * D * 2;
constexpr size_t WS_VT = WS_QK + (size_t)MP * 3072 * 2;
constexpr size_t WS_O = WS_VT + (size_t)3 * 512 * MPV * 2;
constexpr size_t WS_VNEW = WS_O + (size_t)MP * 512 * 2;
constexpr size_t WS_END = WS_VNEW + (size_t)NS * 1536 * 2;

constexpr size_t O_YP = 0, O_YS = (size_t)S * D, O_PSP = O_YS + (size_t)NS * D, O_PSS = O_PSP + 15 * D, O_KV0 = O_PSS + (size_t)NS * 15 * D;
__host__ __device__ constexpr size_t kv_group_base(int g) {
    size_t o = O_KV0;
    for (int i = 0; i < g; ++i) { const size_t W = (size_t)128 << (2 * i); o += 2 * W * 512 + 2 * (size_t)NS * W * 512; }
    return o;
}
constexpr size_t OUT_TOTAL = kv_group_base(3);

constexpr int CP_ROWS_TOTAL = 2 * NS * (127 + 511 + 2047);
constexpr int CP_CHUNKS = (CP_ROWS_TOTAL + 31) / 32;
__device__ __forceinline__ bool cp_addr(const float* const* in, float* out, int rho, int lane, const f32x4*& src, f32x4*& dst) {
    if (rho >= CP_ROWS_TOTAL) return false;
    int g = 0, kv = 0, rem = rho;
    if (rem >= 2 * NS * 127) { rem -= 2 * NS * 127; g = 1; if (rem >= 2 * NS * 511) { rem -= 2 * NS * 511; g = 2; } }
    const int W = 128 << (2 * g), per = NS * (W - 1);
    if (rem >= per) { rem -= per; kv = 1; }
    const int b = rem / (W - 1), t = rem % (W - 1);
    src = (const f32x4*)in[3 + 2 * g + kv] + ((size_t)b * W + t + 1) * 128 + lane;
    dst = (f32x4*)(out + kv_group_base(g) + 2 * (size_t)W * 512 + (size_t)kv * NS * W * 512) + ((size_t)b * W + t) * 128 + lane;
    return true;
}
struct CopyJob { const float* const* in; float* out; int next; };

__device__ __forceinline__ float rstd_of(const float* part, int row) {
    const f32x4 a = *(const f32x4*)(part + (size_t)row * 4);
    return __builtin_amdgcn_rsqf(((a.x + a.y) + (a.z + a.w)) * (1.0f / D) + EPS);
}
__device__ __forceinline__ float silu_mul(float g, float u) { return g * __builtin_amdgcn_rcpf(1.0f + __expf(-g)) * u; }
__device__ __forceinline__ u32x4 pack8(const f32x4 v0, const f32x4 v1) { u32x4 w; w.x = cvt_pk_bf16(v0[0], v0[1]); w.y = cvt_pk_bf16(v0[2], v0[3]); w.z = cvt_pk_bf16(v1[0], v1[1]); w.w = cvt_pk_bf16(v1[2], v1[3]); return w; }

template <class Derived> struct EpiBase {
    __device__ __forceinline__ void operator()(f32x4 (&acc)[2][2][4][2], const Unit& u, int wr, int wc, int fr, int fq) const {
        const Derived& self = *static_cast<const Derived*>(this);
        const int row0 = u.pm * 256 + wr * 64 + fr;
        float ctx[2][4];
#pragma unroll
        for (int ai = 0; ai < 2; ++ai)
#pragma unroll
            for (int m = 0; m < 4; ++m) ctx[ai][m] = self.pre_row(acc[ai][0][m], acc[ai][1][m], row0 + ai * 128 + m * 16, u.pn, wc, fq);
        __builtin_amdgcn_sched_barrier(0);
#pragma unroll
        for (int ai = 0; ai < 2; ++ai)
#pragma unroll
            for (int m = 0; m < 4; ++m) { const f32x4 v[2][2] = {{acc[ai][0][m][0], acc[ai][0][m][1]}, {acc[ai][1][m][0], acc[ai][1][m][1]}};
                self.row_op(v, row0 + ai * 128 + m * 16, u.pn, wc, fq, ai * 128 + wr * 64 + m * 16 + fr, ctx[ai][m]); }
        self.finish(u.pm, u.pn, 256);
    }
    __device__ __forceinline__ void small(f32x4 (&accS)[2][2][2], int pn, int wc, int fr, int fq, bool active) const {
        const Derived& self = *static_cast<const Derived*>(this);
        if (active) {
            float ctx[2];
#pragma unroll
            for (int m = 0; m < 2; ++m) ctx[m] = self.pre_row(accS[0][m], accS[1][m], S + m * 16 + fr, pn, wc, fq);
            __builtin_amdgcn_sched_barrier(0);
#pragma unroll
            for (int m = 0; m < 2; ++m) { const f32x4 v[2][2] = {{accS[0][m][0], accS[0][m][1]}, {accS[1][m][0], accS[1][m][1]}};
                self.row_op(v, S + m * 16 + fr, pn, wc, fq, m * 16 + fr, ctx[m]); }
        }
        self.finish(64, pn, 32);
    }
    __device__ __forceinline__ void finish(int, int, int) const {}
};

struct RsCache { int t0, t1; };
struct EpiGU : EpiBase<EpiGU> {
    rsrc_t act; const float* part; CopyJob* cj; RsCache* rc; LAS float* rsl;
    __device__ __forceinline__ float pre_row(f32x4 (&)[2], f32x4 (&)[2], int row, int, int, int) const { return rstd_of(part, row); }
    __device__ __forceinline__ u32x4 silu_pack(const f32x4 (&v)[2][2], float rs) const {
        const float c = -1.4426950408889634f * rs, r2 = rs * rs;
        f32x4 o0, o1;
#pragma unroll
        for (int e = 0; e < 4; ++e) { o0[e] = (v[0][0][e] * v[1][0][e]) * (r2 * __builtin_amdgcn_rcpf(1.0f + __builtin_amdgcn_exp2f(v[0][0][e] * c))); o1[e] = (v[0][1][e] * v[1][1][e]) * (r2 * __builtin_amdgcn_rcpf(1.0f + __builtin_amdgcn_exp2f(v[0][1][e] * c))); }
        return pack8(o0, o1);
    }
    __device__ __forceinline__ void row_op(const f32x4 (&v)[2][2], int row, int pn, int wc, int fq, int, float rs) const {
        ST16(act, ((unsigned)row * FF + pn * 128 + wc * 32 + 8 * fq) * 2u, silu_pack(v, rs));
    }
    __device__ __forceinline__ void operator()(f32x4 (&acc)[2][2][4][2], const Unit& u, int wr, int wc, int fr, int fq) const {
        const int row0 = u.pm * 256 + wr * 64 + fr, lane = fr + 16 * fq, wave = wr * 4 + wc;
        float rs[2][4];
        const int slot = u.pm & 1; const bool hit = (slot ? rc->t1 : rc->t0) == u.pm; LAS float* rl = rsl + slot * 256 + wr * 64 + fr;
        if (hit) {
#pragma unroll
            for (int ai = 0; ai < 2; ++ai)
#pragma unroll
                for (int m = 0; m < 4; ++m) rs[ai][m] = rl[ai * 128 + m * 16];
        } else {
#pragma unroll
            for (int ai = 0; ai < 2; ++ai)
#pragma unroll
                for (int m = 0; m < 4; ++m) rs[ai][m] = rstd_of(part, row0 + ai * 128 + m * 16);
            if (wc == 0 && fq == 0) {
#pragma unroll
                for (int ai = 0; ai < 2; ++ai)
#pragma unroll
                    for (int m = 0; m < 4; ++m) rl[ai * 128 + m * 16] = rs[ai][m]; }
            if (slot) rc->t1 = u.pm; else rc->t0 = u.pm;
        }
        f32x4 cv[4][2]; f32x4* cd[4]; const int chunk = cj->next;
        if (chunk < CP_CHUNKS) {
#pragma unroll
            for (int q = 0; q < 4; ++q) { const f32x4* src; cd[q] = nullptr; if (cp_addr(cj->in, cj->out, chunk * 32 + wave * 4 + q, lane, src, cd[q])) { cv[q][0] = __builtin_nontemporal_load(src); cv[q][1] = __builtin_nontemporal_load(src + 64); } }
        }
        __builtin_amdgcn_sched_barrier(0);
        u32x4 w[2][4];
#pragma unroll
        for (int ai = 0; ai < 2; ++ai)
#pragma unroll
            for (int m = 0; m < 4; ++m) { const f32x4 v[2][2] = {{acc[ai][0][m][0], acc[ai][0][m][1]}, {acc[ai][1][m][0], acc[ai][1][m][1]}}; w[ai][m] = silu_pack(v, rs[ai][m]); }
        __builtin_amdgcn_sched_barrier(0);
        if (chunk < CP_CHUNKS) {
#pragma unroll
            for (int q = 0; q < 4; ++q) if (cd[q]) { __builtin_nontemporal_store(cv[q][0], cd[q]); __builtin_nontemporal_store(cv[q][1], cd[q] + 64); }
            cj->next = chunk + 256;
        }
#pragma unroll
        for (int ai = 0; ai < 2; ++ai)
#pragma unroll
            for (int m = 0; m < 4; ++m) ST16(act, ((unsigned)(row0 + ai * 128 + m * 16) * FF + u.pn * 128 + wc * 32 + 8 * fq) * 2u, w[ai][m]);
    }
};
template <bool LAST> struct EpiRes : EpiBase<EpiRes<LAST>> {
    const bf16_t* xr; rsrc_t xo; rsrc_t xb; rsrc_t part; LAS float* red;
    __device__ __forceinline__ void operator()(f32x4 (&acc)[2][2][4][2], const Unit& u, int wr, int wc, int fr, int fq) const {
        const int row0 = u.pm * 256 + wr * 64 + fr, coff = u.pn * 256 + wc * 32 + 8 * fq;
        u32x4 xn[2][4][2];
#pragma unroll
        for (int ai = 0; ai < 2; ++ai)
#pragma unroll
            for (int m = 0; m < 4; ++m) { const bf16_t* xi = xr + (size_t)(row0 + ai * 128 + m * 16) * D + coff; xn[ai][m][0] = *(const u32x4*)xi; xn[ai][m][1] = *(const u32x4*)(xi + 128); }
        __builtin_amdgcn_sched_barrier(0);
#pragma unroll
        for (int ai = 0; ai < 2; ++ai)
#pragma unroll
            for (int m = 0; m < 4; ++m) {
                f32x4 v[2][2];
#pragma unroll
                for (int bj = 0; bj < 2; ++bj) { const u32x4 t = xn[ai][m][bj];
                    v[bj][0] = acc[ai][bj][m][0] + (f32x4){bflo(t.x), bfhi(t.x), bflo(t.y), bfhi(t.y)}; v[bj][1] = acc[ai][bj][m][1] + (f32x4){bflo(t.z), bfhi(t.z), bflo(t.w), bfhi(t.w)}; }
                row_op(v, row0 + ai * 128 + m * 16, u.pn, wc, fq, ai * 128 + wr * 64 + m * 16 + fr, 0.f);
            }
        finish(u.pm, u.pn, 256);
    }
    __device__ __forceinline__ float pre_row(f32x4 (&a0)[2], f32x4 (&a1)[2], int row, int pn, int wc, int fq) const {
        const bf16_t* xi = xr + (size_t)row * D + pn * 256 + wc * 32 + 8 * fq;
        const u32x4 t0 = *(const u32x4*)xi, t1 = *(const u32x4*)(xi + 128);
        a0[0] += (f32x4){bflo(t0.x), bfhi(t0.x), bflo(t0.y), bfhi(t0.y)}; a0[1] += (f32x4){bflo(t0.z), bfhi(t0.z), bflo(t0.w), bfhi(t0.w)};
        a1[0] += (f32x4){bflo(t1.x), bfhi(t1.x), bflo(t1.y), bfhi(t1.y)}; a1[1] += (f32x4){bflo(t1.z), bfhi(t1.z), bflo(t1.w), bfhi(t1.w)};
        return 0.f;
    }
    __device__ __forceinline__ void row_op(const f32x4 (&v)[2][2], int row, int pn, int wc, int fq, int lrow, float) const {
        const int col0 = pn * 256 + wc * 32 + 8 * fq;
        float ss = 0.f;
#pragma unroll
        for (int bj = 0; bj < 2; ++bj) {
            const f32x4 v0 = v[bj][0], v1 = v[bj][1];
            ss += (v0[0] * v0[0] + v0[1] * v0[1]) + (v0[2] * v0[2] + v0[3] * v0[3]) + (v1[0] * v1[0] + v1[1] * v1[1]) + (v1[2] * v1[2] + v1[3] * v1[3]);
            if (LAST) { const unsigned o = ((unsigned)row * D + col0 + bj * 128) * 4u; ST16(xo, o, F4U(v0)); ST16(xo, o + 16u, F4U(v1)); }
            else ST16(xb, ((unsigned)row * D + col0 + bj * 128) * 2u, pack8(v0, v1));
        }
        ss += __shfl_xor(ss, 16); ss += __shfl_xor(ss, 32);
        if (fq == 0) red[lrow * 4 + wc] = ss;
    }
    __device__ __forceinline__ void finish(int pm, int pn, int nrows) const {
        asm volatile("s_waitcnt lgkmcnt(0)" ::: "memory"); __builtin_amdgcn_s_barrier(); asm volatile("" ::: "memory");
        if ((int)threadIdx.x < nrows) { const f32x4 v = *(const LAS f32x4*)(red + threadIdx.x * 4); ST4(part, ((unsigned)(pm * 256 + threadIdx.x) * 4 + pn) * 4u, __builtin_bit_cast(unsigned, (v.x + v.y) + (v.z + v.w))); }
    }
};
struct EpiU : EpiBase<EpiU> {
    rsrc_t ub; const float* part; float* psp; float* pss;
    __device__ __forceinline__ float pre_row(f32x4 (&)[2], f32x4 (&)[2], int row, int, int, int) const { return rstd_of(part, row); }
    __device__ __forceinline__ void row_op(const f32x4 (&v)[2][2], int row, int pn, int wc, int fq, int, float rs) const {
        const int col0 = pn * 256 + wc * 32 + 8 * fq;
        float* po = nullptr;
        if (row >= S - 15 && row < S) po = psp + (size_t)(row - (S - 15)) * D; else if (row >= S && row < MV) po = pss + ((size_t)(row - S) * 15 + 14) * D;
#pragma unroll
        for (int bj = 0; bj < 2; ++bj) {
            const f32x4 v0 = v[bj][0] * rs, v1 = v[bj][1] * rs;
            ST16(ub, ((unsigned)row * D + col0 + bj * 128) * 2u, pack8(v0, v1));
            if (po) { *(f32x4*)(po + col0 + bj * 128) = v0; *(f32x4*)(po + col0 + bj * 128 + 4) = v1; }
        }
    }
};
struct EpiPlain : EpiBase<EpiPlain> {
    rsrc_t o;
    __device__ __forceinline__ float pre_row(f32x4 (&)[2], f32x4 (&)[2], int, int, int, int) const { return 0.f; }
    __device__ __forceinline__ void row_op(const f32x4 (&v)[2][2], int row, int pn, int wc, int fq, int, float) const {
        const int col0 = pn * 256 + wc * 32 + 8 * fq;
#pragma unroll
        for (int bj = 0; bj < 2; ++bj) ST16(o, ((unsigned)row * D + col0 + bj * 128) * 2u, pack8(v[bj][0], v[bj][1]));
    }
};
struct EpiQK : EpiBase<EpiQK> {
    rsrc_t qk; const float* part; float* out; rsrc_t vnew;
    __device__ __forceinline__ float pre_row(f32x4 (&)[2], f32x4 (&)[2], int row, int, int, int) const { return rstd_of(part, row); }
    __device__ __forceinline__ void row_op(const f32x4 (&v)[2][2], int row, int pn, int wc, int fq, int, float rs) const {
        const int colt = pn * 256, cw = wc * 32 + 8 * fq;
        const bool isv = colt >= 3072;
        const int g = isv ? (colt - 3072) / 512 : colt / 1024, s = isv ? 2 : (colt % 1024) / 512;
        const int W = 128 << (2 * g);
        const size_t gb = kv_group_base(g);
        const size_t o_p = gb, o_s = gb + 2 * (size_t)W * 512 + (isv ? (size_t)NS * W * 512 : 0);
        float* po = nullptr;
        if (s != 0) { if (row >= S - W && row < S) po = out + o_p + (size_t)(row - (S - W)) * 512; else if (row >= S && row < MV) po = out + o_s + ((size_t)(row - S) * W + (W - 1)) * 512; }
#pragma unroll
        for (int bj = 0; bj < 2; ++bj) {
            const f32x4 v0 = v[bj][0] * rs, v1 = v[bj][1] * rs;
            if (!isv) ST16(qk, ((unsigned)row * 3072 + colt + cw + bj * 128) * 2u, pack8(v0, v1));
            else ST16(vnew, ((unsigned)(row - S) * 1536 + (colt - 3072) + cw + bj * 128) * 2u, pack8(v0, v1));
            if (po) { const int he = (colt + cw + bj * 128) % 512; *(f32x4*)(po + he) = v0; *(f32x4*)(po + he + 4) = v1; }
        }
    }
};
struct EpiVT {
    rsrc_t vTg; const float* part; float* out; int g, d;
    __device__ __forceinline__ void operator()(f32x4 (&acc)[2][2][4][2], const Unit& u, int wr, int wc, int fr, int fq) const {
        const int dim0 = u.pm * 256 + wr * 64 + fr;
        const int W = 128 << (2 * g), q = 256 / d;
        const size_t o_p = kv_group_base(g) + (size_t)W * 512;
        const bool tail = (u.pn * 256 + 255 >= S - W);
        float rsa[2][8];
#pragma unroll
        for (int bj = 0; bj < 2; ++bj) { const int v0 = 128 * bj + 32 * wc + 8 * fq, r = v0 / q, ii0 = v0 % q, tok0 = u.pn * 256 + ii0 * d + r;
#pragma unroll
            for (int e = 0; e < 8; ++e) rsa[bj][e] = rstd_of(part, tok0 + e * d);
            __builtin_amdgcn_sched_barrier(0); }
#pragma unroll
        for (int bj = 0; bj < 2; ++bj) {
            const int v0 = 128 * bj + 32 * wc + 8 * fq, r = v0 / q, ii0 = v0 % q;
            const int tok0 = u.pn * 256 + ii0 * d + r;
            float rs[8];
#pragma unroll
            for (int e = 0; e < 8; ++e) rs[e] = rsa[bj][e];
            const size_t sidx = (size_t)r * (S / d) + (size_t)(u.pn * 256) / d + ii0;
            const unsigned vp = (unsigned)(((size_t)dim0 * MPV + 128 + sidx) * 2);
#pragma unroll
            for (int ai = 0; ai < 2; ++ai)
#pragma unroll
                for (int m = 0; m < 4; ++m) {
                    const f32x4 a0 = acc[ai][bj][m][0], a1 = acc[ai][bj][m][1];
                    u32x4 w; w.x = cvt_pk_bf16(a0[0] * rs[0], a0[1] * rs[1]); w.y = cvt_pk_bf16(a0[2] * rs[2], a0[3] * rs[3]); w.z = cvt_pk_bf16(a1[0] * rs[4], a1[1] * rs[5]); w.w = cvt_pk_bf16(a1[2] * rs[6], a1[3] * rs[7]);
                    ST16(vTg, vp + (unsigned)(ai * 128 + m * 16) * (unsigned)(MPV * 2), w);
                    asm volatile("" ::: "memory");
                }
            if (tail) {
#pragma unroll
                for (int e = 0; e < 8; ++e) { const int t = tok0 + e * d;
                    if (t >= S - W) { float* po = out + o_p + (size_t)(t - (S - W)) * 512 + dim0;
#pragma unroll
                        for (int ai = 0; ai < 2; ++ai)
#pragma unroll
                            for (int m = 0; m < 4; ++m) po[ai * 128 + m * 16] = acc[ai][bj][m][e >> 2][e & 3] * rs[e]; }
                    asm volatile("" ::: "memory"); }
            }
        }
    }
};

template <class Epi>
__device__ __forceinline__ void skinny_unit(LAS unsigned char* lds, const pg8::Gemm g, int pn, const Epi& E) {
    int tid = threadIdx.x; asm volatile("" : "+v"(tid));
    const int wid = __builtin_amdgcn_readfirstlane(tid >> 6), lane = tid & 63, kh = wid >> 2, wc = wid & 3, fr = lane & 15, fq = lane >> 4;
    const int Kh = g.K / 2;
    const bf16_t* ap = g.A + (size_t)(S + fr) * g.lda + (size_t)pn * g.a_pn + kh * Kh + 8 * fq;
    const bf16_t* bp = g.Bt + (size_t)(pn * 256 + wc * 32 + 8 * (fr >> 2) + (fr & 3)) * g.ldb + kh * Kh + 8 * fq;
    f32x4 acc[2][2][2];
#pragma unroll
    for (int a = 0; a < 2; ++a)
#pragma unroll
        for (int b = 0; b < 2; ++b)
#pragma unroll
            for (int c = 0; c < 2; ++c) acc[a][b][c] = (f32x4){0.f, 0.f, 0.f, 0.f};
#pragma unroll 4
    for (int k0 = 0; k0 < Kh; k0 += 32) {
        bf16x8 af[2], bf[2][2];
#pragma unroll
        for (int m = 0; m < 2; ++m) af[m] = *(const bf16x8*)(ap + (size_t)(16 * m) * g.lda + k0);
#pragma unroll
        for (int bj = 0; bj < 2; ++bj)
#pragma unroll
            for (int n = 0; n < 2; ++n) bf[bj][n] = *(const bf16x8*)(bp + (size_t)(128 * bj + 4 * n) * g.ldb + k0);
#pragma unroll
        for (int bj = 0; bj < 2; ++bj)
#pragma unroll
            for (int m = 0; m < 2; ++m)
#pragma unroll
                for (int n = 0; n < 2; ++n) acc[bj][m][n] = __builtin_amdgcn_mfma_f32_16x16x32_bf16(bf[bj][n], af[m], acc[bj][m][n], 0, 0, 0);
    }
    LAS f32x4* xs = (LAS f32x4*)lds + (wc * 64 + lane) * 8;
    __syncthreads();
    if (kh == 1) {
#pragma unroll
        for (int bj = 0; bj < 2; ++bj)
#pragma unroll
            for (int m = 0; m < 2; ++m)
#pragma unroll
                for (int n = 0; n < 2; ++n) xs[(bj * 2 + m) * 2 + n] = acc[bj][m][n];
    }
    __syncthreads();
    if (kh == 0) {
#pragma unroll
        for (int bj = 0; bj < 2; ++bj)
#pragma unroll
            for (int m = 0; m < 2; ++m)
#pragma unroll
                for (int n = 0; n < 2; ++n) acc[bj][m][n] += xs[(bj * 2 + m) * 2 + n];
    }
    E.small(acc, pn, wc, fr, fq, kh == 0);
}

typedef float f32x16 __attribute__((ext_vector_type(16)));
typedef __bf16 bf16v2 __attribute__((ext_vector_type(2)));
#define MFMA32(a, b, c) __builtin_amdgcn_mfma_f32_32x32x16_bf16((a), (b), (c), 0, 0, 0)
__device__ __forceinline__ unsigned cvt2(float a, float b) { const f32x2 v = {a, b}; return __builtin_bit_cast(unsigned, __builtin_convertvector(v, bf16v2)); }

template <int GI>
__device__ __forceinline__ void attn_job(const bf16_t* qk, const bf16_t* vTg, const LAS float* biasL, bf16_t* act, rsrc_t ob, int h, int r, int i0, int lane) {
    constexpr int d = 1 << (2 * GI), SD = S / d;
    int r16 = lane & 15, g = lane >> 4;
    asm volatile("" : "+v"(r16), "+v"(g));
    bf16x8 qf[2][2];
#pragma unroll
    for (int qt = 0; qt < 2; ++qt) { const bf16_t* qp = qk + (size_t)((i0 + 16 * qt + r16) * d + r) * 3072 + GI * 1024 + h * 64 + 8 * g;
#pragma unroll
        for (int ks = 0; ks < 2; ++ks) qf[qt][ks] = *(const bf16x8*)(qp + 32 * ks); }
    f32x4 st[5][2][2];
    bf16x8 kf[5][2][2];
#pragma unroll
    for (int kb = 0; kb < 5; ++kb)
#pragma unroll
        for (int T = 0; T < 2; ++T) {
            int ik = i0 - 128 + 32 * kb + 8 * (r16 >> 2) + 4 * T + (r16 & 3); ik = ik < 0 ? 0 : ik;
            const bf16_t* kp = qk + (size_t)(ik * d + r) * 3072 + GI * 1024 + 512 + h * 64 + 8 * g;
            kf[kb][T][0] = *(const bf16x8*)kp; kf[kb][T][1] = *(const bf16x8*)(kp + 32);
        }
    __builtin_amdgcn_sched_barrier(0);
#pragma unroll
    for (int kb = 0; kb < 5; ++kb)
#pragma unroll
        for (int T = 0; T < 2; ++T)
#pragma unroll
            for (int qt = 0; qt < 2; ++qt) { f32x4 a = {0.f, 0.f, 0.f, 0.f};
                a = __builtin_amdgcn_mfma_f32_16x16x32_bf16(kf[kb][T][0], qf[qt][0], a, 0, 0, 0); a = __builtin_amdgcn_mfma_f32_16x16x32_bf16(kf[kb][T][1], qf[qt][1], a, 0, 0, 0); st[kb][T][qt] = a; }
    const bf16_t* vbase = vTg + (size_t)(h * 64 + r16) * MPV + 128 + (r * SD + i0 - 128 + 8 * g);
    bf16x8 vf[5][4];
#pragma unroll
    for (int kb = 0; kb < 5; ++kb)
#pragma unroll
        for (int dt = 0; dt < 4; ++dt) vf[kb][dt] = *(const bf16x8*)(vbase + (size_t)dt * 16 * MPV + 32 * kb);
    __builtin_amdgcn_sched_barrier(0);
    float mx[2] = {-1e30f, -1e30f};
    const LAS float* bl = biasL + (r16 - 8 * g);
#pragma unroll
    for (int kb = 0; kb < 5; ++kb)
#pragma unroll
        for (int T = 0; T < 2; ++T)
#pragma unroll
            for (int qt = 0; qt < 2; ++qt)
#pragma unroll
                for (int i = 0; i < 4; ++i) {
                    const int jc0 = 128 - 32 * kb + 16 * qt - 4 * T - i;
                    if (kb >= 1 && kb <= 3) st[kb][T][qt][i] += bl[jc0];
                    else { const int jo = jc0 + r16 - 8 * g; const int jc = jo < 0 ? 0 : (jo > 128 ? 128 : jo); st[kb][T][qt][i] += biasL[jc]; }
                }
    __builtin_amdgcn_sched_barrier(0);
#pragma unroll
    for (int T = 0; T < 2; ++T)
#pragma unroll
        for (int qt = 0; qt < 2; ++qt)
#pragma unroll
            for (int i = 0; i < 4; ++i) {
                const int j0 = 128 + 16 * qt + r16 - 8 * g - 4 * T - i, j4 = j0 - 128;
                st[0][T][qt][i] = (j0 <= 128) ? st[0][T][qt][i] : -1e30f;
                st[4][T][qt][i] = (j4 >= 0) ? st[4][T][qt][i] : -1e30f;
            }
    if (i0 < 128) {
#pragma unroll
        for (int kb = 0; kb < 4; ++kb)
#pragma unroll
            for (int T = 0; T < 2; ++T)
#pragma unroll
                for (int qt = 0; qt < 2; ++qt)
#pragma unroll
                    for (int i = 0; i < 4; ++i) { const int ik = i0 - 128 + 32 * kb + 8 * g + 4 * T + i; st[kb][T][qt][i] = (ik >= 0) ? st[kb][T][qt][i] : -1e30f; }
    }
#pragma unroll
    for (int kb = 0; kb < 5; ++kb)
#pragma unroll
        for (int T = 0; T < 2; ++T)
#pragma unroll
            for (int qt = 0; qt < 2; ++qt)
#pragma unroll
                for (int i = 0; i < 4; ++i) mx[qt] = fmaxf(mx[qt], st[kb][T][qt][i]);
    float sum[2];
#pragma unroll
    for (int qt = 0; qt < 2; ++qt) { mx[qt] = fmaxf(mx[qt], __shfl_xor(mx[qt], 16)); mx[qt] = fmaxf(mx[qt], __shfl_xor(mx[qt], 32)); sum[qt] = 0.f; }
#pragma unroll
    for (int kb = 0; kb < 5; ++kb)
#pragma unroll
        for (int T = 0; T < 2; ++T)
#pragma unroll
            for (int qt = 0; qt < 2; ++qt)
#pragma unroll
                for (int i = 0; i < 4; ++i) { const float p = __builtin_amdgcn_exp2f(st[kb][T][qt][i] - mx[qt]); st[kb][T][qt][i] = p; sum[qt] += p; }
#pragma unroll
    for (int qt = 0; qt < 2; ++qt) { sum[qt] += __shfl_xor(sum[qt], 16); sum[qt] += __shfl_xor(sum[qt], 32); }
    f32x4 oa[4][2];
#pragma unroll
    for (int dt = 0; dt < 4; ++dt)
#pragma unroll
        for (int qt = 0; qt < 2; ++qt) oa[dt][qt] = (f32x4){0.f, 0.f, 0.f, 0.f};
#pragma unroll
    for (int kb = 0; kb < 5; ++kb) {
        bf16x8 pf[2];
#pragma unroll
        for (int qt = 0; qt < 2; ++qt) { u32x4 pw; pw.x = cvt2(st[kb][0][qt][0], st[kb][0][qt][1]); pw.y = cvt2(st[kb][0][qt][2], st[kb][0][qt][3]); pw.z = cvt2(st[kb][1][qt][0], st[kb][1][qt][1]); pw.w = cvt2(st[kb][1][qt][2], st[kb][1][qt][3]);
            pf[qt] = __builtin_bit_cast(bf16x8, pw); }
#pragma unroll
        for (int dt = 0; dt < 4; ++dt)
#pragma unroll
            for (int qt = 0; qt < 2; ++qt) oa[dt][qt] = __builtin_amdgcn_mfma_f32_16x16x32_bf16(vf[kb][dt], pf[qt], oa[dt][qt], 0, 0, 0);
    }
#pragma unroll
    for (int qt = 0; qt < 2; ++qt) {
        const int tq = (i0 + 16 * qt + r16) * d + r;
        const float inv = 1.0f / sum[qt], lse = mx[qt] + __log2f(sum[qt]);
        float* scr = (float*)(act + (size_t)tq * FF);
        bf16_t* scb = act + (size_t)tq * FF;
        if (GI > 0) {
#pragma unroll
            for (int dt = 0; dt < 4; ++dt) { const f32x4 v = oa[dt][qt] * inv; u32x2 w; w.x = cvt2(v[0], v[1]); w.y = cvt2(v[2], v[3]); *(u32x2*)(scb + (GI - 1) * 512 + h * 64 + 16 * dt + 4 * g) = w; }
            if (g == 0) scr[1024 + (GI - 1) * 8 + h] = lse;
        } else {
            const float l1 = scr[1024 + h], l2 = scr[1024 + 8 + h];
            f32x4 o1[4], o2[4];
#pragma unroll
            for (int dt = 0; dt < 4; ++dt) { const int dim0 = h * 64 + 16 * dt + 4 * g; const u32x2 p1 = *(const u32x2*)(scb + dim0), p2 = *(const u32x2*)(scb + 512 + dim0);
                o1[dt] = (f32x4){bflo(p1.x), bfhi(p1.x), bflo(p1.y), bfhi(p1.y)}; o2[dt] = (f32x4){bflo(p2.x), bfhi(p2.x), bflo(p2.y), bfhi(p2.y)}; }
            const float mm = fmaxf(fmaxf(lse, l1), l2);
            const float w0 = __builtin_amdgcn_exp2f(lse - mm), w1 = __builtin_amdgcn_exp2f(l1 - mm), w2 = __builtin_amdgcn_exp2f(l2 - mm), iw = 1.0f / (w0 + w1 + w2);
            const float a0 = w0 * inv * iw, a1 = w1 * iw, a2 = w2 * iw;
#pragma unroll
            for (int dt = 0; dt < 4; ++dt) { const int dim0 = h * 64 + 16 * dt + 4 * g; const f32x4 v = oa[dt][qt] * a0 + o1[dt] * a1 + o2[dt] * a2;
                u32x2 w; w.x = cvt2(v[0], v[1]); w.y = cvt2(v[2], v[3]);
                ST8(ob, ((unsigned)tq * 512 + dim0) * 2u, w); }
        }
    }
}
__device__ __forceinline__ float wave_sum(float v) {
#pragma unroll
    for (int o = 1; o < 64; o <<= 1) v += __shfl_xor(v, o);
    return v;
}
__device__ __forceinline__ float wave_max(float v) {
#pragma unroll
    for (int o = 1; o < 64; o <<= 1) v = fmaxf(v, __shfl_xor(v, o));
    return v;
}
__device__ __forceinline__ void sample_attn_group(int g, int b, int h, const bf16_t* qk, const bf16_t* vnew, const float* ck, const float* cv, const float* biasT, LAS float* smp, int lane) {
    const int d = 1 << (2 * g), W = 128 << (2 * g), row = S + b, kq = lane >> 3, dc = lane & 7;
    float q[64];
    { const u32x4* qp = (const u32x4*)(qk + (size_t)row * 3072 + g * 1024 + h * 64);
#pragma unroll
      for (int c = 0; c < 8; ++c) { const u32x4 t = qp[c]; q[8 * c] = bflo(t.x); q[8 * c + 1] = bfhi(t.x); q[8 * c + 2] = bflo(t.y); q[8 * c + 3] = bfhi(t.y); q[8 * c + 4] = bflo(t.z); q[8 * c + 5] = bfhi(t.z); q[8 * c + 6] = bflo(t.w); q[8 * c + 7] = bfhi(t.w); } }
    float sc[3];
#pragma unroll
    for (int rnd = 0; rnd < 3; ++rnd) {
        const int j = lane + 64 * rnd; float s = -1e30f;
        if (j <= 128) { float a = 0.f;
            if (j == 0) { const u32x4* kp = (const u32x4*)(qk + (size_t)row * 3072 + g * 1024 + 512 + h * 64);
#pragma unroll
                for (int c = 0; c < 8; ++c) { const u32x4 t = kp[c]; a += q[8 * c] * bflo(t.x) + q[8 * c + 1] * bfhi(t.x) + q[8 * c + 2] * bflo(t.y) + q[8 * c + 3] * bfhi(t.y) + q[8 * c + 4] * bflo(t.z) + q[8 * c + 5] * bfhi(t.z) + q[8 * c + 6] * bflo(t.w) + q[8 * c + 7] * bfhi(t.w); } }
            else { const f32x4* kp = (const f32x4*)(ck + (((size_t)b * W + (W - j * d)) * 8 + h) * 64);
#pragma unroll
                for (int c = 0; c < 16; ++c) { const f32x4 t = __builtin_nontemporal_load(kp + c); a += q[4 * c] * t.x + q[4 * c + 1] * t.y + q[4 * c + 2] * t.z + q[4 * c + 3] * t.w; } }
            s = a + biasT[(g * 8 + h) * 132 + j]; }
        sc[rnd] = s;
    }
    const float mx = wave_max(fmaxf(fmaxf(sc[0], sc[1]), sc[2]));
    float p[3]; float sum = 0.f;
#pragma unroll
    for (int rnd = 0; rnd < 3; ++rnd) { p[rnd] = (sc[rnd] > -1e29f) ? __builtin_amdgcn_exp2f(sc[rnd] - mx) : 0.f; sum += p[rnd]; }
    sum = wave_sum(sum);
    const float inv = 1.0f / sum;
    float o[8] = {0.f, 0.f, 0.f, 0.f, 0.f, 0.f, 0.f, 0.f};
#pragma unroll
    for (int i = 0; i < 17; ++i) {
        const int j = kq + 8 * i, src = j & 63, rnd = j >> 6;
        const float p0 = __shfl(p[0], src), p1 = __shfl(p[1], src), p2 = __shfl(p[2], src);
        const float pj = (rnd == 0) ? p0 : ((rnd == 1) ? p1 : p2);
        if (j <= 128) {
            if (j == 0) { const u32x4 t = *(const u32x4*)(vnew + (size_t)b * 1536 + g * 512 + h * 64 + 8 * dc);
                o[0] += pj * bflo(t.x); o[1] += pj * bfhi(t.x); o[2] += pj * bflo(t.y); o[3] += pj * bfhi(t.y); o[4] += pj * bflo(t.z); o[5] += pj * bfhi(t.z); o[6] += pj * bflo(t.w); o[7] += pj * bfhi(t.w); }
            else { const f32x4* vp = (const f32x4*)(cv + (((size_t)b * W + (W - j * d)) * 8 + h) * 64 + 8 * dc); const f32x4 t0 = __builtin_nontemporal_load(vp), t1 = __builtin_nontemporal_load(vp + 1);
                o[0] += pj * t0.x; o[1] += pj * t0.y; o[2] += pj * t0.z; o[3] += pj * t0.w; o[4] += pj * t1.x; o[5] += pj * t1.y; o[6] += pj * t1.z; o[7] += pj * t1.w; }
        }
    }
#pragma unroll
    for (int e = 0; e < 8; ++e) { float v = o[e]; v += __shfl_xor(v, 8); v += __shfl_xor(v, 16); v += __shfl_xor(v, 32); if (kq == 0) smp[g * 72 + 8 * dc + e] = v * inv; }
    if (lane == 0) smp[g * 72 + 64] = mx + __log2f(sum);
}

template <int W>
__device__ __forceinline__ void pool_strip(const bf16_t* ub, const float* state_pool, rsrc_t rs_z, int r0, int ch) {
    if (r0 < S) {
        u32x4 raw[16 + W - 1];
#pragma unroll
        for (int i = 0; i < 16 + W - 1; ++i) { const int row = r0 - (W - 1) + i; raw[i] = (row >= 0) ? *(const u32x4*)(ub + (size_t)row * D + ch) : (u32x4){0u, 0u, 0u, 0u}; }
        float run[8] = {0.f, 0.f, 0.f, 0.f, 0.f, 0.f, 0.f, 0.f};
#pragma unroll
        for (int i = 0; i < W - 1; ++i) { run[0] += bflo(raw[i].x); run[1] += bfhi(raw[i].x); run[2] += bflo(raw[i].y); run[3] += bfhi(raw[i].y); run[4] += bflo(raw[i].z); run[5] += bfhi(raw[i].z); run[6] += bflo(raw[i].w); run[7] += bfhi(raw[i].w); }
#pragma unroll
        for (int i = 0; i < 16; ++i) {
            const u32x4 c = raw[i + W - 1]; const float cv[8] = {bflo(c.x), bfhi(c.x), bflo(c.y), bfhi(c.y), bflo(c.z), bfhi(c.z), bflo(c.w), bfhi(c.w)};
#pragma unroll
            for (int e = 0; e < 8; ++e) run[e] += cv[e];
            const int row = r0 + i; const float ic = 1.0f / (float)(W < row + 1 ? W : row + 1);
            u32x4 o; o.x = pk2(run[0] * ic - cv[0], run[1] * ic - cv[1]); o.y = pk2(run[2] * ic - cv[2], run[3] * ic - cv[3]); o.z = pk2(run[4] * ic - cv[4], run[5] * ic - cv[5]); o.w = pk2(run[6] * ic - cv[6], run[7] * ic - cv[7]);
            ST16(rs_z, ((unsigned)row * D + ch) * 2u, o);
            const u32x4 l = raw[i];
            run[0] -= bflo(l.x); run[1] -= bfhi(l.x); run[2] -= bflo(l.y); run[3] -= bfhi(l.y); run[4] -= bflo(l.z); run[5] -= bfhi(l.z); run[6] -= bflo(l.w); run[7] -= bfhi(l.w);
        }
    } else {
#pragma nounroll
        for (int i = 0; i < 16; ++i) {
            const int row = r0 + i; u32x4 o = {0u, 0u, 0u, 0u};
            if (row < MV) {
                const u32x4 c = *(const u32x4*)(ub + (size_t)row * D + ch); const float cv[8] = {bflo(c.x), bfhi(c.x), bflo(c.y), bfhi(c.y), bflo(c.z), bfhi(c.z), bflo(c.w), bfhi(c.w)};
                float a[8];
#pragma unroll
                for (int e = 0; e < 8; ++e) a[e] = cv[e];
                const float* sp = state_pool + (size_t)(row - S) * 15 * D + ch;
#pragma unroll
                for (int k = 1; k < W; ++k) { const f32x4 p0 = *(const f32x4*)(sp + (size_t)(15 - k) * D), p1 = *(const f32x4*)(sp + (size_t)(15 - k) * D + 4);
                    a[0] += p0.x; a[1] += p0.y; a[2] += p0.z; a[3] += p0.w; a[4] += p1.x; a[5] += p1.y; a[6] += p1.z; a[7] += p1.w; }
                const float ic = 1.0f / (float)W;
                o.x = pk2(a[0] * ic - cv[0], a[1] * ic - cv[1]); o.y = pk2(a[2] * ic - cv[2], a[3] * ic - cv[3]); o.z = pk2(a[4] * ic - cv[4], a[5] * ic - cv[5]); o.w = pk2(a[6] * ic - cv[6], a[7] * ic - cv[7]);
            }
            ST16(rs_z, ((unsigned)row * D + ch) * 2u, o);
        }
    }
}

struct Args { const float* in[26]; float* out; unsigned char* ws; };
enum { PH_GU0 = 0, PH_D0, PH_WIN, PH_POOL, PH_GRP, PH_WPO, PH_GU1, PH_D1, PH_GU2, PH_D2, PH_QKV, PH_ATT, PH_WAO, PH_GU3, PH_D3, NPHC };

constexpr int NWAVES = 8, NTHR = 512;
constexpr int LDS_BYTES = 147456;

__device__ __forceinline__ void tr_item(const float* W, int ldw, int k0, int n0, bf16_t* dst, int ldd, const float* kscale, const float* nscale, float f, LAS float* scr, int lane) {
    const rsrc_t rs = mkrs(dst, (size_t)1 << 30);
    float tv[32];
#pragma unroll
    for (int i = 0; i < 32; ++i) { const int kk = 2 * i + (lane >> 5); tv[i] = __builtin_nontemporal_load(W + (size_t)(k0 + kk) * ldw + n0 + (lane & 31)); }
#pragma unroll
    for (int i = 0; i < 32; ++i) { const int kk = 2 * i + (lane >> 5); float v = tv[i]; if (kscale) v *= kscale[k0 + kk]; scr[kk * 33 + (lane & 31)] = v; }
    LDS_WAIT(); asm volatile("" ::: "memory");
    const int c = lane & 7;
#pragma unroll
    for (int j = 0; j < 4; ++j) { const int n = (lane >> 3) + 8 * j; const LAS float* s = scr + (8 * c) * 33 + n; const float fn = nscale ? f * nscale[n0 + n] : f;
        u32x4 o; o.x = pk2(s[0 * 33] * fn, s[1 * 33] * fn); o.y = pk2(s[2 * 33] * fn, s[3 * 33] * fn); o.z = pk2(s[4 * 33] * fn, s[5 * 33] * fn); o.w = pk2(s[6 * 33] * fn, s[7 * 33] * fn);
        ST16(rs, (unsigned)(n * ldd + k0 + 8 * c) * 2u, o); }
    LDS_WAIT(); asm volatile("" ::: "memory");
}
__device__ __forceinline__ int t5_bucket(int dist) {
    if (dist < 16) return dist;
    const int b = 16 + (int)(log((double)dist / 16.0) / log(128.0) * 16.0);
    return b < 31 ? b : 31;
}

#ifndef PM
#define PM 0xffffff
#endif
#define ON(k) if ((PM >> (k)) & 1)
__global__ void __launch_bounds__(NTHR, 2) fwd_kernel(Args args) {
    extern __shared__ __attribute__((aligned(16))) unsigned char lds_raw[];
    LAS unsigned char* lds = (LAS unsigned char*)lds_raw;
    const int tid = threadIdx.x, lane = tid & 63, wave = __builtin_amdgcn_readfirstlane(tid >> 6);
    const int G = gridDim.x, bx = blockIdx.x;
    const int gw = bx * NWAVES + wave, NGW = G * NWAVES;
    const size_t gt = (size_t)bx * NTHR + tid, NGT = (size_t)G * NTHR;
    unsigned char* ws = args.ws; float* out = args.out;
    bf16_t* Wgu = (bf16_t*)(ws + WS_WGU); bf16_t* Wd = (bf16_t*)(ws + WS_WD); bf16_t* Win = (bf16_t*)(ws + WS_WIN); bf16_t* Wgrp = (bf16_t*)(ws + WS_WGRP);
    bf16_t* Wpo = (bf16_t*)(ws + WS_WPO); bf16_t* Wqkv = (bf16_t*)(ws + WS_WQKV); bf16_t* Wao = (bf16_t*)(ws + WS_WAO);
    float* biasT = (float*)(ws + WS_BIAS); float* part = (float*)(ws + WS_PART);
    bf16_t* xb = (bf16_t*)(ws + WS_XB); bf16_t* act = (bf16_t*)(ws + WS_ACT);
    bf16_t* ub = (bf16_t*)(ws + WS_U); bf16_t* zb = (bf16_t*)(ws + WS_Z); bf16_t* z2b = (bf16_t*)(ws + WS_Z2); bf16_t* qk = (bf16_t*)(ws + WS_QK); bf16_t* vT = (bf16_t*)(ws + WS_VT); bf16_t* ob = (bf16_t*)(ws + WS_O); bf16_t* vnew = (bf16_t*)(ws + WS_VNEW);
    const float* x_prompt = args.in[0]; const float* x_sample = args.in[1]; const float* state_pool = args.in[2];
    cg::grid_group grid = cg::this_grid();
    unsigned* ctl = (unsigned*)(ws + WS_CTL);
#define CNT(ph) (ctl + (size_t)(ph) * 72 * 64)
    constexpr size_t QOFF = (size_t)NPHC * 72 * 64 + 1024, QWORDS = (size_t)48 * 8 * 64;

    constexpr int I_GU = 16 * 88, I_D = 44 * 32, I_IN = 16 * 32, I_GRP = 4 * 8, I_QKV = 16 * 144, I_AO = 8 * 32;
#define TR_SCR ((LAS float*)(lds + wave * 16384))
#define CV_FOR(q, OFF_, CNT_) for (int q = gw - (OFF_) + (gw < (OFF_) ? NGW : 0); q < (CNT_); q += NGW)
#define CV_GU(f_, OFF_) CV_FOR(q2, OFF_, 2 * I_GU) { const int f = (f_), up = q2 / I_GU, q = q2 % I_GU, kb = q / 88, nb = q % 88, n0 = nb * 32, layer = f >> 1, second = f & 1; \
        tr_item(args.in[(second ? 22 : 10) + up] + (size_t)layer * D * FF, FF, kb * 64, n0, Wgu + (size_t)f * 2 * FF * D + (size_t)((n0 / 128) * 256 + (n0 % 128) + up * 128) * D, D, \
                args.in[second ? 21 : 9] + layer * D, nullptr, 1.0f, TR_SCR, lane_c); }
#define CV_D(f_, OFF_) CV_FOR(q, OFF_, I_D) { const int f = (f_), kb = q / 32, nb = q % 32, layer = f >> 1, second = f & 1; \
        tr_item(args.in[(second ? 22 : 10) + 2] + (size_t)layer * FF * D, D, kb * 64, nb * 32, Wd + (size_t)f * D * FF + (size_t)(nb * 32) * FF, FF, nullptr, nullptr, 0.5f, TR_SCR, lane_c); }
#define CV_IN(OFF_) CV_FOR(q, OFF_, I_IN) { const int kb = q / 32, nb = q % 32; tr_item(args.in[14], D, kb * 64, nb * 32, Win + (size_t)(nb * 32) * D, D, args.in[13], nullptr, 1.0f, TR_SCR, lane_c); }
#define CV_GRP(OFF_) CV_FOR(q2, OFF_, 4 * I_GRP) { const int gq = q2 / I_GRP, q = q2 % I_GRP, kb = q / 8, nb = q % 8; \
        tr_item(args.in[15] + (size_t)gq * 256 * 256, 256, kb * 64, nb * 32, Wgrp + (size_t)(gq * 256 + nb * 32) * 256, 256, nullptr, args.in[16] + gq * 256, 1.0f, TR_SCR, lane_c); }
#define CV_PO(OFF_) CV_FOR(q, OFF_, I_IN) { const int kb = q / 32, nb = q % 32; tr_item(args.in[17], D, kb * 64, nb * 32, Wpo + (size_t)(nb * 32) * D, D, nullptr, nullptr, 1.0f, TR_SCR, lane_c); }
#define CV_QKV(OFF_) CV_FOR(q, OFF_, I_QKV) { const int kb = q / 144, nb = q % 144, n0 = nb * 32; const float fs = ((n0 % 1536) < 512) ? 0.125f * 1.4426950408889634f : 1.0f; \
        const int gg = n0 / 1536, ss = (n0 % 1536) / 512, he = n0 % 512; const int drow = ss < 2 ? gg * 1024 + ss * 512 + he : 3072 + gg * 512 + he; \
        tr_item(args.in[18], QKVW, kb * 64, n0, Wqkv + (size_t)drow * D, D, args.in[13] + D, nullptr, fs, TR_SCR, lane_c); }
#define CV_AO(OFF_) CV_FOR(q, OFF_, I_AO) { const int kb = q / 32, nb = q % 32; tr_item(args.in[19], D, kb * 64, nb * 32, Wao + (size_t)(nb * 32) * 512, 512, nullptr, nullptr, 1.0f, TR_SCR, lane_c); }
#define WC(c) (ctl + (size_t)NPHC * 72 * 64 + (size_t)(c) * 64)
#define CONV_POINT(c, BODY) do { int lane_c = threadIdx.x; asm volatile("" : "+v"(lane_c)); lane_c &= 63; BODY VM_WAIT(); if (lane_c == 0) __hip_atomic_fetch_add(WC(c), 1u, RLX_AGENT); __syncthreads(); } while (0)
    ON(0) {
        LAS float* scr = (LAS float*)(lds + wave * 16384);
        { const int lane_c = lane; CV_GU(0, 0) CV_D(0, 768) }
        for (int row = gw; row < MP; row += NGW) {
            f32x4 v[4]; float s = 0.f;
            if (row < MV) { const f32x4* xr = (const f32x4*)(row < S ? x_prompt + (size_t)row * D : x_sample + (size_t)(row - S) * D) + lane;
#pragma unroll
                for (int j = 0; j < 4; ++j) { v[j] = __builtin_nontemporal_load(xr + 64 * j); s += (v[j].x * v[j].x + v[j].y * v[j].y) + (v[j].z * v[j].z + v[j].w * v[j].w); } }
            else {
#pragma unroll
                for (int j = 0; j < 4; ++j) v[j] = (f32x4){0.f, 0.f, 0.f, 0.f}; }
            s = wave_sum(s);
            u32x2* o8 = (u32x2*)(xb + (size_t)row * D) + lane;
#pragma unroll
            for (int j = 0; j < 4; ++j) { u32x2 w; w.x = pk2(v[j].x, v[j].y); w.y = pk2(v[j].z, v[j].w); o8[64 * j] = w; }
            if (lane < 4) part[(size_t)row * 4 + lane] = (lane == 0) ? s : 0.f;
        }
        for (size_t i = gt; i < 3 * 8 * 132; i += NGT) { const int j = (int)(i % 132), gh = (int)(i / 132), g = gh / 8, h = gh % 8;
            biasT[i] = (j <= 128) ? 1.4426950408889634f * args.in[20][t5_bucket(j * (1 << (2 * g))) * 24 + g * 8 + h] : 0.f; }
        for (size_t i = gt; i < (size_t)NS * 14 * (D / 4); i += NGT) { const size_t b = i / (14 * (D / 4)), rem = i % (14 * (D / 4));
            ((f32x4*)(out + O_PSS + b * 15 * D))[rem] = ((const f32x4*)(state_pool + b * 15 * D + D))[rem]; }
        for (size_t i = gt; i < QOFF + QWORDS; i += NGT) ctl[i] = 0u;
        for (size_t i = gt; i < (size_t)(MP - MV) * 64; i += NGT) ((u32x4*)(ob + (size_t)MV * 512))[i] = (u32x4){0u, 0u, 0u, 0u};
    }
    grid.sync();

    const int xcd = bx % 8;
    unsigned* qbase = ctl + QOFF; int qi = 0; int sk_id = 0; LAS unsigned* qslot = (LAS unsigned*)(lds + 131072 + 4096);
    RsCache rcache{-1, -1};
    CopyJob cjob{args.in, out, bx};
    const rsrc_t rs_act = mkrs(act, (size_t)MP * FF * 2), rs_xb = mkrs(xb, (size_t)MP * D * 2), rs_part = mkrs(part, (size_t)MP * 16);
    LAS float* red = (LAS float*)(lds + 131072);
    const unsigned* wdep_next = nullptr;
#define FLOW_GEMM(EPI_T, EPI_INIT, Aptr, LDA_, Bptr, LDB_, K_, NM_, NN_, APN_, BSIG_, DEP_, NEED_, DEPPN_, DEPSH_, PUB_, PUBPN_) do { \
        pg8::Gemm g{(const bf16_t*)(Aptr), (const bf16_t*)(Bptr), (LDA_), (LDB_), (K_), (APN_), (BSIG_)}; pg8::FlowOrder So; So.init((NM_), (NN_), 2, xcd, qbase, qi, qslot); \
        So.dep = (DEP_); So.need = (NEED_); So.need64 = (NEED_); So.dep_pn = (DEPPN_); So.dep_shift = (DEPSH_); So.pub = (PUB_); So.pub_pn = (PUBPN_); So.wdep = wdep_next; So.wneed = (unsigned)NGW; wdep_next = nullptr; \
        EPI_T E EPI_INIT; pg8::gemm_phase<EPI_T, pg8::FlowOrder>(lds, g, So, E); } while (0)
#define SKINNY(EPI_T, EPI_INIT, Aptr, LDA_, Bptr, LDB_, K_, NN_, APN_, DEP_, NEED_, PUB_) do { \
        const pg8::Gemm g{(const bf16_t*)(Aptr), (const bf16_t*)(Bptr), (LDA_), (LDB_), (K_), (APN_), 1}; \
        ++sk_id; \
        for (int j = 0; j < (NN_); ++j) if ((sk_id * 29 + j * 13 + 7) % G == bx) {        \
            EPI_T E EPI_INIT; const unsigned* dp = (DEP_); \
            if (dp) { if (tid < 64) { flow_poll1(dp + (size_t)64 * 64, (NEED_)); __builtin_amdgcn_fence(__ATOMIC_ACQUIRE, "agent"); VM_WAIT(); } } \
            __syncthreads(); skinny_unit<EPI_T>(lds, g, j, E); flow_publish((PUB_) + (size_t)64 * 64); __syncthreads(); } \
        } while (0)
#define SKINNY_Q(EPI_T, EPI_INIT, Aptr, LDA_, Bptr, LDB_, K_, NN_, APN_, DEP_, NEED_, PUB_) do { \
        const pg8::Gemm g{(const bf16_t*)(Aptr), (const bf16_t*)(Bptr), (LDA_), (LDB_), (K_), (APN_), 1}; pg8::FlowOrder So; So.init(1, (NN_), 1, xcd, qbase, qi, qslot); \
        EPI_T E EPI_INIT; Unit u; \
        while (So.next_blocking(u)) { const unsigned* dp = (DEP_); \
            if (dp) { if (tid < 64) { flow_poll1(dp + (size_t)64 * 64, (NEED_)); __builtin_amdgcn_fence(__ATOMIC_ACQUIRE, "agent"); VM_WAIT(); } } \
            __syncthreads(); skinny_unit<EPI_T>(lds, g, u.pn, E); flow_publish((PUB_) + (size_t)64 * 64); } \
        __syncthreads(); } while (0)
#define GU_PHASE(f, DEP_, PH_) do { rcache.t0 = -1; rcache.t1 = -1; FLOW_GEMM(EpiGU, ({{}, rs_act, part, &cjob, &rcache, red}), xb, D, Wgu + (size_t)(f) * 2 * FF * D, D, D, 64, 22, 0, 1, DEP_, 32u, 0, 0, CNT(PH_), 0); \
        SKINNY(EpiGU, ({{}, rs_act, part, &cjob, &rcache, red}), xb, D, Wgu + (size_t)(f) * 2 * FF * D, D, D, 22, 0, DEP_, 32u, CNT(PH_)); } while (0)
#define DN_PHASE(LAST_, RSXO_, f, DEP_, PH_) do { FLOW_GEMM(EpiRes<LAST_>, ({{}, xb, RSXO_, rs_xb, rs_part, red}), act, FF, Wd + (size_t)(f) * D * FF, FF, FF, 64, 4, 0, 1, DEP_, 176u, 0, 0, CNT(PH_), 0); \
        SKINNY(EpiRes<LAST_>, ({{}, xb, RSXO_, rs_xb, rs_part, red}), act, FF, Wd + (size_t)(f) * D * FF, FF, FF, 4, 0, DEP_, 176u, CNT(PH_)); } while (0)

#ifndef PM
#define PM 0xffffff
#endif
    ON(1) GU_PHASE(0, nullptr, PH_GU0);
    CONV_POINT(1, CV_IN(0) CV_GRP(512) CV_PO(640));
    ON(2) DN_PHASE(false, rs_xb, 0, CNT(PH_GU0), PH_D0);
    CONV_POINT(2, CV_GU(1, 0));
    wdep_next = WC(1);
    ON(3) { FLOW_GEMM(EpiU, ({{}, mkrs(ub, (size_t)MP * D * 2), part, out + O_PSP, out + O_PSS}), xb, D, Win, D, D, 64, 4, 0, 1, CNT(PH_D0), 32u, 0, 0, CNT(PH_WIN), 0);
            SKINNY(EpiU, ({{}, mkrs(ub, (size_t)MP * D * 2), part, out + O_PSP, out + O_PSS}), xb, D, Win, D, D, 4, 0, CNT(PH_D0), 32u, CNT(PH_WIN)); }
    ON(4)
    for (int sm = 0; sm < 2; ++sm) {
        pg8::FlowOrder So; So.init(sm ? 1 : 64, 4, sm ? 1 : 2, xcd, qbase, qi, qslot);
        const rsrc_t rs_z = mkrs(zb, (size_t)MP * D * 2);
        Unit u;
        while (So.next_blocking(u)) {
            const int pm = sm ? 64 : u.pm;
            if (tid < 64) { flow_poll1(CNT(PH_WIN) + (size_t)pm * 64, 32u); if (pm > 0 && pm < 64) flow_poll1(CNT(PH_WIN) + (size_t)(pm - 1) * 64, 32u);
                __builtin_amdgcn_fence(__ATOMIC_ACQUIRE, "agent"); VM_WAIT(); }
            __syncthreads();
            {
                const int chunk = tid & 31, strip = tid >> 5, ch = u.pn * 256 + chunk * 8, r0 = pm * 256 + strip * 16;
                if (u.pn == 0) pool_strip<2>(ub, state_pool, rs_z, r0, ch);
                else if (u.pn == 1) pool_strip<4>(ub, state_pool, rs_z, r0, ch);
                else if (u.pn == 2) pool_strip<8>(ub, state_pool, rs_z, r0, ch);
                else pool_strip<16>(ub, state_pool, rs_z, r0, ch);
            }
            flow_publish(CNT(PH_POOL) + (size_t)pm * 64);
        }
    }
    CONV_POINT(3, CV_D(1, 0));
    wdep_next = WC(1);
    ON(5) { FLOW_GEMM(EpiPlain, ({{}, mkrs(z2b, (size_t)MP * D * 2)}), zb, D, Wgrp, 256, 256, 64, 4, 256, 1, CNT(PH_POOL), 32u, 0, 0, CNT(PH_GRP), 0);
            SKINNY(EpiPlain, ({{}, mkrs(z2b, (size_t)MP * D * 2)}), zb, D, Wgrp, 256, 256, 4, 256, CNT(PH_POOL), 32u, CNT(PH_GRP)); }
    wdep_next = WC(1);
    ON(6) { FLOW_GEMM(EpiRes<false>, ({{}, xb, rs_xb, rs_xb, rs_part, red}), z2b, D, Wpo, D, D, 64, 4, 0, 1, CNT(PH_GRP), 32u, 0, 0, CNT(PH_WPO), 0);
            SKINNY(EpiRes<false>, ({{}, xb, rs_xb, rs_xb, rs_part, red}), z2b, D, Wpo, D, D, 4, 0, CNT(PH_GRP), 32u, CNT(PH_WPO)); }
    CONV_POINT(4, CV_GU(2, 0));
    wdep_next = WC(2);
    ON(7) GU_PHASE(1, CNT(PH_WPO), PH_GU1);
    CONV_POINT(5, CV_D(2, 0));
    wdep_next = WC(3);
    ON(8) DN_PHASE(false, rs_xb, 1, CNT(PH_GU1), PH_D1);
    CONV_POINT(6, CV_QKV(0));
    wdep_next = WC(4);
    ON(9) GU_PHASE(2, CNT(PH_D1), PH_GU2);
    CONV_POINT(7, CV_AO(0) CV_GU(3, 256));
    wdep_next = WC(5);
    ON(10) DN_PHASE(false, rs_xb, 2, CNT(PH_GU2), PH_D2);
    CONV_POINT(8, CV_D(3, 0));
    wdep_next = WC(6);
    ON(11) { FLOW_GEMM(EpiQK, ({{}, mkrs(qk, (size_t)MP * 3072 * 2), part, out, mkrs(vnew, (size_t)NS * 1536 * 2)}), xb, D, Wqkv, D, D, 64, 12, 0, 1, CNT(PH_D2), 32u, 0, 0, CNT(PH_QKV), 0);
             SKINNY(EpiQK, ({{}, mkrs(qk, (size_t)MP * 3072 * 2), part, out, mkrs(vnew, (size_t)NS * 1536 * 2)}), xb, D, Wqkv, D, D, 18, 0, CNT(PH_D2), 32u, CNT(PH_QKV)); }
    ON(12)
#pragma unroll
    for (int gi = 0; gi < 3; ++gi)
        FLOW_GEMM(EpiVT, ({mkrs(vT + (size_t)gi * 512 * MPV, (size_t)512 * MPV * 2), part, out, gi, 1 << (2 * gi)}), Wqkv + (size_t)(3072 + gi * 512) * D, D, xb, D, D, 2, 64, 0, 1 << (2 * gi), CNT(PH_D2), 32u, 1, 0, CNT(PH_QKV), 1);
    ON(13) {
        LAS float* biasL = (LAS float*)lds;
        LAS float* smp = (LAS float*)(lds + 2048);
        const rsrc_t rs_o = mkrs(ob, (size_t)MP * 512 * 2);
        pg8::FlowOrder So; So.init(32, 8, 1, xcd, qbase, qi, qslot);
        Unit u;
        while (So.next_blocking(u)) {
            const int sp = u.pm, h = u.pn;
            if (tid < 64) { const int p0 = 2 * sp - 8 < 0 ? 0 : 2 * sp - 8, idx = p0 + lane; unsigned spn = 0;
                for (;;) { const unsigned v = (idx <= 2 * sp + 1) ? __hip_atomic_load(CNT(PH_QKV) + (size_t)idx * 64, RLX_AGENT) : 144u;
                    if (__all(v >= 144u)) break; __builtin_amdgcn_s_sleep(2); if (++spn > FLOW_SPIN_CAP) break; }
                            __builtin_amdgcn_fence(__ATOMIC_ACQUIRE, "agent"); VM_WAIT(); }
            __syncthreads();
            for (int j = tid; j < 3 * 132; j += NTHR) biasL[j] = biasT[((j / 132) * 8 + h) * 132 + (j % 132)];
            __syncthreads();
#pragma nounroll
            for (int k = 0; k < 2; ++k) attn_job<2>(qk, vT + (size_t)2 * 512 * MPV, biasL + 2 * 132, act, rs_o, h, wave + 8 * k, 32 * sp, lane);
#pragma nounroll
            for (int k = 0; k < 2; ++k) attn_job<1>(qk, vT + (size_t)1 * 512 * MPV, biasL + 1 * 132, act, rs_o, h, wave & 3, 128 * sp + 32 * ((wave >> 2) + 2 * k), lane);
            __syncthreads();
#pragma nounroll
            for (int k = 0; k < 2; ++k) attn_job<0>(qk, vT, biasL, act, rs_o, h, 0, 512 * sp + 32 * (wave + 8 * k), lane);
            flow_publish(CNT(PH_ATT) + (size_t)sp * 64);
        }
        pg8::FlowOrder Ss; Ss.init(NS, 8, 1, xcd, qbase, qi, qslot);
        while (Ss.next_blocking(u)) {
            const int b = u.pm, h = u.pn;
            if (tid < 64) { flow_poll1(CNT(PH_QKV) + (size_t)64 * 64, 144u); __builtin_amdgcn_fence(__ATOMIC_ACQUIRE, "agent"); VM_WAIT(); }
            __syncthreads();
            if (wave < 3) sample_attn_group(wave, b, h, qk, vnew, args.in[3 + 2 * wave], args.in[4 + 2 * wave], biasT, smp, lane);
            __syncthreads();
            if (wave == 0 && lane < 32) { const float l0 = smp[64], l1 = smp[72 + 64], l2 = smp[144 + 64], mm = fmaxf(fmaxf(l0, l1), l2);
                const float w0 = __builtin_amdgcn_exp2f(l0 - mm), w1 = __builtin_amdgcn_exp2f(l1 - mm), w2 = __builtin_amdgcn_exp2f(l2 - mm), iw = 1.0f / (w0 + w1 + w2);
                const float r0 = (w0 * smp[2 * lane] + w1 * smp[72 + 2 * lane] + w2 * smp[144 + 2 * lane]) * iw, r1 = (w0 * smp[2 * lane + 1] + w1 * smp[72 + 2 * lane + 1] + w2 * smp[144 + 2 * lane + 1]) * iw;
                ST4(rs_o, ((unsigned)(S + b) * 512 + h * 64 + 2 * lane) * 2u, pk2(r0, r1)); }
            flow_publish(CNT(PH_ATT) + (size_t)32 * 64);
        }
        __syncthreads();
    }
    wdep_next = WC(7);
    ON(14) { FLOW_GEMM(EpiRes<false>, ({{}, xb, rs_xb, rs_xb, rs_part, red}), ob, 512, Wao, 512, 512, 64, 4, 0, 1, CNT(PH_ATT), 64u, 0, 1, CNT(PH_WAO), 0);
             SKINNY(EpiRes<false>, ({{}, xb, rs_xb, rs_xb, rs_part, red}), ob, 512, Wao, 512, 512, 4, 0, CNT(PH_ATT) - (size_t)32 * 64, (unsigned)(NS * 8 * 8), CNT(PH_WAO)); }
    wdep_next = WC(7);
    ON(15) { rcache.t0 = -1; rcache.t1 = -1; FLOW_GEMM(EpiGU, ({{}, rs_act, part, &cjob, &rcache, red}), xb, D, Wgu + (size_t)3 * 2 * FF * D, D, D, 64, 22, 0, 1, CNT(PH_WAO), 32u, 0, 0, CNT(PH_GU3), 0);
             SKINNY_Q(EpiGU, ({{}, rs_act, part, &cjob, &rcache, red}), xb, D, Wgu + (size_t)3 * 2 * FF * D, D, D, 22, 0, CNT(PH_WAO), 32u, CNT(PH_GU3)); }
    wdep_next = WC(8);
    ON(16) { FLOW_GEMM(EpiRes<false>, ({{}, xb, rs_xb, rs_xb, rs_part, red}), act, FF, Wd + (size_t)3 * D * FF, FF, FF, 64, 4, 0, 1, CNT(PH_GU3), 176u, 0, 0, CNT(PH_D3), 0);
             SKINNY_Q(EpiRes<false>, ({{}, xb, rs_xb, rs_xb, rs_part, red}), act, FF, Wd + (size_t)3 * D * FF, FF, FF, 4, 0, CNT(PH_GU3), 176u, CNT(PH_D3)); }
    ON(17) {
        pg8::FlowOrder So; So.init(NPANEL, 4, 1, xcd, qbase, qi, qslot);
        const float* gf = args.in[25]; Unit u;
        while (So.next_blocking(u)) {
            if (tid < 64) { flow_poll1(CNT(PH_D3) + (size_t)u.pm * 64, 32u); __builtin_amdgcn_fence(__ATOMIC_ACQUIRE, "agent"); VM_WAIT(); }
            __syncthreads();
            u32x2 xw[8][4]; float rsv[8];
#pragma unroll
            for (int k = 0; k < 8; ++k) { int row = u.pm * 256 + u.pn * 64 + wave + 8 * k; if (row >= MV) row = MV - 1;
                rsv[k] = rstd_of(part, row); const u32x2* xr = (const u32x2*)(xb + (size_t)row * D) + lane;
#pragma unroll
                for (int j = 0; j < 4; ++j) xw[k][j] = xr[64 * j]; }
            f32x4 gg[4];
#pragma unroll
            for (int j = 0; j < 4; ++j) gg[j] = ((const f32x4*)gf + lane)[64 * j];
#pragma unroll
            for (int k = 0; k < 8; ++k) { const int row = u.pm * 256 + u.pn * 64 + wave + 8 * k;
                if (row < MV) { f32x4* xr = (f32x4*)(out + (size_t)row * D) + lane;
#pragma unroll
                    for (int j = 0; j < 4; ++j) { const f32x4 xv = {bflo(xw[k][j].x), bfhi(xw[k][j].x), bflo(xw[k][j].y), bfhi(xw[k][j].y)}; __builtin_nontemporal_store(xv * rsv[k] * gg[j], xr + 64 * j); } } }
        }
    }
    for (int chunk = cjob.next; chunk < CP_CHUNKS; chunk += 256) {
#pragma unroll
        for (int q = 0; q < 4; ++q) { const f32x4* src; f32x4* dst; if (cp_addr(args.in, out, chunk * 32 + wave * 4 + q, lane, src, dst)) { const f32x4 a0 = __builtin_nontemporal_load(src), a1 = __builtin_nontemporal_load(src + 64); __builtin_nontemporal_store(a0, dst); __builtin_nontemporal_store(a1, dst + 64); } }
    }
}

extern "C" void kernel_launch(void* const* d_in, const int* in_sizes, int n_in, void* d_out, int out_size, void* d_ws, size_t ws_size, hipStream_t stream) {
    static int grid = 0;
    if (grid == 0) {
        if (n_in != 26 || (size_t)out_size != OUT_TOTAL || ws_size < WS_END) { fprintf(stderr, "kernel_launch: unexpected shapes: n_in %d out %d (want %zu) ws %zu (need %zu)\n", n_in, out_size, (size_t)OUT_TOTAL, ws_size, (size_t)WS_END); grid = -1; return; }
        int dev = 0, cus = 0, per_cu = 0;
        hipGetDevice(&dev); hipDeviceGetAttribute(&cus, hipDeviceAttributeMultiprocessorCount, dev);
        hipFuncSetAttribute((const void*)fwd_kernel, hipFuncAttributeMaxDynamicSharedMemorySize, LDS_BYTES);
        hipOccupancyMaxActiveBlocksPerMultiprocessor(&per_cu, (const void*)fwd_kernel, NTHR, LDS_BYTES);
        if (per_cu < 1) { fprintf(stderr, "kernel_launch: occupancy query says %d blocks per CU\n", per_cu); per_cu = 1; }
        grid = cus;
        (void)hipGetLastError();
    }
    if (grid < 0) return;
    Args a{};
    for (int i = 0; i < 26; ++i) a.in[i] = (const float*)d_in[i];
    a.out = (float*)d_out; a.ws = (unsigned char*)d_ws;
    void* kargs[] = {&a};
    hipError_t e = hipLaunchCooperativeKernel((const void*)fwd_kernel, dim3(grid), dim3(NTHR), kargs, LDS_BYTES, stream);
    if (e != hipSuccess) fprintf(stderr, "cooperative launch failed: %s (grid %d)\n", hipGetErrorString(e), grid);
}
```

```cpp
#include <hip/hip_runtime.h>
#include <hip/hip_cooperative_groups.h>
#include <cstdio>
#include <cstdint>
namespace cg = cooperative_groups;


#define LAS __attribute__((address_space(3)))
typedef unsigned short bf16_t;
typedef short bf16x8 __attribute__((ext_vector_type(8)));
typedef float f32x4 __attribute__((ext_vector_type(4)));
typedef float f32x2 __attribute__((ext_vector_type(2)));
typedef unsigned u32x4 __attribute__((ext_vector_type(4)));
typedef unsigned u32x2 __attribute__((ext_vector_type(2)));

constexpr int D = 1024, S = 16384, NS = 32, FF = 2816, MP = 16640, NPANEL = 65, MV = S + NS;
constexpr int QKVW = 4608;
constexpr int MPV = MP + 128;
constexpr float EPS = 1e-6f;

__device__ __forceinline__ unsigned f2bf(float f) { unsigned u = __builtin_bit_cast(unsigned, f); return (u + 0x7fffu + ((u >> 16) & 1u)) >> 16; }
__device__ __forceinline__ unsigned pk2(float lo, float hi) { return f2bf(lo) | (f2bf(hi) << 16); }
__device__ __forceinline__ float bf2f(unsigned short b) { return __builtin_bit_cast(float, ((unsigned)b) << 16); }
__device__ __forceinline__ float bflo(unsigned w) { return __builtin_bit_cast(float, w << 16); }
__device__ __forceinline__ float bfhi(unsigned w) { return __builtin_bit_cast(float, w & 0xffff0000u); }
#define LDS_WAIT() asm volatile("s_waitcnt lgkmcnt(0)" ::: "memory")
#define VM_WAIT() asm volatile("s_waitcnt vmcnt(0)" ::: "memory")
typedef __amdgpu_buffer_rsrc_t rsrc_t;
__device__ __forceinline__ rsrc_t mkrs(const void* p, size_t bytes) { return __builtin_amdgcn_make_buffer_rsrc((void*)p, 0, (int)bytes, 0x00020000); }
#define ST16(rs, off, v) __builtin_amdgcn_raw_buffer_store_b128((v), (rs), (unsigned)(off), 0, 16)
#define ST8(rs, off, v) __builtin_amdgcn_raw_buffer_store_b64((v), (rs), (unsigned)(off), 0, 16)
#define ST4(rs, off, v) __builtin_amdgcn_raw_buffer_store_b32((v), (rs), (unsigned)(off), 0, 16)
#define F4U(v) __builtin_bit_cast(u32x4, (v))
#define RLX_AGENT __ATOMIC_RELAXED, __HIP_MEMORY_SCOPE_AGENT

namespace pg8 {
constexpr int BM = 256, BK = 64, HALF = 128, HTB = HALF * BK * 2, STAGE_BYTES = 8 * HTB, NXCD = 8, WGM = 8;
__host__ __device__ __forceinline__ int lds_byte(int r, int c) { const int st = (r >> 4) * 2 + (c >> 5), rr = r & 15, cc = c & 31, ob = rr * 64 + cc * 2; return st * 1024 + (ob ^ (((ob >> 9) & 1) << 5)); }
__host__ __device__ __forceinline__ void stage_rc(int b, int& R, int& C) { const int st = b / 1024, sb = b % 1024, swz = sb ^ (((sb >> 9) & 1) << 5); R = (st >> 1) * 16 + swz / 64; C = (st & 1) * 32 + (swz % 64) / 2; }
__host__ __device__ __forceinline__ int perm32(int rho) { const int n = rho >> 4, i = rho & 15; return 8 * (i >> 2) + 4 * n + (i & 3); }
__host__ __device__ __forceinline__ int sigma_row(int d, int v) { const int q = 256 / d; return (v % q) * d + v / q; }

struct Unit { int pm, pn; };
struct Gemm { const bf16_t* A; const bf16_t* Bt; int lda, ldb, K, a_pn, bsig; };

#define FLOW_SPIN_CAP (1u << 21)
__device__ __forceinline__ void flow_poll1(const unsigned* c, unsigned need) {
    unsigned sp = 0;
    while ((unsigned)__builtin_amdgcn_readfirstlane(__hip_atomic_load(c, RLX_AGENT)) < need) { __builtin_amdgcn_s_sleep(2); if (++sp > FLOW_SPIN_CAP) break; }
}
__device__ __forceinline__ void flow_publish(unsigned* c) {
    asm volatile("s_waitcnt vmcnt(0)" ::: "memory");
    if ((threadIdx.x & 63) == 0) __hip_atomic_fetch_add(c, 1u, RLX_AGENT);
}
struct FlowOrder {
    int nM, nN, wgm, base, nx;
    unsigned* head;
    LAS unsigned* slot;
    unsigned claimed;
    const unsigned* wdep; unsigned wneed;
    const unsigned* dep; unsigned need, need64; int dep_pn, dep_shift;
    unsigned* pub; int pub_pn;
    __device__ __forceinline__ void init(int nM_, int nN_, int wgm_, int xcd, unsigned* qbase, int& qi, LAS unsigned* slot_) {
        nM = nM_; nN = nN_; wgm = wgm_;
        const int nwg = nM * nN, q = nwg / NXCD, r = nwg % NXCD;
        nx = q + (xcd < r ? 1 : 0); base = xcd < r ? xcd * (q + 1) : r * (q + 1) + (xcd - r) * q;
        head = qbase + (size_t)(qi * NXCD + xcd) * 64; ++qi; slot = slot_; claimed = 0u;
        wdep = nullptr; wneed = 0; dep = nullptr; need = 0; need64 = 0; dep_pn = 0; dep_shift = 0; pub = nullptr; pub_pn = 0;
    }
    __device__ __forceinline__ void restrict_to(int lo, int hi) { if (hi < nx) nx = hi; base += lo; nx = nx > lo ? nx - lo : 0; }
    __device__ __forceinline__ bool decode(unsigned l, Unit& u) const {
        if (l >= (unsigned)nx) return false;
        const int wgid = base + (int)l, nig = wgm * nN, gid = wgid / nig, fm = gid * wgm, gsz = (nM - fm) < wgm ? (nM - fm) : wgm;
        u.pm = fm + ((wgid % nig) % gsz); u.pn = (wgid % nig) / gsz; return true;
    }
    __device__ __forceinline__ bool next_blocking(Unit& u) {
        __syncthreads();
        if (threadIdx.x == 0) { const unsigned tk = __hip_atomic_fetch_add(head, 1u, RLX_AGENT);
            if (wdep) { unsigned sp = 0; while (__hip_atomic_load(wdep, RLX_AGENT) < wneed) { __builtin_amdgcn_s_sleep(2); if (++sp > FLOW_SPIN_CAP) break; } }
            *slot = tk; }
        __syncthreads();
        return decode(*slot, u);
    }
    __device__ __forceinline__ void claim_issue() { if (threadIdx.x == 0) claimed = __hip_atomic_fetch_add(head, 1u, RLX_AGENT); }
    __device__ __forceinline__ bool ready_next(Unit& u) {
        if (threadIdx.x < 64) {
            const unsigned l = (unsigned)__builtin_amdgcn_readfirstlane((int)claimed);
            Unit t; const bool ok = decode(l, t);
            if (ok && dep) { const int panel = dep_pn ? t.pn : t.pm;
                flow_poll1(dep + (size_t)(panel >> dep_shift) * 64, panel == 64 ? need64 : need);
                __builtin_amdgcn_fence(__ATOMIC_ACQUIRE, "agent");
                asm volatile("s_waitcnt vmcnt(0)" ::: "memory"); }
            if (threadIdx.x == 0) *slot = l;
        }
        asm volatile("s_waitcnt lgkmcnt(0)" ::: "memory"); __builtin_amdgcn_s_barrier(); asm volatile("" ::: "memory");
        return decode(*slot, u);
    }
    __device__ __forceinline__ void a_ready(const Unit& u) const {
        if (dep) {
            if (threadIdx.x < 64) { const int panel = dep_pn ? u.pn : u.pm;
                flow_poll1(dep + (size_t)(panel >> dep_shift) * 64, panel == 64 ? need64 : need);
                __builtin_amdgcn_fence(__ATOMIC_ACQUIRE, "agent");
                asm volatile("s_waitcnt vmcnt(0)" ::: "memory"); }
            asm volatile("" ::: "memory"); __builtin_amdgcn_s_barrier(); asm volatile("" ::: "memory");
        }
    }
    __device__ __forceinline__ void done(const Unit& u) const { if (pub) flow_publish(pub + (size_t)(pub_pn ? u.pn : u.pm) * 64); }
};

__device__ __forceinline__ unsigned cvt_pk_bf16(float lo, float hi) { unsigned r; asm volatile("v_cvt_pk_bf16_f32 %0, %1, %2" : "=v"(r) : "v"(lo), "v"(hi)); return r; }

template <class E_> __device__ __forceinline__ bool epi_pub(const E_&) { return true; }
template <class Epi, class Sched>
__device__ __forceinline__ void gemm_phase(LAS unsigned char* lds, const Gemm g, Sched& S, const Epi& E) {
    int tid = threadIdx.x; asm volatile("" : "+v"(tid));
    const int wid = __builtin_amdgcn_readfirstlane(tid >> 6), lane = tid & 63, wr = wid >> 2, wc = wid & 3, fr = lane & 15, fq = lane >> 4;
    const int K = g.K, nt = K / BK;
    unsigned voffA[2], voffB[2];
#pragma unroll
    for (int i = 0; i < 2; ++i) { int R, C; stage_rc(tid * 16 + i * 8192, R, C); const int Rb = sigma_row(g.bsig, (R & ~31) + perm32(R & 31));
        voffA[i] = (unsigned)(R * g.lda + C) * 2u; voffB[i] = (unsigned)(Rb * g.ldb + C) * 2u; }
    const size_t kstep = (size_t)(BK * 2);
    const size_t hstepA = (size_t)HALF * g.lda * 2, hstepB = (size_t)sigma_row(g.bsig, HALF) * g.ldb * 2;
    const size_t tstepA = 2 * hstepA, tstepB = (size_t)BM * g.ldb * 2;
    const unsigned ldsw = (unsigned)wid * 1024u;
    const int aoff = lds_byte(wr * 64 + fr, fq * 8), boff = lds_byte(wc * 32 + fr, fq * 8);
#define PG8_SA(b, h) (((b) * 2 + (h)) * HTB)
#define PG8_SB(b, h) ((4 + (b) * 2 + (h)) * HTB)
#define PG8_STAGE(bufoff, gbase, voff) do { _Pragma("unroll") for (int _i = 0; _i < 2; ++_i) \
        __builtin_amdgcn_global_load_lds((const unsigned*)((const char*)(gbase) + (voff)[_i]), (LAS unsigned*)(lds + (bufoff) + ldsw + _i * 8192), 16, 0, 0); } while (0)
#define PG8_LDA(dst, b, h) do { _Pragma("unroll") for (int m = 0; m < 4; ++m) _Pragma("unroll") for (int k = 0; k < 2; ++k) dst[m][k] = *(const LAS bf16x8*)(lds + PG8_SA(b, h) + aoff + m * 2048 + k * 1024); } while (0)
#define PG8_LDB(dst, b, h) do { _Pragma("unroll") for (int n = 0; n < 2; ++n) _Pragma("unroll") for (int k = 0; k < 2; ++k) dst[n][k] = *(const LAS bf16x8*)(lds + PG8_SB(b, h) + boff + n * 2048 + k * 1024); } while (0)
#define PG8_MMA(ai, bj, At, Bt) do { __builtin_amdgcn_s_setprio(1); _Pragma("unroll") for (int m = 0; m < 4; ++m) _Pragma("unroll") for (int n = 0; n < 2; ++n) _Pragma("unroll") for (int k = 0; k < 2; ++k) \
        acc[ai][bj][m][n] = __builtin_amdgcn_mfma_f32_16x16x32_bf16(Bt[n][k], At[m][k], acc[ai][bj][m][n], 0, 0, 0); __builtin_amdgcn_s_setprio(0); } while (0)
#define PG8_WAIT_V(n) asm volatile("s_waitcnt vmcnt(" #n ")" ::: "memory")
#define PG8_WAIT_L(n) asm volatile("s_waitcnt lgkmcnt(" #n ")" ::: "memory")
#define PG8_BAR __builtin_amdgcn_s_barrier()
#define PG8_SCHED __builtin_amdgcn_sched_barrier(0)
    Unit cur, nxt; int ui = 0;
    if (!S.next_blocking(cur)) return;
    f32x4 acc[2][2][4][2];
#pragma unroll
    for (int a = 0; a < 2; ++a)
#pragma unroll
        for (int b = 0; b < 2; ++b)
#pragma unroll
            for (int m = 0; m < 4; ++m)
#pragma unroll
                for (int n = 0; n < 2; ++n) acc[a][b][m][n] = (f32x4){0.f, 0.f, 0.f, 0.f};
    bf16x8 At[4][2], B0[2][2], B1[2][2];
    const char* cA = (const char*)g.A + (size_t)cur.pm * tstepA + (size_t)cur.pn * g.a_pn * 2; const char* cB = (const char*)g.Bt + (size_t)cur.pn * tstepB;
    PG8_STAGE(PG8_SB(0, 0), cB, voffB); PG8_STAGE(PG8_SB(0, 1), cB + hstepB, voffB);
    S.a_ready(cur);
    PG8_STAGE(PG8_SA(0, 0), cA, voffA); PG8_STAGE(PG8_SA(0, 1), cA + hstepA, voffA);
    if (wr == 1) PG8_BAR;
    PG8_WAIT_V(2); PG8_BAR;
    PG8_STAGE(PG8_SB(1, 0), cB + kstep, voffB); PG8_STAGE(PG8_SA(1, 0), cA + kstep, voffA); PG8_STAGE(PG8_SB(1, 1), cB + hstepB + kstep, voffB);
    PG8_WAIT_V(6); PG8_BAR;
    for (;;) {
        bool has_next = false; const char* nA = cA; const char* nB = cB;
        const int t_claim = nt >= 4 ? nt - 4 : 0;
#pragma nounroll
        for (int t = 0; t < nt; t += 2) {
            const bool last = (t == nt - 2);
            const char* a1 = cA + (size_t)(t + 1) * kstep;
            if (t == t_claim) S.claim_issue();
            if (last) { has_next = S.ready_next(nxt);
                if (has_next) { nA = (const char*)g.A + (size_t)nxt.pm * tstepA + (size_t)nxt.pn * g.a_pn * 2; nB = (const char*)g.Bt + (size_t)nxt.pn * tstepB; } }
            const char* a2 = last ? nA : cA + (size_t)(t + 2) * kstep; const char* b2 = last ? nB : cB + (size_t)(t + 2) * kstep;
            const char* a3 = a2 + kstep; const char* b3 = b2 + kstep;
            PG8_LDB(B0, 0, 0); PG8_LDB(B1, 0, 1); PG8_SCHED; PG8_LDA(At, 0, 0); PG8_STAGE(PG8_SA(1, 1), a1 + hstepA, voffA);
            PG8_WAIT_V(8); PG8_WAIT_L(0); PG8_BAR; PG8_MMA(0, 0, At, B0); PG8_MMA(0, 1, At, B1); PG8_BAR; PG8_SCHED;
            PG8_LDA(At, 0, 1); PG8_STAGE(PG8_SB(0, 0), b2, voffB); PG8_STAGE(PG8_SB(0, 1), b2 + hstepB, voffB); PG8_STAGE(PG8_SA(0, 0), a2, voffA);
            PG8_WAIT_V(8); PG8_WAIT_L(0); PG8_BAR; PG8_MMA(1, 0, At, B0); PG8_MMA(1, 1, At, B1); PG8_BAR; PG8_SCHED;
            PG8_LDB(B0, 1, 0); PG8_LDB(B1, 1, 1); PG8_SCHED; PG8_LDA(At, 1, 0); PG8_STAGE(PG8_SA(0, 1), a2 + hstepA, voffA);
            PG8_WAIT_V(8); PG8_WAIT_L(0); PG8_BAR; PG8_MMA(0, 0, At, B0); PG8_MMA(0, 1, At, B1); PG8_BAR; PG8_SCHED;
            PG8_LDA(At, 1, 1); PG8_STAGE(PG8_SB(1, 0), b3, voffB); PG8_STAGE(PG8_SB(1, 1), b3 + hstepB, voffB); PG8_STAGE(PG8_SA(1, 0), a3, voffA);
            PG8_WAIT_V(8); PG8_WAIT_L(0); PG8_BAR; PG8_MMA(1, 0, At, B0); PG8_MMA(1, 1, At, B1); PG8_BAR; PG8_SCHED;
        }
        if (wr == 0) PG8_BAR;
        E(acc, cur, wr, wc, fr, fq); if (epi_pub(E)) S.done(cur);
        if (!has_next) break;
#pragma unroll
        for (int a = 0; a < 2; ++a)
#pragma unroll
            for (int b = 0; b < 2; ++b)
#pragma unroll
                for (int m = 0; m < 4; ++m)
#pragma unroll
                    for (int n = 0; n < 2; ++n) acc[a][b][m][n] = (f32x4){0.f, 0.f, 0.f, 0.f};
        cur = nxt; cA = nA; cB = nB; ++ui;
        if (wr == 1) PG8_BAR;
    }
    PG8_WAIT_V(0);
    PG8_BAR;
#undef PG8_SA
#undef PG8_SB
#undef PG8_STAGE
#undef PG8_LDA
#undef PG8_LDB
#undef PG8_MMA
#undef PG8_WAIT_V
#undef PG8_WAIT_L
#undef PG8_BAR
#undef PG8_SCHED
}
}
using pg8::Unit;
using pg8::cvt_pk_bf16;
using pg8::flow_poll1;
using pg8::flow_publish;

constexpr size_t MiB = 1u << 20;
constexpr size_t al(size_t x) { return (x + 4095) & ~(size_t)4095; }
constexpr size_t WS_CTL = 0;
constexpr size_t WS_WGU = 1 * MiB;
constexpr size_t SZ_WGU = (size_t)2 * FF * D * 2;
constexpr size_t WS_WD = WS_WGU + 4 * SZ_WGU;
constexpr size_t SZ_WD = (size_t)D * FF * 2;
constexpr size_t WS_WIN = WS_WD + 4 * SZ_WD;
constexpr size_t WS_WGRP = WS_WIN + (size_t)D * D * 2;
constexpr size_t WS_WPO = WS_WGRP + (size_t)D * 256 * 2;
constexpr size_t WS_WQKV = WS_WPO + (size_t)D * D * 2;
constexpr size_t WS_WAO = WS_WQKV + (size_t)QKVW * D * 2;
constexpr size_t WS_BIAS = WS_WAO + (size_t)D * 512 * 2;
constexpr size_t WS_PART = al(WS_BIAS + 3 * 8 * 132 * 4);
constexpr size_t WS_XB = al(WS_PART + (size_t)MP * 4 * 4);
constexpr size_t WS_XF = WS_XB + (size_t)MP * D * 2;
constexpr size_t WS_ACT = WS_XF + (size_t)MP * D * 4;
constexpr size_t WS_U = WS_ACT + (size_t)MP * FF * 2;
constexpr size_t WS_Z = WS_U + (size_t)MP * D * 2;
constexpr size_t WS_Z2 = WS_Z + (size_t)MP * D * 2;
constexpr size_t WS_QK = WS_Z2 + (size_t)MP * D * 2;
constexpr size_t WS_VT = WS_QK + (size_t)MP * 3072 * 2;
constexpr size_t WS_O = WS_VT + (size_t)3 * 512 * MPV * 2;
constexpr size_t WS_VNEW = WS_O + (size_t)MP * 512 * 2;
constexpr size_t WS_END = WS_VNEW + (size_t)NS * 1536 * 2;

constexpr size_t O_YP = 0, O_YS = (size_t)S * D, O_PSP = O_YS + (size_t)NS * D, O_PSS = O_PSP + 15 * D, O_KV0 = O_PSS + (size_t)NS * 15 * D;
__host__ __device__ constexpr size_t kv_group_base(int g) {
    size_t o = O_KV0;
    for (int i = 0; i < g; ++i) { const size_t W = (size_t)128 << (2 * i); o += 2 * W * 512 + 2 * (size_t)NS * W * 512; }
    return o;
}
constexpr size_t OUT_TOTAL = kv_group_base(3);

constexpr int CP_ROWS_TOTAL = 2 * NS * (127 + 511 + 2047);
constexpr int CP_CHUNKS = (CP_ROWS_TOTAL + 31) / 32;
__device__ __forceinline__ bool cp_addr(const float* const* in, float* out, int rho, int lane, const f32x4*& src, f32x4*& dst) {
    if (rho >= CP_ROWS_TOTAL) return false;
    int g = 0, kv = 0, rem = rho;
    if (rem >= 2 * NS * 127) { rem -= 2 * NS * 127; g = 1; if (rem >= 2 * NS * 511) { rem -= 2 * NS * 511; g = 2; } }
    const int W = 128 << (2 * g), per = NS * (W - 1);
    if (rem >= per) { rem -= per; kv = 1; }
    const int b = rem / (W - 1), t = rem % (W - 1);
    src = (const f32x4*)in[3 + 2 * g + kv] + ((size_t)b * W + t + 1) * 128 + lane;
    dst = (f32x4*)(out + kv_group_base(g) + 2 * (size_t)W * 512 + (size_t)kv * NS * W * 512) + ((size_t)b * W + t) * 128 + lane;
    return true;
}
struct CopyJob { const float* const* in; float* out; int next; };

__device__ __forceinline__ float rstd_of(const float* part, int row) {
    const f32x4 a = *(const f32x4*)(part + (size_t)row * 4);
    return __builtin_amdgcn_rsqf(((a.x + a.y) + (a.z + a.w)) * (1.0f / D) + EPS);
}
__device__ __forceinline__ float silu_mul(float g, float u) { return g * __builtin_amdgcn_rcpf(1.0f + __expf(-g)) * u; }
__device__ __forceinline__ u32x4 pack8(const f32x4 v0, const f32x4 v1) { u32x4 w; w.x = cvt_pk_bf16(v0[0], v0[1]); w.y = cvt_pk_bf16(v0[2], v0[3]); w.z = cvt_pk_bf16(v1[0], v1[1]); w.w = cvt_pk_bf16(v1[2], v1[3]); return w; }

template <class Derived> struct EpiBase {
    __device__ __forceinline__ void operator()(f32x4 (&acc)[2][2][4][2], const Unit& u, int wr, int wc, int fr, int fq) const {
        const Derived& self = *static_cast<const Derived*>(this);
        const int row0 = u.pm * 256 + wr * 64 + fr;
        float ctx[2][4];
#pragma unroll
        for (int ai = 0; ai < 2; ++ai)
#pragma unroll
            for (int m = 0; m < 4; ++m) ctx[ai][m] = self.pre_row(acc[ai][0][m], acc[ai][1][m], row0 + ai * 128 + m * 16, u.pn, wc, fq);
        __builtin_amdgcn_sched_barrier(0);
#pragma unroll
        for (int ai = 0; ai < 2; ++ai)
#pragma unroll
            for (int m = 0; m < 4; ++m) { const f32x4 v[2][2] = {{acc[ai][0][m][0], acc[ai][0][m][1]}, {acc[ai][1][m][0], acc[ai][1][m][1]}};
                self.row_op(v, row0 + ai * 128 + m * 16, u.pn, wc, fq, ai * 128 + wr * 64 + m * 16 + fr, ctx[ai][m]); }
        self.finish(u.pm, u.pn, 256);
    }
    __device__ __forceinline__ void small(f32x4 (&accS)[2][2][2], int pn, int wc, int fr, int fq, bool active) const {
        const Derived& self = *static_cast<const Derived*>(this);
        if (active) {
            float ctx[2];
#pragma unroll
            for (int m = 0; m < 2; ++m) ctx[m] = self.pre_row(accS[0][m], accS[1][m], S + m * 16 + fr, pn, wc, fq);
            __builtin_amdgcn_sched_barrier(0);
#pragma unroll
            for (int m = 0; m < 2; ++m) { const f32x4 v[2][2] = {{accS[0][m][0], accS[0][m][1]}, {accS[1][m][0], accS[1][m][1]}};
                self.row_op(v, S + m * 16 + fr, pn, wc, fq, m * 16 + fr, ctx[m]); }
        }
        self.finish(64, pn, 32);
    }
    __device__ __forceinline__ void finish(int, int, int) const {}
};

struct EpiGU : EpiBase<EpiGU> {
    rsrc_t act; const float* part; CopyJob* cj;
    __device__ __forceinline__ float pre_row(f32x4 (&)[2], f32x4 (&)[2], int row, int, int, int) const { return rstd_of(part, row); }
    __device__ __forceinline__ u32x4 silu_pack(const f32x4 (&v)[2][2], float rs) const {
        const float c = -1.4426950408889634f * rs, r2 = rs * rs;
        f32x4 o0, o1;
#pragma unroll
        for (int e = 0; e < 4; ++e) { o0[e] = (v[0][0][e] * v[1][0][e]) * (r2 * __builtin_amdgcn_rcpf(1.0f + __builtin_amdgcn_exp2f(v[0][0][e] * c))); o1[e] = (v[0][1][e] * v[1][1][e]) * (r2 * __builtin_amdgcn_rcpf(1.0f + __builtin_amdgcn_exp2f(v[0][1][e] * c))); }
        return pack8(o0, o1);
    }
    __device__ __forceinline__ void row_op(const f32x4 (&v)[2][2], int row, int pn, int wc, int fq, int, float rs) const {
        ST16(act, ((unsigned)row * FF + pn * 128 + wc * 32 + 8 * fq) * 2u, silu_pack(v, rs));
    }
    __device__ __forceinline__ void operator()(f32x4 (&acc)[2][2][4][2], const Unit& u, int wr, int wc, int fr, int fq) const {
        const int row0 = u.pm * 256 + wr * 64 + fr, lane = fr + 16 * fq, wave = wr * 4 + wc;
        float rs[2][4];
#pragma unroll
        for (int ai = 0; ai < 2; ++ai)
#pragma unroll
            for (int m = 0; m < 4; ++m) rs[ai][m] = rstd_of(part, row0 + ai * 128 + m * 16);
        f32x4 cv[4][2]; f32x4* cd[4]; const int chunk = cj->next;
        if (chunk < CP_CHUNKS) {
#pragma unroll
            for (int q = 0; q < 4; ++q) { const f32x4* src; cd[q] = nullptr; if (cp_addr(cj->in, cj->out, chunk * 32 + wave * 4 + q, lane, src, cd[q])) { cv[q][0] = __builtin_nontemporal_load(src); cv[q][1] = __builtin_nontemporal_load(src + 64); } }
        }
        __builtin_amdgcn_sched_barrier(0);
        u32x4 w[2][4];
#pragma unroll
        for (int ai = 0; ai < 2; ++ai)
#pragma unroll
            for (int m = 0; m < 4; ++m) { const f32x4 v[2][2] = {{acc[ai][0][m][0], acc[ai][0][m][1]}, {acc[ai][1][m][0], acc[ai][1][m][1]}}; w[ai][m] = silu_pack(v, rs[ai][m]); }
        __builtin_amdgcn_sched_barrier(0);
        if (chunk < CP_CHUNKS) {
#pragma unroll
            for (int q = 0; q < 4; ++q) if (cd[q]) { __builtin_nontemporal_store(cv[q][0], cd[q]); __builtin_nontemporal_store(cv[q][1], cd[q] + 64); }
            cj->next = chunk + 256;
        }
#pragma unroll
        for (int ai = 0; ai < 2; ++ai)
#pragma unroll
            for (int m = 0; m < 4; ++m) ST16(act, ((unsigned)(row0 + ai * 128 + m * 16) * FF + u.pn * 128 + wc * 32 + 8 * fq) * 2u, w[ai][m]);
    }
};
template <bool LAST> struct EpiRes : EpiBase<EpiRes<LAST>> {
    const bf16_t* xr; rsrc_t xo; rsrc_t xb; rsrc_t part; LAS float* red;
    __device__ __forceinline__ void operator()(f32x4 (&acc)[2][2][4][2], const Unit& u, int wr, int wc, int fr, int fq) const {
        const int row0 = u.pm * 256 + wr * 64 + fr, coff = u.pn * 256 + wc * 32 + 8 * fq;
        u32x4 xn[2][4][2];
#pragma unroll
        for (int ai = 0; ai < 2; ++ai)
#pragma unroll
            for (int m = 0; m < 4; ++m) { const bf16_t* xi = xr + (size_t)(row0 + ai * 128 + m * 16) * D + coff; xn[ai][m][0] = *(const u32x4*)xi; xn[ai][m][1] = *(const u32x4*)(xi + 128); }
        __builtin_amdgcn_sched_barrier(0);
#pragma unroll
        for (int ai = 0; ai < 2; ++ai)
#pragma unroll
            for (int m = 0; m < 4; ++m) {
                f32x4 v[2][2];
#pragma unroll
                for (int bj = 0; bj < 2; ++bj) { const u32x4 t = xn[ai][m][bj];
                    v[bj][0] = acc[ai][bj][m][0] + (f32x4){bflo(t.x), bfhi(t.x), bflo(t.y), bfhi(t.y)}; v[bj][1] = acc[ai][bj][m][1] + (f32x4){bflo(t.z), bfhi(t.z), bflo(t.w), bfhi(t.w)}; }
                row_op(v, row0 + ai * 128 + m * 16, u.pn, wc, fq, ai * 128 + wr * 64 + m * 16 + fr, 0.f);
            }
        finish(u.pm, u.pn, 256);
    }
    __device__ __forceinline__ float pre_row(f32x4 (&a0)[2], f32x4 (&a1)[2], int row, int pn, int wc, int fq) const {
        const bf16_t* xi = xr + (size_t)row * D + pn * 256 + wc * 32 + 8 * fq;
        const u32x4 t0 = *(const u32x4*)xi, t1 = *(const u32x4*)(xi + 128);
        a0[0] += (f32x4){bflo(t0.x), bfhi(t0.x), bflo(t0.y), bfhi(t0.y)}; a0[1] += (f32x4){bflo(t0.z), bfhi(t0.z), bflo(t0.w), bfhi(t0.w)};
        a1[0] += (f32x4){bflo(t1.x), bfhi(t1.x), bflo(t1.y), bfhi(t1.y)}; a1[1] += (f32x4){bflo(t1.z), bfhi(t1.z), bflo(t1.w), bfhi(t1.w)};
        return 0.f;
    }
    __device__ __forceinline__ void row_op(const f32x4 (&v)[2][2], int row, int pn, int wc, int fq, int lrow, float) const {
        const int col0 = pn * 256 + wc * 32 + 8 * fq;
        float ss = 0.f;
#pragma unroll
        for (int bj = 0; bj < 2; ++bj) {
            const f32x4 v0 = v[bj][0], v1 = v[bj][1];
            ss += (v0[0] * v0[0] + v0[1] * v0[1]) + (v0[2] * v0[2] + v0[3] * v0[3]) + (v1[0] * v1[0] + v1[1] * v1[1]) + (v1[2] * v1[2] + v1[3] * v1[3]);
            if (LAST) { const unsigned o = ((unsigned)row * D + col0 + bj * 128) * 4u; ST16(xo, o, F4U(v0)); ST16(xo, o + 16u, F4U(v1)); }
            else ST16(xb, ((unsigned)row * D + col0 + bj * 128) * 2u, pack8(v0, v1));
        }
        ss += __shfl_xor(ss, 16); ss += __shfl_xor(ss, 32);
        if (fq == 0) red[lrow * 4 + wc] = ss;
    }
    __device__ __forceinline__ void finish(int pm, int pn, int nrows) const {
        asm volatile("s_waitcnt lgkmcnt(0)" ::: "memory"); __builtin_amdgcn_s_barrier(); asm volatile("" ::: "memory");
        if ((int)threadIdx.x < nrows) { const f32x4 v = *(const LAS f32x4*)(red + threadIdx.x * 4); ST4(part, ((unsigned)(pm * 256 + threadIdx.x) * 4 + pn) * 4u, __builtin_bit_cast(unsigned, (v.x + v.y) + (v.z + v.w))); }
    }
};
struct EpiPark {
    unsigned* tflag; float* parked;
    __device__ __forceinline__ void operator()(f32x4 (&acc)[2][2][4][2], const Unit& u, int wr, int wc, int fr, int fq) const {
        const int tile = u.pm * 4 + u.pn, wave = wr * 4 + wc, lane = fr + 16 * fq;
        const rsrc_t pr = mkrs(parked + (size_t)tile * 65536, (size_t)1 << 20); const unsigned po = (unsigned)(wave * 256 + lane * 4) * 4u;
#pragma unroll
        for (int ai = 0; ai < 2; ++ai)
#pragma unroll
            for (int bj = 0; bj < 2; ++bj)
#pragma unroll
                for (int m = 0; m < 4; ++m)
#pragma unroll
                    for (int n = 0; n < 2; ++n) ST16(pr, po + (unsigned)((((ai * 2 + bj) * 4 + m) * 2 + n) * 2048 * 4), F4U(acc[ai][bj][m][n]));
        flow_publish(tflag + (size_t)tile * 16);
    }
};
__device__ __forceinline__ bool epi_pub(const EpiPark&) { return false; }
struct EpiMerge {
    EpiRes<false> res; const unsigned* tflag; const float* parked;
    __device__ __forceinline__ void operator()(f32x4 (&acc)[2][2][4][2], const Unit& u, int wr, int wc, int fr, int fq) const {
        const int tile = u.pm * 4 + u.pn, wave = wr * 4 + wc, lane = fr + 16 * fq;
        if (threadIdx.x < 64) { flow_poll1(tflag + (size_t)tile * 16, 8u); __builtin_amdgcn_fence(__ATOMIC_ACQUIRE, "agent"); asm volatile("s_waitcnt vmcnt(0)" ::: "memory"); }
        asm volatile("" ::: "memory"); __builtin_amdgcn_s_barrier(); asm volatile("" ::: "memory");
        const float* pt = parked + (size_t)tile * 65536 + (size_t)wave * 256 + lane * 4;
        const int row0 = u.pm * 256 + wr * 64 + fr, coff = u.pn * 256 + wc * 32 + 8 * fq;
#pragma unroll
        for (int ai = 0; ai < 2; ++ai)
#pragma unroll
            for (int mp = 0; mp < 2; ++mp) {
                u32x4 xn[2][2]; f32x4 pp[2][2][2];
#pragma unroll
                for (int mm = 0; mm < 2; ++mm) { const int m = 2 * mp + mm; const bf16_t* xi = res.xr + (size_t)(row0 + ai * 128 + m * 16) * D + coff; xn[mm][0] = *(const u32x4*)xi; xn[mm][1] = *(const u32x4*)(xi + 128);
#pragma unroll
                    for (int bj = 0; bj < 2; ++bj)
#pragma unroll
                        for (int n = 0; n < 2; ++n) pp[mm][bj][n] = *(const f32x4*)(pt + (size_t)((((ai * 2 + bj) * 4 + m) * 2 + n) * 2048)); }
                __builtin_amdgcn_sched_barrier(0);
#pragma unroll
                for (int mm = 0; mm < 2; ++mm) { const int m = 2 * mp + mm; f32x4 v[2][2];
#pragma unroll
                    for (int bj = 0; bj < 2; ++bj) { const u32x4 t = xn[mm][bj];
                        v[bj][0] = (acc[ai][bj][m][0] + pp[mm][bj][0]) + (f32x4){bflo(t.x), bfhi(t.x), bflo(t.y), bfhi(t.y)}; v[bj][1] = (acc[ai][bj][m][1] + pp[mm][bj][1]) + (f32x4){bflo(t.z), bfhi(t.z), bflo(t.w), bfhi(t.w)}; }
                    res.row_op(v, row0 + ai * 128 + m * 16, u.pn, wc, fq, ai * 128 + wr * 64 + m * 16 + fr, 0.f); }
                __builtin_amdgcn_sched_barrier(0);
            }
        res.finish(u.pm, u.pn, 256);
    }
};
struct EpiU : EpiBase<EpiU> {
    rsrc_t ub; const float* part; float* psp; float* pss;
    __device__ __forceinline__ float pre_row(f32x4 (&)[2], f32x4 (&)[2], int row, int, int, int) const { return rstd_of(part, row); }
    __device__ __forceinline__ void row_op(const f32x4 (&v)[2][2], int row, int pn, int wc, int fq, int, float rs) const {
        const int col0 = pn * 256 + wc * 32 + 8 * fq;
        float* po = nullptr;
        if (row >= S - 15 && row < S) po = psp + (size_t)(row - (S - 15)) * D; else if (row >= S && row < MV) po = pss + ((size_t)(row - S) * 15 + 14) * D;
#pragma unroll
        for (int bj = 0; bj < 2; ++bj) {
            const f32x4 v0 = v[bj][0] * rs, v1 = v[bj][1] * rs;
            ST16(ub, ((unsigned)row * D + col0 + bj * 128) * 2u, pack8(v0, v1));
            if (po) { *(f32x4*)(po + col0 + bj * 128) = v0; *(f32x4*)(po + col0 + bj * 128 + 4) = v1; }
        }
    }
};
struct EpiPlain : EpiBase<EpiPlain> {
    rsrc_t o;
    __device__ __forceinline__ float pre_row(f32x4 (&)[2], f32x4 (&)[2], int, int, int, int) const { return 0.f; }
    __device__ __forceinline__ void row_op(const f32x4 (&v)[2][2], int row, int pn, int wc, int fq, int, float) const {
        const int col0 = pn * 256 + wc * 32 + 8 * fq;
#pragma unroll
        for (int bj = 0; bj < 2; ++bj) ST16(o, ((unsigned)row * D + col0 + bj * 128) * 2u, pack8(v[bj][0], v[bj][1]));
    }
};
struct EpiQK : EpiBase<EpiQK> {
    rsrc_t qk; const float* part; float* out; rsrc_t vnew;
    __device__ __forceinline__ float pre_row(f32x4 (&)[2], f32x4 (&)[2], int row, int, int, int) const { return rstd_of(part, row); }
    __device__ __forceinline__ void row_op(const f32x4 (&v)[2][2], int row, int pn, int wc, int fq, int, float rs) const {
        const int colt = pn * 256, cw = wc * 32 + 8 * fq;
        const bool isv = colt >= 3072;
        const int g = isv ? (colt - 3072) / 512 : colt / 1024, s = isv ? 2 : (colt % 1024) / 512;
        const int W = 128 << (2 * g);
        const size_t gb = kv_group_base(g);
        const size_t o_p = gb, o_s = gb + 2 * (size_t)W * 512 + (isv ? (size_t)NS * W * 512 : 0);
        float* po = nullptr;
        if (s != 0) { if (row >= S - W && row < S) po = out + o_p + (size_t)(row - (S - W)) * 512; else if (row >= S && row < MV) po = out + o_s + ((size_t)(row - S) * W + (W - 1)) * 512; }
#pragma unroll
        for (int bj = 0; bj < 2; ++bj) {
            const f32x4 v0 = v[bj][0] * rs, v1 = v[bj][1] * rs;
            if (!isv) ST16(qk, ((unsigned)row * 3072 + colt + cw + bj * 128) * 2u, pack8(v0, v1));
            else ST16(vnew, ((unsigned)(row - S) * 1536 + (colt - 3072) + cw + bj * 128) * 2u, pack8(v0, v1));
            if (po) { const int he = (colt + cw + bj * 128) % 512; *(f32x4*)(po + he) = v0; *(f32x4*)(po + he + 4) = v1; }
        }
    }
};
struct EpiVT {
    rsrc_t vTg; const float* part; float* out; int g, d;
    __device__ __forceinline__ void operator()(f32x4 (&acc)[2][2][4][2], const Unit& u, int wr, int wc, int fr, int fq) const {
        const int dim0 = u.pm * 256 + wr * 64 + fr;
        const int W = 128 << (2 * g), q = 256 / d;
        const size_t o_p = kv_group_base(g) + (size_t)W * 512;
        const bool tail = (u.pn * 256 + 255 >= S - W);
        float rsa[2][8];
#pragma unroll
        for (int bj = 0; bj < 2; ++bj) { const int v0 = 128 * bj + 32 * wc + 8 * fq, r = v0 / q, ii0 = v0 % q, tok0 = u.pn * 256 + ii0 * d + r;
#pragma unroll
            for (int e = 0; e < 8; ++e) rsa[bj][e] = rstd_of(part, tok0 + e * d);
            __builtin_amdgcn_sched_barrier(0); }
#pragma unroll
        for (int bj = 0; bj < 2; ++bj) {
            const int v0 = 128 * bj + 32 * wc + 8 * fq, r = v0 / q, ii0 = v0 % q;
            const int tok0 = u.pn * 256 + ii0 * d + r;
            float rs[8];
#pragma unroll
            for (int e = 0; e < 8; ++e) rs[e] = rsa[bj][e];
            const size_t sidx = (size_t)r * (S / d) + (size_t)(u.pn * 256) / d + ii0;
            const unsigned vp = (unsigned)(((size_t)dim0 * MPV + 128 + sidx) * 2);
#pragma unroll
            for (int ai = 0; ai < 2; ++ai)
#pragma unroll
                for (int m = 0; m < 4; ++m) {
                    const f32x4 a0 = acc[ai][bj][m][0], a1 = acc[ai][bj][m][1];
                    u32x4 w; w.x = cvt_pk_bf16(a0[0] * rs[0], a0[1] * rs[1]); w.y = cvt_pk_bf16(a0[2] * rs[2], a0[3] * rs[3]); w.z = cvt_pk_bf16(a1[0] * rs[4], a1[1] * rs[5]); w.w = cvt_pk_bf16(a1[2] * rs[6], a1[3] * rs[7]);
                    ST16(vTg, vp + (unsigned)(ai * 128 + m * 16) * (unsigned)(MPV * 2), w);
                    asm volatile("" ::: "memory");
                }
            if (tail) {
#pragma unroll
                for (int e = 0; e < 8; ++e) { const int t = tok0 + e * d;
                    if (t >= S - W) { float* po = out + o_p + (size_t)(t - (S - W)) * 512 + dim0;
#pragma unroll
                        for (int ai = 0; ai < 2; ++ai)
#pragma unroll
                            for (int m = 0; m < 4; ++m) po[ai * 128 + m * 16] = acc[ai][bj][m][e >> 2][e & 3] * rs[e]; }
                    asm volatile("" ::: "memory"); }
            }
        }
    }
};

template <class Epi>
__device__ __forceinline__ void skinny_unit(LAS unsigned char* lds, const pg8::Gemm g, int pn, const Epi& E) {
    int tid = threadIdx.x; asm volatile("" : "+v"(tid));
    const int wid = __builtin_amdgcn_readfirstlane(tid >> 6), lane = tid & 63, kh = wid >> 2, wc = wid & 3, fr = lane & 15, fq = lane >> 4;
    const int Kh = g.K / 2;
    const bf16_t* ap = g.A + (size_t)(S + fr) * g.lda + (size_t)pn * g.a_pn + kh * Kh + 8 * fq;
    const bf16_t* bp = g.Bt + (size_t)(pn * 256 + wc * 32 + 8 * (fr >> 2) + (fr & 3)) * g.ldb + kh * Kh + 8 * fq;
    f32x4 acc[2][2][2];
#pragma unroll
    for (int a = 0; a < 2; ++a)
#pragma unroll
        for (int b = 0; b < 2; ++b)
#pragma unroll
            for (int c = 0; c < 2; ++c) acc[a][b][c] = (f32x4){0.f, 0.f, 0.f, 0.f};
#pragma unroll 4
    for (int k0 = 0; k0 < Kh; k0 += 32) {
        bf16x8 af[2], bf[2][2];
#pragma unroll
        for (int m = 0; m < 2; ++m) af[m] = *(const bf16x8*)(ap + (size_t)(16 * m) * g.lda + k0);
#pragma unroll
        for (int bj = 0; bj < 2; ++bj)
#pragma unroll
            for (int n = 0; n < 2; ++n) bf[bj][n] = *(const bf16x8*)(bp + (size_t)(128 * bj + 4 * n) * g.ldb + k0);
#pragma unroll
        for (int bj = 0; bj < 2; ++bj)
#pragma unroll
            for (int m = 0; m < 2; ++m)
#pragma unroll
                for (int n = 0; n < 2; ++n) acc[bj][m][n] = __builtin_amdgcn_mfma_f32_16x16x32_bf16(bf[bj][n], af[m], acc[bj][m][n], 0, 0, 0);
    }
    LAS f32x4* xs = (LAS f32x4*)lds + (wc * 64 + lane) * 8;
    __syncthreads();
    if (kh == 1) {
#pragma unroll
        for (int bj = 0; bj < 2; ++bj)
#pragma unroll
            for (int m = 0; m < 2; ++m)
#pragma unroll
                for (int n = 0; n < 2; ++n) xs[(bj * 2 + m) * 2 + n] = acc[bj][m][n];
    }
    __syncthreads();
    if (kh == 0) {
#pragma unroll
        for (int bj = 0; bj < 2; ++bj)
#pragma unroll
            for (int m = 0; m < 2; ++m)
#pragma unroll
                for (int n = 0; n < 2; ++n) acc[bj][m][n] += xs[(bj * 2 + m) * 2 + n];
    }
    E.small(acc, pn, wc, fr, fq, kh == 0);
}

typedef float f32x16 __attribute__((ext_vector_type(16)));
typedef __bf16 bf16v2 __attribute__((ext_vector_type(2)));
#define MFMA32(a, b, c) __builtin_amdgcn_mfma_f32_32x32x16_bf16((a), (b), (c), 0, 0, 0)
__device__ __forceinline__ unsigned cvt2(float a, float b) { const f32x2 v = {a, b}; return __builtin_bit_cast(unsigned, __builtin_convertvector(v, bf16v2)); }

template <int GI>
__device__ __forceinline__ void attn_job(const bf16_t* qk, const bf16_t* vTg, const LAS float* biasL, bf16_t* act, rsrc_t ob, int h, int r, int i0, int lane) {
    constexpr int d = 1 << (2 * GI), SD = S / d;
    int r16 = lane & 15, g = lane >> 4;
    asm volatile("" : "+v"(r16), "+v"(g));
    bf16x8 qf[2][2];
#pragma unroll
    for (int qt = 0; qt < 2; ++qt) { const bf16_t* qp = qk + (size_t)((i0 + 16 * qt + r16) * d + r) * 3072 + GI * 1024 + h * 64 + 8 * g;
#pragma unroll
        for (int ks = 0; ks < 2; ++ks) qf[qt][ks] = *(const bf16x8*)(qp + 32 * ks); }
    f32x4 st[5][2][2];
    bf16x8 kf[5][2][2];
#pragma unroll
    for (int kb = 0; kb < 5; ++kb)
#pragma unroll
        for (int T = 0; T < 2; ++T) {
            int ik = i0 - 128 + 32 * kb + 8 * (r16 >> 2) + 4 * T + (r16 & 3); ik = ik < 0 ? 0 : ik;
            const bf16_t* kp = qk + (size_t)(ik * d + r) * 3072 + GI * 1024 + 512 + h * 64 + 8 * g;
            kf[kb][T][0] = *(const bf16x8*)kp; kf[kb][T][1] = *(const bf16x8*)(kp + 32);
        }
    __builtin_amdgcn_sched_barrier(0);
#pragma unroll
    for (int kb = 0; kb < 5; ++kb)
#pragma unroll
        for (int T = 0; T < 2; ++T)
#pragma unroll
            for (int qt = 0; qt < 2; ++qt) { f32x4 a = {0.f, 0.f, 0.f, 0.f};
                a = __builtin_amdgcn_mfma_f32_16x16x32_bf16(kf[kb][T][0], qf[qt][0], a, 0, 0, 0); a = __builtin_amdgcn_mfma_f32_16x16x32_bf16(kf[kb][T][1], qf[qt][1], a, 0, 0, 0); st[kb][T][qt] = a; }
    const bf16_t* vbase = vTg + (size_t)(h * 64 + r16) * MPV + 128 + (r * SD + i0 - 128 + 8 * g);
    bf16x8 vf[5][4];
#pragma unroll
    for (int kb = 0; kb < 5; ++kb)
#pragma unroll
        for (int dt = 0; dt < 4; ++dt) vf[kb][dt] = *(const bf16x8*)(vbase + (size_t)dt * 16 * MPV + 32 * kb);
    __builtin_amdgcn_sched_barrier(0);
    float mx[2] = {-1e30f, -1e30f};
    const LAS float* bl = biasL + (r16 - 8 * g);
#pragma unroll
    for (int kb = 0; kb < 5; ++kb)
#pragma unroll
        for (int T = 0; T < 2; ++T)
#pragma unroll
            for (int qt = 0; qt < 2; ++qt)
#pragma unroll
                for (int i = 0; i < 4; ++i) {
                    const int jc0 = 128 - 32 * kb + 16 * qt - 4 * T - i;
                    if (kb >= 1 && kb <= 3) st[kb][T][qt][i] += bl[jc0];
                    else { const int jo = jc0 + r16 - 8 * g; const int jc = jo < 0 ? 0 : (jo > 128 ? 128 : jo); st[kb][T][qt][i] += biasL[jc]; }
                }
    __builtin_amdgcn_sched_barrier(0);
#pragma unroll
    for (int T = 0; T < 2; ++T)
#pragma unroll
        for (int qt = 0; qt < 2; ++qt)
#pragma unroll
            for (int i = 0; i < 4; ++i) {
                const int j0 = 128 + 16 * qt + r16 - 8 * g - 4 * T - i, j4 = j0 - 128;
                st[0][T][qt][i] = (j0 <= 128) ? st[0][T][qt][i] : -1e30f;
                st[4][T][qt][i] = (j4 >= 0) ? st[4][T][qt][i] : -1e30f;
            }
    if (i0 < 128) {
#pragma unroll
        for (int kb = 0; kb < 4; ++kb)
#pragma unroll
            for (int T = 0; T < 2; ++T)
#pragma unroll
                for (int qt = 0; qt < 2; ++qt)
#pragma unroll
                    for (int i = 0; i < 4; ++i) { const int ik = i0 - 128 + 32 * kb + 8 * g + 4 * T + i; st[kb][T][qt][i] = (ik >= 0) ? st[kb][T][qt][i] : -1e30f; }
    }
#pragma unroll
    for (int kb = 0; kb < 5; ++kb)
#pragma unroll
        for (int T = 0; T < 2; ++T)
#pragma unroll
            for (int qt = 0; qt < 2; ++qt)
#pragma unroll
                for (int i = 0; i < 4; ++i) mx[qt] = fmaxf(mx[qt], st[kb][T][qt][i]);
    float sum[2];
#pragma unroll
    for (int qt = 0; qt < 2; ++qt) { mx[qt] = fmaxf(mx[qt], __shfl_xor(mx[qt], 16)); mx[qt] = fmaxf(mx[qt], __shfl_xor(mx[qt], 32)); sum[qt] = 0.f; }
#pragma unroll
    for (int kb = 0; kb < 5; ++kb)
#pragma unroll
        for (int T = 0; T < 2; ++T)
#pragma unroll
            for (int qt = 0; qt < 2; ++qt)
#pragma unroll
                for (int i = 0; i < 4; ++i) { const float p = __builtin_amdgcn_exp2f(st[kb][T][qt][i] - mx[qt]); st[kb][T][qt][i] = p; sum[qt] += p; }
#pragma unroll
    for (int qt = 0; qt < 2; ++qt) { sum[qt] += __shfl_xor(sum[qt], 16); sum[qt] += __shfl_xor(sum[qt], 32); }
    f32x4 oa[4][2];
#pragma unroll
    for (int dt = 0; dt < 4; ++dt)
#pragma unroll
        for (int qt = 0; qt < 2; ++qt) oa[dt][qt] = (f32x4){0.f, 0.f, 0.f, 0.f};
#pragma unroll
    for (int kb = 0; kb < 5; ++kb) {
        bf16x8 pf[2];
#pragma unroll
        for (int qt = 0; qt < 2; ++qt) { u32x4 pw; pw.x = cvt2(st[kb][0][qt][0], st[kb][0][qt][1]); pw.y = cvt2(st[kb][0][qt][2], st[kb][0][qt][3]); pw.z = cvt2(st[kb][1][qt][0], st[kb][1][qt][1]); pw.w = cvt2(st[kb][1][qt][2], st[kb][1][qt][3]);
            pf[qt] = __builtin_bit_cast(bf16x8, pw); }
#pragma unroll
        for (int dt = 0; dt < 4; ++dt)
#pragma unroll
            for (int qt = 0; qt < 2; ++qt) oa[dt][qt] = __builtin_amdgcn_mfma_f32_16x16x32_bf16(vf[kb][dt], pf[qt], oa[dt][qt], 0, 0, 0);
    }
#pragma unroll
    for (int qt = 0; qt < 2; ++qt) {
        const int tq = (i0 + 16 * qt + r16) * d + r;
        const float inv = 1.0f / sum[qt], lse = mx[qt] + __log2f(sum[qt]);
        float* scr = (float*)(act + (size_t)tq * FF);
        bf16_t* scb = act + (size_t)tq * FF;
        if (GI > 0) {
#pragma unroll
            for (int dt = 0; dt < 4; ++dt) { const f32x4 v = oa[dt][qt] * inv; u32x2 w; w.x = cvt2(v[0], v[1]); w.y = cvt2(v[2], v[3]); *(u32x2*)(scb + (GI - 1) * 512 + h * 64 + 16 * dt + 4 * g) = w; }
            if (g == 0) scr[1024 + (GI - 1) * 8 + h] = lse;
        } else {
            const float l1 = scr[1024 + h], l2 = scr[1024 + 8 + h];
            f32x4 o1[4], o2[4];
#pragma unroll
            for (int dt = 0; dt < 4; ++dt) { const int dim0 = h * 64 + 16 * dt + 4 * g; const u32x2 p1 = *(const u32x2*)(scb + dim0), p2 = *(const u32x2*)(scb + 512 + dim0);
                o1[dt] = (f32x4){bflo(p1.x), bfhi(p1.x), bflo(p1.y), bfhi(p1.y)}; o2[dt] = (f32x4){bflo(p2.x), bfhi(p2.x), bflo(p2.y), bfhi(p2.y)}; }
            const float mm = fmaxf(fmaxf(lse, l1), l2);
            const float w0 = __builtin_amdgcn_exp2f(lse - mm), w1 = __builtin_amdgcn_exp2f(l1 - mm), w2 = __builtin_amdgcn_exp2f(l2 - mm), iw = 1.0f / (w0 + w1 + w2);
            const float a0 = w0 * inv * iw, a1 = w1 * iw, a2 = w2 * iw;
#pragma unroll
            for (int dt = 0; dt < 4; ++dt) { const int dim0 = h * 64 + 16 * dt + 4 * g; const f32x4 v = oa[dt][qt] * a0 + o1[dt] * a1 + o2[dt] * a2;
                u32x2 w; w.x = cvt2(v[0], v[1]); w.y = cvt2(v[2], v[3]);
                ST8(ob, ((unsigned)tq * 512 + dim0) * 2u, w); }
        }
    }
}
__device__ __forceinline__ float wave_sum(float v) {
#pragma unroll
    for (int o = 1; o < 64; o <<= 1) v += __shfl_xor(v, o);
    return v;
}
__device__ __forceinline__ float wave_max(float v) {
#pragma unroll
    for (int o = 1; o < 64; o <<= 1) v = fmaxf(v, __shfl_xor(v, o));
    return v;
}
__device__ __forceinline__ void sample_attn_group(int g, int b, int h, const bf16_t* qk, const bf16_t* vnew, const float* ck, const float* cv, const float* biasT, LAS float* smp, int lane) {
    const int d = 1 << (2 * g), W = 128 << (2 * g), row = S + b, kq = lane >> 3, dc = lane & 7;
    float q[64];
    { const u32x4* qp = (const u32x4*)(qk + (size_t)row * 3072 + g * 1024 + h * 64);
#pragma unroll
      for (int c = 0; c < 8; ++c) { const u32x4 t = qp[c]; q[8 * c] = bflo(t.x); q[8 * c + 1] = bfhi(t.x); q[8 * c + 2] = bflo(t.y); q[8 * c + 3] = bfhi(t.y); q[8 * c + 4] = bflo(t.z); q[8 * c + 5] = bfhi(t.z); q[8 * c + 6] = bflo(t.w); q[8 * c + 7] = bfhi(t.w); } }
    float sc[3];
#pragma unroll
    for (int rnd = 0; rnd < 3; ++rnd) {
        const int j = lane + 64 * rnd; float s = -1e30f;
        if (j <= 128) { float a = 0.f;
            if (j == 0) { const u32x4* kp = (const u32x4*)(qk + (size_t)row * 3072 + g * 1024 + 512 + h * 64);
#pragma unroll
                for (int c = 0; c < 8; ++c) { const u32x4 t = kp[c]; a += q[8 * c] * bflo(t.x) + q[8 * c + 1] * bfhi(t.x) + q[8 * c + 2] * bflo(t.y) + q[8 * c + 3] * bfhi(t.y) + q[8 * c + 4] * bflo(t.z) + q[8 * c + 5] * bfhi(t.z) + q[8 * c + 6] * bflo(t.w) + q[8 * c + 7] * bfhi(t.w); } }
            else { const f32x4* kp = (const f32x4*)(ck + (((size_t)b * W + (W - j * d)) * 8 + h) * 64);
#pragma unroll
                for (int c = 0; c < 16; ++c) { const f32x4 t = __builtin_nontemporal_load(kp + c); a += q[4 * c] * t.x + q[4 * c + 1] * t.y + q[4 * c + 2] * t.z + q[4 * c + 3] * t.w; } }
            s = a + biasT[(g * 8 + h) * 132 + j]; }
        sc[rnd] = s;
    }
    const float mx = wave_max(fmaxf(fmaxf(sc[0], sc[1]), sc[2]));
    float p[3]; float sum = 0.f;
#pragma unroll
    for (int rnd = 0; rnd < 3; ++rnd) { p[rnd] = (sc[rnd] > -1e29f) ? __builtin_amdgcn_exp2f(sc[rnd] - mx) : 0.f; sum += p[rnd]; }
    sum = wave_sum(sum);
    const float inv = 1.0f / sum;
    float o[8] = {0.f, 0.f, 0.f, 0.f, 0.f, 0.f, 0.f, 0.f};
#pragma unroll
    for (int i = 0; i < 17; ++i) {
        const int j = kq + 8 * i, src = j & 63, rnd = j >> 6;
        const float p0 = __shfl(p[0], src), p1 = __shfl(p[1], src), p2 = __shfl(p[2], src);
        const float pj = (rnd == 0) ? p0 : ((rnd == 1) ? p1 : p2);
        if (j <= 128) {
            if (j == 0) { const u32x4 t = *(const u32x4*)(vnew + (size_t)b * 1536 + g * 512 + h * 64 + 8 * dc);
                o[0] += pj * bflo(t.x); o[1] += pj * bfhi(t.x); o[2] += pj * bflo(t.y); o[3] += pj * bfhi(t.y); o[4] += pj * bflo(t.z); o[5] += pj * bfhi(t.z); o[6] += pj * bflo(t.w); o[7] += pj * bfhi(t.w); }
            else { const f32x4* vp = (const f32x4*)(cv + (((size_t)b * W + (W - j * d)) * 8 + h) * 64 + 8 * dc); const f32x4 t0 = __builtin_nontemporal_load(vp), t1 = __builtin_nontemporal_load(vp + 1);
                o[0] += pj * t0.x; o[1] += pj * t0.y; o[2] += pj * t0.z; o[3] += pj * t0.w; o[4] += pj * t1.x; o[5] += pj * t1.y; o[6] += pj * t1.z; o[7] += pj * t1.w; }
        }
    }
#pragma unroll
    for (int e = 0; e < 8; ++e) { float v = o[e]; v += __shfl_xor(v, 8); v += __shfl_xor(v, 16); v += __shfl_xor(v, 32); if (kq == 0) smp[g * 72 + 8 * dc + e] = v * inv; }
    if (lane == 0) smp[g * 72 + 64] = mx + __log2f(sum);
}

template <int W>
__device__ __forceinline__ void pool_strip(const bf16_t* ub, const float* state_pool, rsrc_t rs_z, int r0, int ch) {
    if (r0 < S) {
        u32x4 raw[16 + W - 1];
#pragma unroll
        for (int i = 0; i < 16 + W - 1; ++i) { const int row = r0 - (W - 1) + i; raw[i] = (row >= 0) ? *(const u32x4*)(ub + (size_t)row * D + ch) : (u32x4){0u, 0u, 0u, 0u}; }
        float run[8] = {0.f, 0.f, 0.f, 0.f, 0.f, 0.f, 0.f, 0.f};
#pragma unroll
        for (int i = 0; i < W - 1; ++i) { run[0] += bflo(raw[i].x); run[1] += bfhi(raw[i].x); run[2] += bflo(raw[i].y); run[3] += bfhi(raw[i].y); run[4] += bflo(raw[i].z); run[5] += bfhi(raw[i].z); run[6] += bflo(raw[i].w); run[7] += bfhi(raw[i].w); }
#pragma unroll
        for (int i = 0; i < 16; ++i) {
            const u32x4 c = raw[i + W - 1]; const float cv[8] = {bflo(c.x), bfhi(c.x), bflo(c.y), bfhi(c.y), bflo(c.z), bfhi(c.z), bflo(c.w), bfhi(c.w)};
#pragma unroll
            for (int e = 0; e < 8; ++e) run[e] += cv[e];
            const int row = r0 + i; const float ic = 1.0f / (float)(W < row + 1 ? W : row + 1);
            u32x4 o; o.x = pk2(run[0] * ic - cv[0], run[1] * ic - cv[1]); o.y = pk2(run[2] * ic - cv[2], run[3] * ic - cv[3]); o.z = pk2(run[4] * ic - cv[4], run[5] * ic - cv[5]); o.w = pk2(run[6] * ic - cv[6], run[7] * ic - cv[7]);
            ST16(rs_z, ((unsigned)row * D + ch) * 2u, o);
            const u32x4 l = raw[i];
            run[0] -= bflo(l.x); run[1] -= bfhi(l.x); run[2] -= bflo(l.y); run[3] -= bfhi(l.y); run[4] -= bflo(l.z); run[5] -= bfhi(l.z); run[6] -= bflo(l.w); run[7] -= bfhi(l.w);
        }
    } else {
#pragma nounroll
        for (int i = 0; i < 16; ++i) {
            const int row = r0 + i; u32x4 o = {0u, 0u, 0u, 0u};
            if (row < MV) {
                const u32x4 c = *(const u32x4*)(ub + (size_t)row * D + ch); const float cv[8] = {bflo(c.x), bfhi(c.x), bflo(c.y), bfhi(c.y), bflo(c.z), bfhi(c.z), bflo(c.w), bfhi(c.w)};
                float a[8];
#pragma unroll
                for (int e = 0; e < 8; ++e) a[e] = cv[e];
                const float* sp = state_pool + (size_t)(row - S) * 15 * D + ch;
#pragma unroll
                for (int k = 1; k < W; ++k) { const f32x4 p0 = *(const f32x4*)(sp + (size_t)(15 - k) * D), p1 = *(const f32x4*)(sp + (size_t)(15 - k) * D + 4);
                    a[0] += p0.x; a[1] += p0.y; a[2] += p0.z; a[3] += p0.w; a[4] += p1.x; a[5] += p1.y; a[6] += p1.z; a[7] += p1.w; }
                const float ic = 1.0f / (float)W;
                o.x = pk2(a[0] * ic - cv[0], a[1] * ic - cv[1]); o.y = pk2(a[2] * ic - cv[2], a[3] * ic - cv[3]); o.z = pk2(a[4] * ic - cv[4], a[5] * ic - cv[5]); o.w = pk2(a[6] * ic - cv[6], a[7] * ic - cv[7]);
            }
            ST16(rs_z, ((unsigned)row * D + ch) * 2u, o);
        }
    }
}

struct Args { const float* in[26]; float* out; unsigned char* ws; };
enum { PH_GU0 = 0, PH_D0, PH_WIN, PH_POOL, PH_GRP, PH_WPO, PH_GU1, PH_D1, PH_GU2, PH_D2, PH_QKV, PH_ATT, PH_WAO, PH_GU3, PH_D3, NPHC };

constexpr int NWAVES = 8, NTHR = 512;
constexpr int LDS_BYTES = 147456;

__device__ __forceinline__ void tr_item(const float* W, int ldw, int k0, int n0, bf16_t* dst, int ldd, const float* kscale, const float* nscale, float f, LAS float* scr, int lane) {
    const rsrc_t rs = mkrs(dst, (size_t)1 << 30);
    float tv[32];
#pragma unroll
    for (int i = 0; i < 32; ++i) { const int kk = 2 * i + (lane >> 5); tv[i] = __builtin_nontemporal_load(W + (size_t)(k0 + kk) * ldw + n0 + (lane & 31)); }
#pragma unroll
    for (int i = 0; i < 32; ++i) { const int kk = 2 * i + (lane >> 5); float v = tv[i]; if (kscale) v *= kscale[k0 + kk]; scr[kk * 33 + (lane & 31)] = v; }
    LDS_WAIT(); asm volatile("" ::: "memory");
    const int c = lane & 7;
#pragma unroll
    for (int j = 0; j < 4; ++j) { const int n = (lane >> 3) + 8 * j; const LAS float* s = scr + (8 * c) * 33 + n; const float fn = nscale ? f * nscale[n0 + n] : f;
        u32x4 o; o.x = pk2(s[0 * 33] * fn, s[1 * 33] * fn); o.y = pk2(s[2 * 33] * fn, s[3 * 33] * fn); o.z = pk2(s[4 * 33] * fn, s[5 * 33] * fn); o.w = pk2(s[6 * 33] * fn, s[7 * 33] * fn);
        ST16(rs, (unsigned)(n * ldd + k0 + 8 * c) * 2u, o); }
    LDS_WAIT(); asm volatile("" ::: "memory");
}
__device__ __forceinline__ int t5_bucket(int dist) {
    if (dist < 16) return dist;
    const int b = 16 + (int)(log((double)dist / 16.0) / log(128.0) * 16.0);
    return b < 31 ? b : 31;
}

#ifndef PM
#define PM 0xffffff
#endif
#define ON(k) if ((PM >> (k)) & 1)
__global__ void __launch_bounds__(NTHR, 2) fwd_kernel(Args args) {
    extern __shared__ __attribute__((aligned(16))) unsigned char lds_raw[];
    LAS unsigned char* lds = (LAS unsigned char*)lds_raw;
    const int tid = threadIdx.x, lane = tid & 63, wave = __builtin_amdgcn_readfirstlane(tid >> 6);
    const int G = gridDim.x, bx = blockIdx.x;
    const int gw = bx * NWAVES + wave, NGW = G * NWAVES;
    const size_t gt = (size_t)bx * NTHR + tid, NGT = (size_t)G * NTHR;
    unsigned char* ws = args.ws; float* out = args.out;
    bf16_t* Wgu = (bf16_t*)(ws + WS_WGU); bf16_t* Wd = (bf16_t*)(ws + WS_WD); bf16_t* Win = (bf16_t*)(ws + WS_WIN); bf16_t* Wgrp = (bf16_t*)(ws + WS_WGRP);
    bf16_t* Wpo = (bf16_t*)(ws + WS_WPO); bf16_t* Wqkv = (bf16_t*)(ws + WS_WQKV); bf16_t* Wao = (bf16_t*)(ws + WS_WAO);
    float* biasT = (float*)(ws + WS_BIAS); float* part = (float*)(ws + WS_PART);
    bf16_t* xb = (bf16_t*)(ws + WS_XB); bf16_t* act = (bf16_t*)(ws + WS_ACT);
    bf16_t* ub = (bf16_t*)(ws + WS_U); bf16_t* zb = (bf16_t*)(ws + WS_Z); bf16_t* z2b = (bf16_t*)(ws + WS_Z2); bf16_t* qk = (bf16_t*)(ws + WS_QK); bf16_t* vT = (bf16_t*)(ws + WS_VT); bf16_t* ob = (bf16_t*)(ws + WS_O); bf16_t* vnew = (bf16_t*)(ws + WS_VNEW);
    const float* x_prompt = args.in[0]; const float* x_sample = args.in[1]; const float* state_pool = args.in[2];
    cg::grid_group grid = cg::this_grid();
    unsigned* ctl = (unsigned*)(ws + WS_CTL);
#define CNT(ph) (ctl + (size_t)(ph) * 72 * 64)
    constexpr size_t QOFF = (size_t)NPHC * 72 * 64 + 1024, QWORDS = (size_t)48 * 8 * 64;

    constexpr int I_GU = 16 * 88, I_D = 44 * 32, I_IN = 16 * 32, I_GRP = 4 * 8, I_QKV = 16 * 144, I_AO = 8 * 32;
#define TR_SCR ((LAS float*)(lds + wave * 16384))
#define CV_FOR(q, OFF_, CNT_) for (int q = gw - (OFF_) + (gw < (OFF_) ? NGW : 0); q < (CNT_); q += NGW)
#define CV_GU(f_, OFF_) CV_FOR(q2, OFF_, 2 * I_GU) { const int f = (f_), up = q2 / I_GU, q = q2 % I_GU, kb = q / 88, nb = q % 88, n0 = nb * 32, layer = f >> 1, second = f & 1; \
        tr_item(args.in[(second ? 22 : 10) + up] + (size_t)layer * D * FF, FF, kb * 64, n0, Wgu + (size_t)f * 2 * FF * D + (size_t)((n0 / 128) * 256 + (n0 % 128) + up * 128) * D, D, \
                args.in[second ? 21 : 9] + layer * D, nullptr, 1.0f, TR_SCR, lane_c); }
#define CV_D(f_, OFF_) CV_FOR(q, OFF_, I_D) { const int f = (f_), kb = q / 32, nb = q % 32, layer = f >> 1, second = f & 1; \
        tr_item(args.in[(second ? 22 : 10) + 2] + (size_t)layer * FF * D, D, kb * 64, nb * 32, Wd + (size_t)f * D * FF + (size_t)(nb * 32) * FF, FF, nullptr, nullptr, 0.5f, TR_SCR, lane_c); }
#define CV_IN(OFF_) CV_FOR(q, OFF_, I_IN) { const int kb = q / 32, nb = q % 32; tr_item(args.in[14], D, kb * 64, nb * 32, Win + (size_t)(nb * 32) * D, D, args.in[13], nullptr, 1.0f, TR_SCR, lane_c); }
#define CV_GRP(OFF_) CV_FOR(q2, OFF_, 4 * I_GRP) { const int gq = q2 / I_GRP, q = q2 % I_GRP, kb = q / 8, nb = q % 8; \
        tr_item(args.in[15] + (size_t)gq * 256 * 256, 256, kb * 64, nb * 32, Wgrp + (size_t)(gq * 256 + nb * 32) * 256, 256, nullptr, args.in[16] + gq * 256, 1.0f, TR_SCR, lane_c); }
#define CV_PO(OFF_) CV_FOR(q, OFF_, I_IN) { const int kb = q / 32, nb = q % 32; tr_item(args.in[17], D, kb * 64, nb * 32, Wpo + (size_t)(nb * 32) * D, D, nullptr, nullptr, 1.0f, TR_SCR, lane_c); }
#define CV_QKV(OFF_) CV_FOR(q, OFF_, I_QKV) { const int kb = q / 144, nb = q % 144, n0 = nb * 32; const float fs = ((n0 % 1536) < 512) ? 0.125f * 1.4426950408889634f : 1.0f; \
        const int gg = n0 / 1536, ss = (n0 % 1536) / 512, he = n0 % 512; const int drow = ss < 2 ? gg * 1024 + ss * 512 + he : 3072 + gg * 512 + he; \
        tr_item(args.in[18], QKVW, kb * 64, n0, Wqkv + (size_t)drow * D, D, args.in[13] + D, nullptr, fs, TR_SCR, lane_c); }
#define CV_AO(OFF_) CV_FOR(q, OFF_, I_AO) { const int kb = q / 32, nb = q % 32; tr_item(args.in[19], D, kb * 64, nb * 32, Wao + (size_t)(nb * 32) * 512, 512, nullptr, nullptr, 1.0f, TR_SCR, lane_c); }
#define WC(c) (ctl + (size_t)NPHC * 72 * 64 + (size_t)(c) * 64)
#define CONV_POINT(c, BODY) do { int lane_c = threadIdx.x; asm volatile("" : "+v"(lane_c)); lane_c &= 63; BODY VM_WAIT(); if (lane_c == 0) __hip_atomic_fetch_add(WC(c), 1u, RLX_AGENT); __syncthreads(); } while (0)
    ON(0) {
        LAS float* scr = (LAS float*)(lds + wave * 16384);
        { const int lane_c = lane; CV_GU(0, 0) CV_D(0, 768) }
        for (int row = gw; row < MP; row += NGW) {
            f32x4 v[4]; float s = 0.f;
            if (row < MV) { const f32x4* xr = (const f32x4*)(row < S ? x_prompt + (size_t)row * D : x_sample + (size_t)(row - S) * D) + lane;
#pragma unroll
                for (int j = 0; j < 4; ++j) { v[j] = __builtin_nontemporal_load(xr + 64 * j); s += (v[j].x * v[j].x + v[j].y * v[j].y) + (v[j].z * v[j].z + v[j].w * v[j].w); } }
            else {
#pragma unroll
                for (int j = 0; j < 4; ++j) v[j] = (f32x4){0.f, 0.f, 0.f, 0.f}; }
            s = wave_sum(s);
            u32x2* o8 = (u32x2*)(xb + (size_t)row * D) + lane;
#pragma unroll
            for (int j = 0; j < 4; ++j) { u32x2 w; w.x = pk2(v[j].x, v[j].y); w.y = pk2(v[j].z, v[j].w); o8[64 * j] = w; }
            if (lane < 4) part[(size_t)row * 4 + lane] = (lane == 0) ? s : 0.f;
        }
        for (size_t i = gt; i < 3 * 8 * 132; i += NGT) { const int j = (int)(i % 132), gh = (int)(i / 132), g = gh / 8, h = gh % 8;
            biasT[i] = (j <= 128) ? 1.4426950408889634f * args.in[20][t5_bucket(j * (1 << (2 * g))) * 24 + g * 8 + h] : 0.f; }
        for (size_t i = gt; i < (size_t)NS * 14 * (D / 4); i += NGT) { const size_t b = i / (14 * (D / 4)), rem = i % (14 * (D / 4));
            ((f32x4*)(out + O_PSS + b * 15 * D))[rem] = ((const f32x4*)(state_pool + b * 15 * D + D))[rem]; }
        for (size_t i = gt; i < QOFF + QWORDS + 4096; i += NGT) ctl[i] = 0u;
        for (size_t i = gt; i < (size_t)(MP - MV) * 64; i += NGT) ((u32x4*)(ob + (size_t)MV * 512))[i] = (u32x4){0u, 0u, 0u, 0u};
    }
    grid.sync();

    const int xcd = bx % 8;
    int q_lo = 0, q_hi = 1 << 30;
    unsigned* qbase = ctl + QOFF; int qi = 0; int sk_id = 0; LAS unsigned* qslot = (LAS unsigned*)(lds + 131072 + 4096);
    CopyJob cjob{args.in, out, bx};
    const rsrc_t rs_act = mkrs(act, (size_t)MP * FF * 2), rs_xb = mkrs(xb, (size_t)MP * D * 2), rs_part = mkrs(part, (size_t)MP * 16);
    LAS float* red = (LAS float*)(lds + 131072);
    const unsigned* wdep_next = nullptr;
#define FLOW_GEMM(EPI_T, EPI_INIT, Aptr, LDA_, Bptr, LDB_, K_, NM_, NN_, APN_, BSIG_, DEP_, NEED_, DEPPN_, DEPSH_, PUB_, PUBPN_) do { \
        pg8::Gemm g{(const bf16_t*)(Aptr), (const bf16_t*)(Bptr), (LDA_), (LDB_), (K_), (APN_), (BSIG_)}; pg8::FlowOrder So; So.init((NM_), (NN_), 2, xcd, qbase, qi, qslot); So.restrict_to(q_lo, q_hi); q_lo = 0; q_hi = 1 << 30; \
        So.dep = (DEP_); So.need = (NEED_); So.need64 = (NEED_); So.dep_pn = (DEPPN_); So.dep_shift = (DEPSH_); So.pub = (PUB_); So.pub_pn = (PUBPN_); So.wdep = wdep_next; So.wneed = (unsigned)NGW; wdep_next = nullptr; \
        EPI_T E EPI_INIT; pg8::gemm_phase<EPI_T, pg8::FlowOrder>(lds, g, So, E); } while (0)
#define SKINNY(EPI_T, EPI_INIT, Aptr, LDA_, Bptr, LDB_, K_, NN_, APN_, DEP_, NEED_, PUB_) do { \
        const pg8::Gemm g{(const bf16_t*)(Aptr), (const bf16_t*)(Bptr), (LDA_), (LDB_), (K_), (APN_), 1}; \
        ++sk_id; \
        for (int j = 0; j < (NN_); ++j) if ((sk_id * 29 + j * 13 + 7) % G == bx) {        \
            EPI_T E EPI_INIT; const unsigned* dp = (DEP_); \
            if (dp) { if (tid < 64) { flow_poll1(dp + (size_t)64 * 64, (NEED_)); __builtin_amdgcn_fence(__ATOMIC_ACQUIRE, "agent"); VM_WAIT(); } } \
            __syncthreads(); skinny_unit<EPI_T>(lds, g, j, E); flow_publish((PUB_) + (size_t)64 * 64); __syncthreads(); } \
        } while (0)
#define SKINNY_Q(EPI_T, EPI_INIT, Aptr, LDA_, Bptr, LDB_, K_, NN_, APN_, DEP_, NEED_, PUB_) do { \
        const pg8::Gemm g{(const bf16_t*)(Aptr), (const bf16_t*)(Bptr), (LDA_), (LDB_), (K_), (APN_), 1}; pg8::FlowOrder So; So.init(1, (NN_), 1, xcd, qbase, qi, qslot); \
        EPI_T E EPI_INIT; Unit u; \
        while (So.next_blocking(u)) { const unsigned* dp = (DEP_); \
            if (dp) { if (tid < 64) { flow_poll1(dp + (size_t)64 * 64, (NEED_)); __builtin_amdgcn_fence(__ATOMIC_ACQUIRE, "agent"); VM_WAIT(); } } \
            __syncthreads(); skinny_unit<EPI_T>(lds, g, u.pn, E); flow_publish((PUB_) + (size_t)64 * 64); } \
        __syncthreads(); } while (0)
#define GU_PHASE(f, DEP_, PH_) do { FLOW_GEMM(EpiGU, ({{}, rs_act, part, &cjob}), xb, D, Wgu + (size_t)(f) * 2 * FF * D, D, D, 64, 22, 0, 1, DEP_, 32u, 0, 0, CNT(PH_), 0); \
        SKINNY(EpiGU, ({{}, rs_act, part, &cjob}), xb, D, Wgu + (size_t)(f) * 2 * FF * D, D, D, 22, 0, DEP_, 32u, CNT(PH_)); } while (0)
#define DN_PHASE(LAST_, RSXO_, f, DEP_, PH_) do { FLOW_GEMM(EpiRes<LAST_>, ({{}, xb, RSXO_, rs_xb, rs_part, red}), act, FF, Wd + (size_t)(f) * D * FF, FF, FF, 64, 4, 0, 1, DEP_, 176u, 0, 0, CNT(PH_), 0); \
        SKINNY(EpiRes<LAST_>, ({{}, xb, RSXO_, rs_xb, rs_part, red}), act, FF, Wd + (size_t)(f) * D * FF, FF, FF, 4, 0, DEP_, 176u, CNT(PH_)); } while (0)

#ifndef PM
#define PM 0xffffff
#endif
    ON(1) GU_PHASE(0, nullptr, PH_GU0);
    CONV_POINT(1, CV_IN(0) CV_GRP(512) CV_PO(640));
    ON(2) DN_PHASE(false, rs_xb, 0, CNT(PH_GU0), PH_D0);
    CONV_POINT(2, CV_GU(1, 0));
    wdep_next = WC(1);
    ON(3) { FLOW_GEMM(EpiU, ({{}, mkrs(ub, (size_t)MP * D * 2), part, out + O_PSP, out + O_PSS}), xb, D, Win, D, D, 64, 4, 0, 1, CNT(PH_D0), 32u, 0, 0, CNT(PH_WIN), 0);
            SKINNY(EpiU, ({{}, mkrs(ub, (size_t)MP * D * 2), part, out + O_PSP, out + O_PSS}), xb, D, Win, D, D, 4, 0, CNT(PH_D0), 32u, CNT(PH_WIN)); }
    ON(4)
    for (int sm = 0; sm < 2; ++sm) {
        pg8::FlowOrder So; So.init(sm ? 1 : 64, 4, sm ? 1 : 2, xcd, qbase, qi, qslot);
        const rsrc_t rs_z = mkrs(zb, (size_t)MP * D * 2);
        Unit u;
        while (So.next_blocking(u)) {
            const int pm = sm ? 64 : u.pm;
            if (tid < 64) { flow_poll1(CNT(PH_WIN) + (size_t)pm * 64, 32u); if (pm > 0 && pm < 64) flow_poll1(CNT(PH_WIN) + (size_t)(pm - 1) * 64, 32u);
                __builtin_amdgcn_fence(__ATOMIC_ACQUIRE, "agent"); VM_WAIT(); }
            __syncthreads();
            {
                const int chunk = tid & 31, strip = tid >> 5, ch = u.pn * 256 + chunk * 8, r0 = pm * 256 + strip * 16;
                if (u.pn == 0) pool_strip<2>(ub, state_pool, rs_z, r0, ch);
                else if (u.pn == 1) pool_strip<4>(ub, state_pool, rs_z, r0, ch);
                else if (u.pn == 2) pool_strip<8>(ub, state_pool, rs_z, r0, ch);
                else pool_strip<16>(ub, state_pool, rs_z, r0, ch);
            }
            flow_publish(CNT(PH_POOL) + (size_t)pm * 64);
        }
    }
    CONV_POINT(3, CV_D(1, 0));
    wdep_next = WC(1);
    ON(5) { FLOW_GEMM(EpiPlain, ({{}, mkrs(z2b, (size_t)MP * D * 2)}), zb, D, Wgrp, 256, 256, 64, 4, 256, 1, CNT(PH_POOL), 32u, 0, 0, CNT(PH_GRP), 0);
            SKINNY(EpiPlain, ({{}, mkrs(z2b, (size_t)MP * D * 2)}), zb, D, Wgrp, 256, 256, 4, 256, CNT(PH_POOL), 32u, CNT(PH_GRP)); }
    wdep_next = WC(1);
    ON(6) { FLOW_GEMM(EpiRes<false>, ({{}, xb, rs_xb, rs_xb, rs_part, red}), z2b, D, Wpo, D, D, 64, 4, 0, 1, CNT(PH_GRP), 32u, 0, 0, CNT(PH_WPO), 0);
            SKINNY(EpiRes<false>, ({{}, xb, rs_xb, rs_xb, rs_part, red}), z2b, D, Wpo, D, D, 4, 0, CNT(PH_GRP), 32u, CNT(PH_WPO)); }
    CONV_POINT(4, CV_GU(2, 0));
    wdep_next = WC(2);
    ON(7) GU_PHASE(1, CNT(PH_WPO), PH_GU1);
    CONV_POINT(5, CV_D(2, 0));
    wdep_next = WC(3);
    ON(8) DN_PHASE(false, rs_xb, 1, CNT(PH_GU1), PH_D1);
    CONV_POINT(6, CV_QKV(0));
    wdep_next = WC(4);
    ON(9) GU_PHASE(2, CNT(PH_D1), PH_GU2);
    CONV_POINT(7, CV_AO(0) CV_GU(3, 256));
    wdep_next = WC(5);
    ON(10) DN_PHASE(false, rs_xb, 2, CNT(PH_GU2), PH_D2);
    CONV_POINT(8, CV_D(3, 0));
    wdep_next = WC(6);
    ON(11) { FLOW_GEMM(EpiQK, ({{}, mkrs(qk, (size_t)MP * 3072 * 2), part, out, mkrs(vnew, (size_t)NS * 1536 * 2)}), xb, D, Wqkv, D, D, 64, 12, 0, 1, CNT(PH_D2), 32u, 0, 0, CNT(PH_QKV), 0);
             SKINNY(EpiQK, ({{}, mkrs(qk, (size_t)MP * 3072 * 2), part, out, mkrs(vnew, (size_t)NS * 1536 * 2)}), xb, D, Wqkv, D, D, 18, 0, CNT(PH_D2), 32u, CNT(PH_QKV)); }
    ON(12)
#pragma unroll
    for (int gi = 0; gi < 3; ++gi)
        FLOW_GEMM(EpiVT, ({mkrs(vT + (size_t)gi * 512 * MPV, (size_t)512 * MPV * 2), part, out, gi, 1 << (2 * gi)}), Wqkv + (size_t)(3072 + gi * 512) * D, D, xb, D, D, 2, 64, 0, 1 << (2 * gi), CNT(PH_D2), 32u, 1, 0, CNT(PH_QKV), 1);
    ON(13) {
        LAS float* biasL = (LAS float*)lds;
        LAS float* smp = (LAS float*)(lds + 2048);
        const rsrc_t rs_o = mkrs(ob, (size_t)MP * 512 * 2);
        pg8::FlowOrder So; So.init(32, 8, 1, xcd, qbase, qi, qslot);
        Unit u;
        while (So.next_blocking(u)) {
            const int sp = u.pm, h = u.pn;
            if (tid < 64) { const int p0 = 2 * sp - 8 < 0 ? 0 : 2 * sp - 8, idx = p0 + lane; unsigned spn = 0;
                for (;;) { const unsigned v = (idx <= 2 * sp + 1) ? __hip_atomic_load(CNT(PH_QKV) + (size_t)idx * 64, RLX_AGENT) : 144u;
                    if (__all(v >= 144u)) break; __builtin_amdgcn_s_sleep(2); if (++spn > FLOW_SPIN_CAP) break; }
                            __builtin_amdgcn_fence(__ATOMIC_ACQUIRE, "agent"); VM_WAIT(); }
            __syncthreads();
            for (int j = tid; j < 3 * 132; j += NTHR) biasL[j] = biasT[((j / 132) * 8 + h) * 132 + (j % 132)];
            __syncthreads();
#pragma nounroll
            for (int k = 0; k < 2; ++k) attn_job<2>(qk, vT + (size_t)2 * 512 * MPV, biasL + 2 * 132, act, rs_o, h, wave + 8 * k, 32 * sp, lane);
#pragma nounroll
            for (int k = 0; k < 2; ++k) attn_job<1>(qk, vT + (size_t)1 * 512 * MPV, biasL + 1 * 132, act, rs_o, h, wave & 3, 128 * sp + 32 * ((wave >> 2) + 2 * k), lane);
            __syncthreads();
#pragma nounroll
            for (int k = 0; k < 2; ++k) attn_job<0>(qk, vT, biasL, act, rs_o, h, 0, 512 * sp + 32 * (wave + 8 * k), lane);
            flow_publish(CNT(PH_ATT) + (size_t)sp * 64);
        }
        pg8::FlowOrder Ss; Ss.init(NS, 8, 1, xcd, qbase, qi, qslot);
        while (Ss.next_blocking(u)) {
            const int b = u.pm, h = u.pn;
            if (tid < 64) { flow_poll1(CNT(PH_QKV) + (size_t)64 * 64, 144u); __builtin_amdgcn_fence(__ATOMIC_ACQUIRE, "agent"); VM_WAIT(); }
            __syncthreads();
            if (wave < 3) sample_attn_group(wave, b, h, qk, vnew, args.in[3 + 2 * wave], args.in[4 + 2 * wave], biasT, smp, lane);
            __syncthreads();
            if (wave == 0 && lane < 32) { const float l0 = smp[64], l1 = smp[72 + 64], l2 = smp[144 + 64], mm = fmaxf(fmaxf(l0, l1), l2);
                const float w0 = __builtin_amdgcn_exp2f(l0 - mm), w1 = __builtin_amdgcn_exp2f(l1 - mm), w2 = __builtin_amdgcn_exp2f(l2 - mm), iw = 1.0f / (w0 + w1 + w2);
                const float r0 = (w0 * smp[2 * lane] + w1 * smp[72 + 2 * lane] + w2 * smp[144 + 2 * lane]) * iw, r1 = (w0 * smp[2 * lane + 1] + w1 * smp[72 + 2 * lane + 1] + w2 * smp[144 + 2 * lane + 1]) * iw;
                ST4(rs_o, ((unsigned)(S + b) * 512 + h * 64 + 2 * lane) * 2u, pk2(r0, r1)); }
            flow_publish(CNT(PH_ATT) + (size_t)32 * 64);
        }
        __syncthreads();
    }
    wdep_next = WC(7);
    ON(14) { FLOW_GEMM(EpiRes<false>, ({{}, xb, rs_xb, rs_xb, rs_part, red}), ob, 512, Wao, 512, 512, 64, 4, 0, 1, CNT(PH_ATT), 64u, 0, 1, CNT(PH_WAO), 0);
             SKINNY(EpiRes<false>, ({{}, xb, rs_xb, rs_xb, rs_part, red}), ob, 512, Wao, 512, 512, 4, 0, CNT(PH_ATT) - (size_t)32 * 64, (unsigned)(NS * 8 * 8), CNT(PH_WAO)); }
    wdep_next = WC(7);
    ON(15) { FLOW_GEMM(EpiGU, ({{}, rs_act, part, &cjob}), xb, D, Wgu + (size_t)3 * 2 * FF * D, D, D, 64, 22, 0, 1, CNT(PH_WAO), 32u, 0, 0, CNT(PH_GU3), 0);
             SKINNY_Q(EpiGU, ({{}, rs_act, part, &cjob}), xb, D, Wgu + (size_t)3 * 2 * FF * D, D, D, 22, 0, CNT(PH_WAO), 32u, CNT(PH_GU3)); }
    wdep_next = WC(8);
    ON(16) {
             q_hi = 24; FLOW_GEMM(EpiRes<false>, ({{}, xb, rs_xb, rs_xb, rs_part, red}), act, FF, Wd + (size_t)3 * D * FF, FF, FF, 64, 4, 0, 1, CNT(PH_GU3), 176u, 0, 0, CNT(PH_D3), 0);
             q_lo = 24; wdep_next = WC(8);
             FLOW_GEMM(EpiPark, ({ctl + QOFF + QWORDS, (float*)(ws + WS_XF)}), act, FF, Wd + (size_t)3 * D * FF, FF, FF / 2, 64, 4, 0, 1, CNT(PH_GU3), 176u, 0, 0, CNT(PH_D3), 0);
             q_lo = 24; wdep_next = WC(8);
             FLOW_GEMM(EpiMerge, ({{{}, xb, rs_xb, rs_xb, rs_part, red}, ctl + QOFF + QWORDS, (const float*)(ws + WS_XF)}), act + FF / 2, FF, Wd + (size_t)3 * D * FF + FF / 2, FF, FF / 2, 64, 4, 0, 1, CNT(PH_GU3), 176u, 0, 0, CNT(PH_D3), 0);
             SKINNY_Q(EpiRes<false>, ({{}, xb, rs_xb, rs_xb, rs_part, red}), act, FF, Wd + (size_t)3 * D * FF, FF, FF, 4, 0, CNT(PH_GU3), 176u, CNT(PH_D3)); }
    ON(17) {
        pg8::FlowOrder So; So.init(NPANEL, 4, 1, xcd, qbase, qi, qslot);
        const float* gf = args.in[25]; Unit u;
        while (So.next_blocking(u)) {
            if (tid < 64) { flow_poll1(CNT(PH_D3) + (size_t)u.pm * 64, 32u); __builtin_amdgcn_fence(__ATOMIC_ACQUIRE, "agent"); VM_WAIT(); }
            __syncthreads();
            u32x2 xw[8][4]; float rsv[8];
#pragma unroll
            for (int k = 0; k < 8; ++k) { int row = u.pm * 256 + u.pn * 64 + wave + 8 * k; if (row >= MV) row = MV - 1;
                rsv[k] = rstd_of(part, row); const u32x2* xr = (const u32x2*)(xb + (size_t)row * D) + lane;
#pragma unroll
                for (int j = 0; j < 4; ++j) xw[k][j] = xr[64 * j]; }
            f32x4 gg[4];
#pragma unroll
            for (int j = 0; j < 4; ++j) gg[j] = ((const f32x4*)gf + lane)[64 * j];
#pragma unroll
            for (int k = 0; k < 8; ++k) { const int row = u.pm * 256 + u.pn * 64 + wave + 8 * k;
                if (row < MV) { f32x4* xr = (f32x4*)(out + (size_t)row * D) + lane;
#pragma unroll
                    for (int j = 0; j < 4; ++j) { const f32x4 xv = {bflo(xw[k][j].x), bfhi(xw[k][j].x), bflo(xw[k][j].y), bfhi(xw[k][j].y)}; __builtin_nontemporal_store(xv * rsv[k] * gg[j], xr + 64 * j); } } }
        }
    }
    for (int chunk = cjob.next; chunk < CP_CHUNKS; chunk += 256) {
#pragma unroll
        for (int q = 0; q < 4; ++q) { const f32x4* src; f32x4* dst; if (cp_addr(args.in, out, chunk * 32 + wave * 4 + q, lane, src, dst)) { const f32x4 a0 = __builtin_nontemporal_load(src), a1 = __builtin_nontemporal_load(src + 64); __builtin_nontemporal_store(a0, dst); __builtin_nontemporal_store(a1, dst + 64); } }
    }
}

extern "C" void kernel_launch(void* const* d_in, const int* in_sizes, int n_in, void* d_out, int out_size, void* d_ws, size_t ws_size, hipStream_t stream) {
    static int grid = 0;
    if (grid == 0) {
        if (n_in != 26 || (size_t)out_size != OUT_TOTAL || ws_size < WS_END) { fprintf(stderr, "kernel_launch: unexpected shapes: n_in %d out %d (want %zu) ws %zu (need %zu)\n", n_in, out_size, (size_t)OUT_TOTAL, ws_size, (size_t)WS_END); grid = -1; return; }
        int dev = 0, cus = 0, per_cu = 0;
        hipGetDevice(&dev); hipDeviceGetAttribute(&cus, hipDeviceAttributeMultiprocessorCount, dev);
        hipFuncSetAttribute((const void*)fwd_kernel, hipFuncAttributeMaxDynamicSharedMemorySize, LDS_BYTES);
        hipOccupancyMaxActiveBlocksPerMultiprocessor(&per_cu, (const void*)fwd_kernel, NTHR, LDS_BYTES);
        if (per_cu < 1) { fprintf(stderr, "kernel_launch: occupancy query says %d blocks per CU\n", per_cu); per_cu = 1; }
        grid = cus;
        (void)hipGetLastError();
    }
    if (grid < 0) return;
    Args a{};
    for (int i = 0; i < 26; ++i) a.in[i] = (const float*)d_in[i];
    a.out = (float*)d_out; a.ws = (unsigned char*)d_ws;
    void* kargs[] = {&a};
    hipError_t e = hipLaunchCooperativeKernel((const void*)fwd_kernel, dim3(grid), dim3(NTHR), kargs, LDS_BYTES, stream);
    if (e != hipSuccess) fprintf(stderr, "cooperative launch failed: %s (grid %d)\n", hipGetErrorString(e), grid);
}
```

```cpp
#include <hip/hip_runtime.h>
#include <hip/hip_cooperative_groups.h>
#include <cstdio>
#include <cstdint>
namespace cg = cooperative_groups;


#define LAS __attribute__((address_space(3)))
typedef unsigned short bf16_t;
typedef short bf16x8 __attribute__((ext_vector_type(8)));
typedef float f32x4 __attribute__((ext_vector_type(4)));
typedef float f32x2 __attribute__((ext_vector_type(2)));
typedef unsigned u32x4 __attribute__((ext_vector_type(4)));
typedef unsigned u32x2 __attribute__((ext_vector_type(2)));

constexpr int D = 1024, S = 16384, NS = 32, FF = 2816, MP = 16640, NPANEL = 65, MV = S + NS;
constexpr int QKVW = 4608;
constexpr int MPV = MP + 128;
constexpr float EPS = 1e-6f;

__device__ __forceinline__ unsigned f2bf(float f) { unsigned u = __builtin_bit_cast(unsigned, f); return (u + 0x7fffu + ((u >> 16) & 1u)) >> 16; }
__device__ __forceinline__ unsigned pk2(float lo, float hi) { return f2bf(lo) | (f2bf(hi) << 16); }
__device__ __forceinline__ float bf2f(unsigned short b) { return __builtin_bit_cast(float, ((unsigned)b) << 16); }
__device__ __forceinline__ float bflo(unsigned w) { return __builtin_bit_cast(float, w << 16); }
__device__ __forceinline__ float bfhi(unsigned w) { return __builtin_bit_cast(float, w & 0xffff0000u); }
#define LDS_WAIT() asm volatile("s_waitcnt lgkmcnt(0)" ::: "memory")
#define VM_WAIT() asm volatile("s_waitcnt vmcnt(0)" ::: "memory")
typedef __amdgpu_buffer_rsrc_t rsrc_t;
__device__ __forceinline__ rsrc_t mkrs(const void* p, size_t bytes) { return __builtin_amdgcn_make_buffer_rsrc((void*)p, 0, (int)bytes, 0x00020000); }
#define ST16(rs, off, v) __builtin_amdgcn_raw_buffer_store_b128((v), (rs), (unsigned)(off), 0, 16)
#define ST8(rs, off, v) __builtin_amdgcn_raw_buffer_store_b64((v), (rs), (unsigned)(off), 0, 16)
#define ST4(rs, off, v) __builtin_amdgcn_raw_buffer_store_b32((v), (rs), (unsigned)(off), 0, 16)
#define F4U(v) __builtin_bit_cast(u32x4, (v))
#define RLX_AGENT __ATOMIC_RELAXED, __HIP_MEMORY_SCOPE_AGENT

namespace pg8 {
constexpr int BM = 256, BK = 64, HALF = 128, HTB = HALF * BK * 2, STAGE_BYTES = 8 * HTB, NXCD = 8, WGM = 8;
__host__ __device__ __forceinline__ int lds_byte(int r, int c) { const int st = (r >> 4) * 2 + (c >> 5), rr = r & 15, cc = c & 31, ob = rr * 64 + cc * 2; return st * 1024 + (ob ^ (((ob >> 9) & 1) << 5)); }
__host__ __device__ __forceinline__ void stage_rc(int b, int& R, int& C) { const int st = b / 1024, sb = b % 1024, swz = sb ^ (((sb >> 9) & 1) << 5); R = (st >> 1) * 16 + swz / 64; C = (st & 1) * 32 + (swz % 64) / 2; }
__host__ __device__ __forceinline__ int perm32(int rho) { const int n = rho >> 4, i = rho & 15; return 8 * (i >> 2) + 4 * n + (i & 3); }
__host__ __device__ __forceinline__ int sigma_row(int d, int v) { const int q = 256 / d; return (v % q) * d + v / q; }

struct Unit { int pm, pn; };
struct Gemm { const bf16_t* A; const bf16_t* Bt; int lda, ldb, K, a_pn, bsig; };

#define FLOW_SPIN_CAP (1u << 21)
__device__ __forceinline__ void flow_poll1(const unsigned* c, unsigned need) {
    unsigned sp = 0;
    while ((unsigned)__builtin_amdgcn_readfirstlane(__hip_atomic_load(c, RLX_AGENT)) < need) { __builtin_amdgcn_s_sleep(2); if (++sp > FLOW_SPIN_CAP) break; }
}
__device__ __forceinline__ void flow_publish(unsigned* c) {
    asm volatile("s_waitcnt vmcnt(0)" ::: "memory");
    if ((threadIdx.x & 63) == 0) __hip_atomic_fetch_add(c, 1u, RLX_AGENT);
}
struct FlowOrder {
    int nM, nN, wgm, base, nx;
    unsigned* head;
    LAS unsigned* slot;
    unsigned claimed;
    const unsigned* wdep; unsigned wneed;
    const unsigned* dep; unsigned need, need64; int dep_pn, dep_shift;
    unsigned* pub; int pub_pn;
    __device__ __forceinline__ void init(int nM_, int nN_, int wgm_, int xcd, unsigned* qbase, int& qi, LAS unsigned* slot_) {
        nM = nM_; nN = nN_; wgm = wgm_;
        const int nwg = nM * nN, q = nwg / NXCD, r = nwg % NXCD;
        nx = q + (xcd < r ? 1 : 0); base = xcd < r ? xcd * (q + 1) : r * (q + 1) + (xcd - r) * q;
        head = qbase + (size_t)(qi * NXCD + xcd) * 64; ++qi; slot = slot_; claimed = 0u;
        wdep = nullptr; wneed = 0; dep = nullptr; need = 0; need64 = 0; dep_pn = 0; dep_shift = 0; pub = nullptr; pub_pn = 0;
    }
    __device__ __forceinline__ bool decode(unsigned l, Unit& u) const {
        if (l >= (unsigned)nx) return false;
        const int wgid = base + (int)l, nig = wgm * nN, gid = wgid / nig, fm = gid * wgm, gsz = (nM - fm) < wgm ? (nM - fm) : wgm;
        u.pm = fm + ((wgid % nig) % gsz); u.pn = (wgid % nig) / gsz; return true;
    }
    __device__ __forceinline__ bool next_blocking(Unit& u) {
        __syncthreads();
        if (threadIdx.x == 0) { const unsigned tk = __hip_atomic_fetch_add(head, 1u, RLX_AGENT);
            if (wdep) { unsigned sp = 0; while (__hip_atomic_load(wdep, RLX_AGENT) < wneed) { __builtin_amdgcn_s_sleep(2); if (++sp > FLOW_SPIN_CAP) break; } }
            *slot = tk; }
        __syncthreads();
        return decode(*slot, u);
    }
    __device__ __forceinline__ void claim_issue() { if (threadIdx.x == 0) claimed = __hip_atomic_fetch_add(head, 1u, RLX_AGENT); }
    __device__ __forceinline__ bool ready_next(Unit& u) {
        if (threadIdx.x < 64) {
            const unsigned l = (unsigned)__builtin_amdgcn_readfirstlane((int)claimed);
            Unit t; const bool ok = decode(l, t);
            if (ok && dep) { const int panel = dep_pn ? t.pn : t.pm;
                flow_poll1(dep + (size_t)(panel >> dep_shift) * 64, panel == 64 ? need64 : need);
                __builtin_amdgcn_fence(__ATOMIC_ACQUIRE, "agent");
                asm volatile("s_waitcnt vmcnt(0)" ::: "memory"); }
            if (threadIdx.x == 0) *slot = l;
        }
        asm volatile("s_waitcnt lgkmcnt(0)" ::: "memory"); __builtin_amdgcn_s_barrier(); asm volatile("" ::: "memory");
        return decode(*slot, u);
    }
    __device__ __forceinline__ void a_ready(const Unit& u) const {
        if (dep) {
            if (threadIdx.x < 64) { const int panel = dep_pn ? u.pn : u.pm;
                flow_poll1(dep + (size_t)(panel >> dep_shift) * 64, panel == 64 ? need64 : need);
                __builtin_amdgcn_fence(__ATOMIC_ACQUIRE, "agent");
                asm volatile("s_waitcnt vmcnt(0)" ::: "memory"); }
            asm volatile("" ::: "memory"); __builtin_amdgcn_s_barrier(); asm volatile("" ::: "memory");
        }
    }
    __device__ __forceinline__ void done(const Unit& u) const { if (pub) flow_publish(pub + (size_t)(pub_pn ? u.pn : u.pm) * 64); }
};

__device__ __forceinline__ unsigned cvt_pk_bf16(float lo, float hi) { unsigned r; asm volatile("v_cvt_pk_bf16_f32 %0, %1, %2" : "=v"(r) : "v"(lo), "v"(hi)); return r; }

template <class Epi, class Sched>
__device__ __forceinline__ void gemm_phase(LAS unsigned char* lds, const Gemm g, Sched& S, const Epi& E) {
    int tid = threadIdx.x; asm volatile("" : "+v"(tid));
    const int wid = __builtin_amdgcn_readfirstlane(tid >> 6), lane = tid & 63, wr = wid >> 2, wc = wid & 3, fr = lane & 15, fq = lane >> 4;
    const int K = g.K, nt = K / BK;
    unsigned voffA[2], voffB[2];
#pragma unroll
    for (int i = 0; i < 2; ++i) { int R, C; stage_rc(tid * 16 + i * 8192, R, C); const int Rb = sigma_row(g.bsig, (R & ~31) + perm32(R & 31));
        voffA[i] = (unsigned)(R * g.lda + C) * 2u; voffB[i] = (unsigned)(Rb * g.ldb + C) * 2u; }
    const size_t kstep = (size_t)(BK * 2);
    const size_t hstepA = (size_t)HALF * g.lda * 2, hstepB = (size_t)sigma_row(g.bsig, HALF) * g.ldb * 2;
    const size_t tstepA = 2 * hstepA, tstepB = (size_t)BM * g.ldb * 2;
    const unsigned ldsw = (unsigned)wid * 1024u;
    const int aoff = lds_byte(wr * 64 + fr, fq * 8), boff = lds_byte(wc * 32 + fr, fq * 8);
#define PG8_SA(b, h) (((b) * 2 + (h)) * HTB)
#define PG8_SB(b, h) ((4 + (b) * 2 + (h)) * HTB)
#define PG8_STAGE(bufoff, gbase, voff) do { _Pragma("unroll") for (int _i = 0; _i < 2; ++_i) \
        __builtin_amdgcn_global_load_lds((const unsigned*)((const char*)(gbase) + (voff)[_i]), (LAS unsigned*)(lds + (bufoff) + ldsw + _i * 8192), 16, 0, 0); } while (0)
#define PG8_LDA(dst, b, h) do { _Pragma("unroll") for (int m = 0; m < 4; ++m) _Pragma("unroll") for (int k = 0; k < 2; ++k) dst[m][k] = *(const LAS bf16x8*)(lds + PG8_SA(b, h) + aoff + m * 2048 + k * 1024); } while (0)
#define PG8_LDB(dst, b, h) do { _Pragma("unroll") for (int n = 0; n < 2; ++n) _Pragma("unroll") for (int k = 0; k < 2; ++k) dst[n][k] = *(const LAS bf16x8*)(lds + PG8_SB(b, h) + boff + n * 2048 + k * 1024); } while (0)
#define PG8_MMA(ai, bj, At, Bt) do { __builtin_amdgcn_s_setprio(1); _Pragma("unroll") for (int m = 0; m < 4; ++m) _Pragma("unroll") for (int n = 0; n < 2; ++n) _Pragma("unroll") for (int k = 0; k < 2; ++k) \
        acc[ai][bj][m][n] = __builtin_amdgcn_mfma_f32_16x16x32_bf16(Bt[n][k], At[m][k], acc[ai][bj][m][n], 0, 0, 0); __builtin_amdgcn_s_setprio(0); } while (0)
#define PG8_WAIT_V(n) asm volatile("s_waitcnt vmcnt(" #n ")" ::: "memory")
#define PG8_WAIT_L(n) asm volatile("s_waitcnt lgkmcnt(" #n ")" ::: "memory")
#define PG8_BAR __builtin_amdgcn_s_barrier()
#define PG8_SCHED __builtin_amdgcn_sched_barrier(0)
    Unit cur, nxt; int ui = 0;
    if (!S.next_blocking(cur)) return;
    f32x4 acc[2][2][4][2];
#pragma unroll
    for (int a = 0; a < 2; ++a)
#pragma unroll
        for (int b = 0; b < 2; ++b)
#pragma unroll
            for (int m = 0; m < 4; ++m)
#pragma unroll
                for (int n = 0; n < 2; ++n) acc[a][b][m][n] = (f32x4){0.f, 0.f, 0.f, 0.f};
    bf16x8 At[4][2], B0[2][2], B1[2][2];
    const char* cA = (const char*)g.A + (size_t)cur.pm * tstepA + (size_t)cur.pn * g.a_pn * 2; const char* cB = (const char*)g.Bt + (size_t)cur.pn * tstepB;
    PG8_STAGE(PG8_SB(0, 0), cB, voffB); PG8_STAGE(PG8_SB(0, 1), cB + hstepB, voffB);
    S.a_ready(cur);
    PG8_STAGE(PG8_SA(0, 0), cA, voffA); PG8_STAGE(PG8_SA(0, 1), cA + hstepA, voffA);
    if (wr == 1) PG8_BAR;
    PG8_WAIT_V(2); PG8_BAR;
    PG8_STAGE(PG8_SB(1, 0), cB + kstep, voffB); PG8_STAGE(PG8_SA(1, 0), cA + kstep, voffA); PG8_STAGE(PG8_SB(1, 1), cB + hstepB + kstep, voffB);
    PG8_WAIT_V(6); PG8_BAR;
    for (;;) {
        bool has_next = false; const char* nA = cA; const char* nB = cB;
        const int t_claim = nt >= 4 ? nt - 4 : 0;
#pragma nounroll
        for (int t = 0; t < nt; t += 2) {
            const bool last = (t == nt - 2);
            const char* a1 = cA + (size_t)(t + 1) * kstep;
            if (t == t_claim) S.claim_issue();
            if (last) { has_next = S.ready_next(nxt);
                if (has_next) { nA = (const char*)g.A + (size_t)nxt.pm * tstepA + (size_t)nxt.pn * g.a_pn * 2; nB = (const char*)g.Bt + (size_t)nxt.pn * tstepB; } }
            const char* a2 = last ? nA : cA + (size_t)(t + 2) * kstep; const char* b2 = last ? nB : cB + (size_t)(t + 2) * kstep;
            const char* a3 = a2 + kstep; const char* b3 = b2 + kstep;
            PG8_LDB(B0, 0, 0); PG8_LDB(B1, 0, 1); PG8_SCHED; PG8_LDA(At, 0, 0); PG8_STAGE(PG8_SA(1, 1), a1 + hstepA, voffA);
            PG8_WAIT_V(8); PG8_WAIT_L(0); PG8_BAR; PG8_MMA(0, 0, At, B0); PG8_MMA(0, 1, At, B1); PG8_BAR; PG8_SCHED;
            PG8_LDA(At, 0, 1); PG8_STAGE(PG8_SB(0, 0), b2, voffB); PG8_STAGE(PG8_SB(0, 1), b2 + hstepB, voffB); PG8_STAGE(PG8_SA(0, 0), a2, voffA);
            PG8_WAIT_V(8); PG8_WAIT_L(0); PG8_BAR; PG8_MMA(1, 0, At, B0); PG8_MMA(1, 1, At, B1); PG8_BAR; PG8_SCHED;
            PG8_LDB(B0, 1, 0); PG8_LDB(B1, 1, 1); PG8_SCHED; PG8_LDA(At, 1, 0); PG8_STAGE(PG8_SA(0, 1), a2 + hstepA, voffA);
            PG8_WAIT_V(8); PG8_WAIT_L(0); PG8_BAR; PG8_MMA(0, 0, At, B0); PG8_MMA(0, 1, At, B1); PG8_BAR; PG8_SCHED;
            PG8_LDA(At, 1, 1); PG8_STAGE(PG8_SB(1, 0), b3, voffB); PG8_STAGE(PG8_SB(1, 1), b3 + hstepB, voffB); PG8_STAGE(PG8_SA(1, 0), a3, voffA);
            PG8_WAIT_V(8); PG8_WAIT_L(0); PG8_BAR; PG8_MMA(1, 0, At, B0); PG8_MMA(1, 1, At, B1); PG8_BAR; PG8_SCHED;
        }
        if (wr == 0) PG8_BAR;
        E(acc, cur, wr, wc, fr, fq); S.done(cur);
        if (!has_next) break;
#pragma unroll
        for (int a = 0; a < 2; ++a)
#pragma unroll
            for (int b = 0; b < 2; ++b)
#pragma unroll
                for (int m = 0; m < 4; ++m)
#pragma unroll
                    for (int n = 0; n < 2; ++n) acc[a][b][m][n] = (f32x4){0.f, 0.f, 0.f, 0.f};
        cur = nxt; cA = nA; cB = nB; ++ui;
        if (wr == 1) PG8_BAR;
    }
    PG8_WAIT_V(0);
    PG8_BAR;
#undef PG8_SA
#undef PG8_SB
#undef PG8_STAGE
#undef PG8_LDA
#undef PG8_LDB
#undef PG8_MMA
#undef PG8_WAIT_V
#undef PG8_WAIT_L
#undef PG8_BAR
#undef PG8_SCHED
}
}
using pg8::Unit;
using pg8::cvt_pk_bf16;
using pg8::flow_poll1;
using pg8::flow_publish;

constexpr size_t MiB = 1u << 20;
constexpr size_t al(size_t x) { return (x + 4095) & ~(size_t)4095; }
constexpr size_t WS_CTL = 0;
constexpr size_t WS_WGU = 1 * MiB;
constexpr size_t SZ_WGU = (size_t)2 * FF * D * 2;
constexpr size_t WS_WD = WS_WGU + 4 * SZ_WGU;
constexpr size_t SZ_WD = (size_t)D * FF * 2;
constexpr size_t WS_WIN = WS_WD + 4 * SZ_WD;
constexpr size_t WS_WGRP = WS_WIN + (size_t)D * D * 2;
constexpr size_t WS_WPO = WS_WGRP + (size_t)D * 256 * 2;
constexpr size_t WS_WQKV = WS_WPO + (size_t)D * D * 2;
constexpr size_t WS_WAO = WS_WQKV + (size_t)QKVW * D * 2;
constexpr size_t WS_BIAS = WS_WAO + (size_t)D * 512 * 2;
constexpr size_t WS_PART = al(WS_BIAS + 3 * 8 * 132 * 4);
constexpr size_t WS_XB = al(WS_PART + (size_t)MP * 4 * 4);
constexpr size_t WS_XF = WS_XB + (size_t)MP * D * 2;
constexpr size_t WS_ACT = WS_XF + (size_t)MP * D * 4;
constexpr size_t WS_U = WS_ACT + (size_t)MP * FF * 2;
constexpr size_t WS_Z = WS_U + (size_t)MP * D * 2;
constexpr size_t WS_Z2 = WS_Z + (size_t)MP * D * 2;
constexpr size_t WS_QK = WS_Z2 + (size_t)MP * D * 2;
constexpr size_t WS_VT = WS_QK + (size_t)MP * 3072 * 2;
constexpr size_t WS_O = WS_VT + (size_t)3 * 512 * MPV * 2;
constexpr size_t WS_VNEW = WS_O + (size_t)MP * 512 * 2;
constexpr size_t WS_END = WS_VNEW + (size_t)NS * 1536 * 2;

constexpr size_t O_YP = 0, O_YS = (size_t)S * D, O_PSP = O_YS + (size_t)NS * D, O_PSS = O_PSP + 15 * D, O_KV0 = O_PSS + (size_t)NS * 15 * D;
__host__ __device__ constexpr size_t kv_group_base(int g) {
    size_t o = O_KV0;
    for (int i = 0; i < g; ++i) { const size_t W = (size_t)128 << (2 * i); o += 2 * W * 512 + 2 * (size_t)NS * W * 512; }
    return o;
}
constexpr size_t OUT_TOTAL = kv_group_base(3);

constexpr int CP_ROWS_TOTAL = 2 * NS * (127 + 511 + 2047);
constexpr int CP_CHUNKS = (CP_ROWS_TOTAL + 31) / 32;
__device__ __forceinline__ bool cp_addr(const float* const* in, float* out, int rho, int lane, const f32x4*& src, f32x4*& dst) {
    if (rho >= CP_ROWS_TOTAL) return false;
    int g = 0, kv = 0, rem = rho;
    if (rem >= 2 * NS * 127) { rem -= 2 * NS * 127; g = 1; if (rem >= 2 * NS * 511) { rem -= 2 * NS * 511; g = 2; } }
    const int W = 128 << (2 * g), per = NS * (W - 1);
    if (rem >= per) { rem -= per; kv = 1; }
    const int b = rem / (W - 1), t = rem % (W - 1);
    src = (const f32x4*)in[3 + 2 * g + kv] + ((size_t)b * W + t + 1) * 128 + lane;
    dst = (f32x4*)(out + kv_group_base(g) + 2 * (size_t)W * 512 + (size_t)kv * NS * W * 512) + ((size_t)b * W + t) * 128 + lane;
    return true;
}
struct CopyJob { const float* const* in; float* out; int next; };

__device__ __forceinline__ float rstd_of(const float* part, int row) {
    const f32x4 a = *(const f32x4*)(part + (size_t)row * 4);
    return __builtin_amdgcn_rsqf(((a.x + a.y) + (a.z + a.w)) * (1.0f / D) + EPS);
}
__device__ __forceinline__ float silu_mul(float g, float u) { return g * __builtin_amdgcn_rcpf(1.0f + __expf(-g)) * u; }
__device__ __forceinline__ u32x4 pack8(const f32x4 v0, const f32x4 v1) { u32x4 w; w.x = cvt_pk_bf16(v0[0], v0[1]); w.y = cvt_pk_bf16(v0[2], v0[3]); w.z = cvt_pk_bf16(v1[0], v1[1]); w.w = cvt_pk_bf16(v1[2], v1[3]); return w; }

template <class Derived> struct EpiBase {
    __device__ __forceinline__ void operator()(f32x4 (&acc)[2][2][4][2], const Unit& u, int wr, int wc, int fr, int fq) const {
        const Derived& self = *static_cast<const Derived*>(this);
        const int row0 = u.pm * 256 + wr * 64 + fr;
        float ctx[2][4];
#pragma unroll
        for (int ai = 0; ai < 2; ++ai)
#pragma unroll
            for (int m = 0; m < 4; ++m) ctx[ai][m] = self.pre_row(acc[ai][0][m], acc[ai][1][m], row0 + ai * 128 + m * 16, u.pn, wc, fq);
        __builtin_amdgcn_sched_barrier(0);
#pragma unroll
        for (int ai = 0; ai < 2; ++ai)
#pragma unroll
            for (int m = 0; m < 4; ++m) { const f32x4 v[2][2] = {{acc[ai][0][m][0], acc[ai][0][m][1]}, {acc[ai][1][m][0], acc[ai][1][m][1]}};
                self.row_op(v, row0 + ai * 128 + m * 16, u.pn, wc, fq, ai * 128 + wr * 64 + m * 16 + fr, ctx[ai][m]); }
        self.finish(u.pm, u.pn, 256);
    }
    __device__ __forceinline__ void small(f32x4 (&accS)[2][2][2], int pn, int wc, int fr, int fq, bool active) const {
        const Derived& self = *static_cast<const Derived*>(this);
        if (active) {
            float ctx[2];
#pragma unroll
            for (int m = 0; m < 2; ++m) ctx[m] = self.pre_row(accS[0][m], accS[1][m], S + m * 16 + fr, pn, wc, fq);
            __builtin_amdgcn_sched_barrier(0);
#pragma unroll
            for (int m = 0; m < 2; ++m) { const f32x4 v[2][2] = {{accS[0][m][0], accS[0][m][1]}, {accS[1][m][0], accS[1][m][1]}};
                self.row_op(v, S + m * 16 + fr, pn, wc, fq, m * 16 + fr, ctx[m]); }
        }
        self.finish(64, pn, 32);
    }
    __device__ __forceinline__ void finish(int, int, int) const {}
};

struct EpiGU : EpiBase<EpiGU> {
    rsrc_t act; const float* part; CopyJob* cj;
    __device__ __forceinline__ float pre_row(f32x4 (&)[2], f32x4 (&)[2], int row, int, int, int) const { return rstd_of(part, row); }
    __device__ __forceinline__ u32x4 silu_pack(const f32x4 (&v)[2][2], float rs) const {
        const float c = -1.4426950408889634f * rs, r2 = rs * rs;
        f32x4 o0, o1;
#pragma unroll
        for (int e = 0; e < 4; ++e) { o0[e] = (v[0][0][e] * v[1][0][e]) * (r2 * __builtin_amdgcn_rcpf(1.0f + __builtin_amdgcn_exp2f(v[0][0][e] * c))); o1[e] = (v[0][1][e] * v[1][1][e]) * (r2 * __builtin_amdgcn_rcpf(1.0f + __builtin_amdgcn_exp2f(v[0][1][e] * c))); }
        return pack8(o0, o1);
    }
    __device__ __forceinline__ void row_op(const f32x4 (&v)[2][2], int row, int pn, int wc, int fq, int, float rs) const {
        ST16(act, ((unsigned)row * FF + pn * 128 + wc * 32 + 8 * fq) * 2u, silu_pack(v, rs));
    }
    __device__ __forceinline__ void operator()(f32x4 (&acc)[2][2][4][2], const Unit& u, int wr, int wc, int fr, int fq) const {
        const int row0 = u.pm * 256 + wr * 64 + fr, lane = fr + 16 * fq, wave = wr * 4 + wc;
        float rs[2][4];
#pragma unroll
        for (int ai = 0; ai < 2; ++ai)
#pragma unroll
            for (int m = 0; m < 4; ++m) rs[ai][m] = rstd_of(part, row0 + ai * 128 + m * 16);
        f32x4 cv[4][2]; f32x4* cd[4]; const int chunk = cj->next;
        if (chunk < CP_CHUNKS) {
#pragma unroll
            for (int q = 0; q < 4; ++q) { const f32x4* src; cd[q] = nullptr; if (cp_addr(cj->in, cj->out, chunk * 32 + wave * 4 + q, lane, src, cd[q])) { cv[q][0] = __builtin_nontemporal_load(src); cv[q][1] = __builtin_nontemporal_load(src + 64); } }
        }
        __builtin_amdgcn_sched_barrier(0);
        u32x4 w[2][4];
#pragma unroll
        for (int ai = 0; ai < 2; ++ai)
#pragma unroll
            for (int m = 0; m < 4; ++m) { const f32x4 v[2][2] = {{acc[ai][0][m][0], acc[ai][0][m][1]}, {acc[ai][1][m][0], acc[ai][1][m][1]}}; w[ai][m] = silu_pack(v, rs[ai][m]); }
        __builtin_amdgcn_sched_barrier(0);
        if (chunk < CP_CHUNKS) {
#pragma unroll
            for (int q = 0; q < 4; ++q) if (cd[q]) { __builtin_nontemporal_store(cv[q][0], cd[q]); __builtin_nontemporal_store(cv[q][1], cd[q] + 64); }
            cj->next = chunk + 256;
        }
#pragma unroll
        for (int ai = 0; ai < 2; ++ai)
#pragma unroll
            for (int m = 0; m < 4; ++m) ST16(act, ((unsigned)(row0 + ai * 128 + m * 16) * FF + u.pn * 128 + wc * 32 + 8 * fq) * 2u, w[ai][m]);
    }
};
template <bool LAST> struct EpiRes : EpiBase<EpiRes<LAST>> {
    const bf16_t* xr; rsrc_t xo; rsrc_t xb; rsrc_t part; LAS float* red;
    __device__ __forceinline__ void operator()(f32x4 (&acc)[2][2][4][2], const Unit& u, int wr, int wc, int fr, int fq) const {
        const int row0 = u.pm * 256 + wr * 64 + fr, coff = u.pn * 256 + wc * 32 + 8 * fq;
        u32x4 xn[2][4][2];
#pragma unroll
        for (int ai = 0; ai < 2; ++ai)
#pragma unroll
            for (int m = 0; m < 4; ++m) { const bf16_t* xi = xr + (size_t)(row0 + ai * 128 + m * 16) * D + coff; xn[ai][m][0] = *(const u32x4*)xi; xn[ai][m][1] = *(const u32x4*)(xi + 128); }
        __builtin_amdgcn_sched_barrier(0);
#pragma unroll
        for (int ai = 0; ai < 2; ++ai)
#pragma unroll
            for (int m = 0; m < 4; ++m) {
                f32x4 v[2][2];
#pragma unroll
                for (int bj = 0; bj < 2; ++bj) { const u32x4 t = xn[ai][m][bj];
                    v[bj][0] = acc[ai][bj][m][0] + (f32x4){bflo(t.x), bfhi(t.x), bflo(t.y), bfhi(t.y)}; v[bj][1] = acc[ai][bj][m][1] + (f32x4){bflo(t.z), bfhi(t.z), bflo(t.w), bfhi(t.w)}; }
                row_op(v, row0 + ai * 128 + m * 16, u.pn, wc, fq, ai * 128 + wr * 64 + m * 16 + fr, 0.f);
            }
        finish(u.pm, u.pn, 256);
    }
    __device__ __forceinline__ float pre_row(f32x4 (&a0)[2], f32x4 (&a1)[2], int row, int pn, int wc, int fq) const {
        const bf16_t* xi = xr + (size_t)row * D + pn * 256 + wc * 32 + 8 * fq;
        const u32x4 t0 = *(const u32x4*)xi, t1 = *(const u32x4*)(xi + 128);
        a0[0] += (f32x4){bflo(t0.x), bfhi(t0.x), bflo(t0.y), bfhi(t0.y)}; a0[1] += (f32x4){bflo(t0.z), bfhi(t0.z), bflo(t0.w), bfhi(t0.w)};
        a1[0] += (f32x4){bflo(t1.x), bfhi(t1.x), bflo(t1.y), bfhi(t1.y)}; a1[1] += (f32x4){bflo(t1.z), bfhi(t1.z), bflo(t1.w), bfhi(t1.w)};
        return 0.f;
    }
    __device__ __forceinline__ void row_op(const f32x4 (&v)[2][2], int row, int pn, int wc, int fq, int lrow, float) const {
        const int col0 = pn * 256 + wc * 32 + 8 * fq;
        float ss = 0.f;
#pragma unroll
        for (int bj = 0; bj < 2; ++bj) {
            const f32x4 v0 = v[bj][0], v1 = v[bj][1];
            ss += (v0[0] * v0[0] + v0[1] * v0[1]) + (v0[2] * v0[2] + v0[3] * v0[3]) + (v1[0] * v1[0] + v1[1] * v1[1]) + (v1[2] * v1[2] + v1[3] * v1[3]);
            if (LAST) { const unsigned o = ((unsigned)row * D + col0 + bj * 128) * 4u; ST16(xo, o, F4U(v0)); ST16(xo, o + 16u, F4U(v1)); }
            else ST16(xb, ((unsigned)row * D + col0 + bj * 128) * 2u, pack8(v0, v1));
        }
        ss += __shfl_xor(ss, 16); ss += __shfl_xor(ss, 32);
        if (fq == 0) red[lrow * 4 + wc] = ss;
    }
    __device__ __forceinline__ void finish(int pm, int pn, int nrows) const {
        asm volatile("s_waitcnt lgkmcnt(0)" ::: "memory"); __builtin_amdgcn_s_barrier(); asm volatile("" ::: "memory");
        if ((int)threadIdx.x < nrows) { const f32x4 v = *(const LAS f32x4*)(red + threadIdx.x * 4); ST4(part, ((unsigned)(pm * 256 + threadIdx.x) * 4 + pn) * 4u, __builtin_bit_cast(unsigned, (v.x + v.y) + (v.z + v.w))); }
    }
};
struct EpiU : EpiBase<EpiU> {
    rsrc_t ub; const float* part; float* psp; float* pss;
    __device__ __forceinline__ float pre_row(f32x4 (&)[2], f32x4 (&)[2], int row, int, int, int) const { return rstd_of(part, row); }
    __device__ __forceinline__ void row_op(const f32x4 (&v)[2][2], int row, int pn, int wc, int fq, int, float rs) const {
        const int col0 = pn * 256 + wc * 32 + 8 * fq;
        float* po = nullptr;
        if (row >= S - 15 && row < S) po = psp + (size_t)(row - (S - 15)) * D; else if (row >= S && row < MV) po = pss + ((size_t)(row - S) * 15 + 14) * D;
#pragma unroll
        for (int bj = 0; bj < 2; ++bj) {
            const f32x4 v0 = v[bj][0] * rs, v1 = v[bj][1] * rs;
            ST16(ub, ((unsigned)row * D + col0 + bj * 128) * 2u, pack8(v0, v1));
            if (po) { *(f32x4*)(po + col0 + bj * 128) = v0; *(f32x4*)(po + col0 + bj * 128 + 4) = v1; }
        }
    }
};
struct EpiPlain : EpiBase<EpiPlain> {
    rsrc_t o;
    __device__ __forceinline__ float pre_row(f32x4 (&)[2], f32x4 (&)[2], int, int, int, int) const { return 0.f; }
    __device__ __forceinline__ void row_op(const f32x4 (&v)[2][2], int row, int pn, int wc, int fq, int, float) const {
        const int col0 = pn * 256 + wc * 32 + 8 * fq;
#pragma unroll
        for (int bj = 0; bj < 2; ++bj) ST16(o, ((unsigned)row * D + col0 + bj * 128) * 2u, pack8(v[bj][0], v[bj][1]));
    }
};
struct EpiQK : EpiBase<EpiQK> {
    rsrc_t qk; const float* part; float* out; rsrc_t vnew;
    __device__ __forceinline__ float pre_row(f32x4 (&)[2], f32x4 (&)[2], int row, int, int, int) const { return rstd_of(part, row); }
    __device__ __forceinline__ void row_op(const f32x4 (&v)[2][2], int row, int pn, int wc, int fq, int, float rs) const {
        const int colt = pn * 256, cw = wc * 32 + 8 * fq;
        const bool isv = colt >= 3072;
        const int g = isv ? (colt - 3072) / 512 : colt / 1024, s = isv ? 2 : (colt % 1024) / 512;
        const int W = 128 << (2 * g);
        const size_t gb = kv_group_base(g);
        const size_t o_p = gb, o_s = gb + 2 * (size_t)W * 512 + (isv ? (size_t)NS * W * 512 : 0);
        float* po = nullptr;
        if (s != 0) { if (row >= S - W && row < S) po = out + o_p + (size_t)(row - (S - W)) * 512; else if (row >= S && row < MV) po = out + o_s + ((size_t)(row - S) * W + (W - 1)) * 512; }
#pragma unroll
        for (int bj = 0; bj < 2; ++bj) {
            const f32x4 v0 = v[bj][0] * rs, v1 = v[bj][1] * rs;
            if (!isv) ST16(qk, ((unsigned)row * 3072 + colt + cw + bj * 128) * 2u, pack8(v0, v1));
            else ST16(vnew, ((unsigned)(row - S) * 1536 + (colt - 3072) + cw + bj * 128) * 2u, pack8(v0, v1));
            if (po) { const int he = (colt + cw + bj * 128) % 512; *(f32x4*)(po + he) = v0; *(f32x4*)(po + he + 4) = v1; }
        }
    }
};
struct EpiVT {
    rsrc_t vTg; const float* part; float* out; int g, d;
    __device__ __forceinline__ void operator()(f32x4 (&acc)[2][2][4][2], const Unit& u, int wr, int wc, int fr, int fq) const {
        const int dim0 = u.pm * 256 + wr * 64 + fr;
        const int W = 128 << (2 * g), q = 256 / d;
        const size_t o_p = kv_group_base(g) + (size_t)W * 512;
        const bool tail = (u.pn * 256 + 255 >= S - W);
        float rsa[2][8];
#pragma unroll
        for (int bj = 0; bj < 2; ++bj) { const int v0 = 128 * bj + 32 * wc + 8 * fq, r = v0 / q, ii0 = v0 % q, tok0 = u.pn * 256 + ii0 * d + r;
#pragma unroll
            for (int e = 0; e < 8; ++e) rsa[bj][e] = rstd_of(part, tok0 + e * d);
            __builtin_amdgcn_sched_barrier(0); }
#pragma unroll
        for (int bj = 0; bj < 2; ++bj) {
            const int v0 = 128 * bj + 32 * wc + 8 * fq, r = v0 / q, ii0 = v0 % q;
            const int tok0 = u.pn * 256 + ii0 * d + r;
            float rs[8];
#pragma unroll
            for (int e = 0; e < 8; ++e) rs[e] = rsa[bj][e];
            const size_t sidx = (size_t)r * (S / d) + (size_t)(u.pn * 256) / d + ii0;
            const unsigned vp = (unsigned)(((size_t)dim0 * MPV + 128 + sidx) * 2);
#pragma unroll
            for (int ai = 0; ai < 2; ++ai)
#pragma unroll
                for (int m = 0; m < 4; ++m) {
                    const f32x4 a0 = acc[ai][bj][m][0], a1 = acc[ai][bj][m][1];
                    u32x4 w; w.x = cvt_pk_bf16(a0[0] * rs[0], a0[1] * rs[1]); w.y = cvt_pk_bf16(a0[2] * rs[2], a0[3] * rs[3]); w.z = cvt_pk_bf16(a1[0] * rs[4], a1[1] * rs[5]); w.w = cvt_pk_bf16(a1[2] * rs[6], a1[3] * rs[7]);
                    ST16(vTg, vp + (unsigned)(ai * 128 + m * 16) * (unsigned)(MPV * 2), w);
                    asm volatile("" ::: "memory");
                }
            if (tail) {
#pragma unroll
                for (int e = 0; e < 8; ++e) { const int t = tok0 + e * d;
                    if (t >= S - W) { float* po = out + o_p + (size_t)(t - (S - W)) * 512 + dim0;
#pragma unroll
                        for (int ai = 0; ai < 2; ++ai)
#pragma unroll
                            for (int m = 0; m < 4; ++m) po[ai * 128 + m * 16] = acc[ai][bj][m][e >> 2][e & 3] * rs[e]; }
                    asm volatile("" ::: "memory"); }
            }
        }
    }
};

template <class Epi>
__device__ __forceinline__ void skinny_unit(LAS unsigned char* lds, const pg8::Gemm g, int pn, const Epi& E) {
    int tid = threadIdx.x; asm volatile("" : "+v"(tid));
    const int wid = __builtin_amdgcn_readfirstlane(tid >> 6), lane = tid & 63, kh = wid >> 2, wc = wid & 3, fr = lane & 15, fq = lane >> 4;
    const int Kh = g.K / 2;
    const bf16_t* ap = g.A + (size_t)(S + fr) * g.lda + (size_t)pn * g.a_pn + kh * Kh + 8 * fq;
    const bf16_t* bp = g.Bt + (size_t)(pn * 256 + wc * 32 + 8 * (fr >> 2) + (fr & 3)) * g.ldb + kh * Kh + 8 * fq;
    f32x4 acc[2][2][2];
#pragma unroll
    for (int a = 0; a < 2; ++a)
#pragma unroll
        for (int b = 0; b < 2; ++b)
#pragma unroll
            for (int c = 0; c < 2; ++c) acc[a][b][c] = (f32x4){0.f, 0.f, 0.f, 0.f};
#pragma unroll 4
    for (int k0 = 0; k0 < Kh; k0 += 32) {
        bf16x8 af[2], bf[2][2];
#pragma unroll
        for (int m = 0; m < 2; ++m) af[m] = *(const bf16x8*)(ap + (size_t)(16 * m) * g.lda + k0);
#pragma unroll
        for (int bj = 0; bj < 2; ++bj)
#pragma unroll
            for (int n = 0; n < 2; ++n) bf[bj][n] = *(const bf16x8*)(bp + (size_t)(128 * bj + 4 * n) * g.ldb + k0);
#pragma unroll
        for (int bj = 0; bj < 2; ++bj)
#pragma unroll
            for (int m = 0; m < 2; ++m)
#pragma unroll
                for (int n = 0; n < 2; ++n) acc[bj][m][n] = __builtin_amdgcn_mfma_f32_16x16x32_bf16(bf[bj][n], af[m], acc[bj][m][n], 0, 0, 0);
    }
    LAS f32x4* xs = (LAS f32x4*)lds + (wc * 64 + lane) * 8;
    __syncthreads();
    if (kh == 1) {
#pragma unroll
        for (int bj = 0; bj < 2; ++bj)
#pragma unroll
            for (int m = 0; m < 2; ++m)
#pragma unroll
                for (int n = 0; n < 2; ++n) xs[(bj * 2 + m) * 2 + n] = acc[bj][m][n];
    }
    __syncthreads();
    if (kh == 0) {
#pragma unroll
        for (int bj = 0; bj < 2; ++bj)
#pragma unroll
            for (int m = 0; m < 2; ++m)
#pragma unroll
                for (int n = 0; n < 2; ++n) acc[bj][m][n] += xs[(bj * 2 + m) * 2 + n];
    }
    E.small(acc, pn, wc, fr, fq, kh == 0);
}

typedef float f32x16 __attribute__((ext_vector_type(16)));
typedef __bf16 bf16v2 __attribute__((ext_vector_type(2)));
#define MFMA32(a, b, c) __builtin_amdgcn_mfma_f32_32x32x16_bf16((a), (b), (c), 0, 0, 0)
__device__ __forceinline__ unsigned cvt2(float a, float b) { const f32x2 v = {a, b}; return __builtin_bit_cast(unsigned, __builtin_convertvector(v, bf16v2)); }

template <int GI>
__device__ __forceinline__ void attn_job(const bf16_t* qk, const bf16_t* vTg, const LAS float* biasL, bf16_t* act, rsrc_t ob, int h, int r, int i0, int lane) {
    constexpr int d = 1 << (2 * GI), SD = S / d;
    int r16 = lane & 15, g = lane >> 4;
    asm volatile("" : "+v"(r16), "+v"(g));
    bf16x8 qf[2][2];
#pragma unroll
    for (int qt = 0; qt < 2; ++qt) { const bf16_t* qp = qk + (size_t)((i0 + 16 * qt + r16) * d + r) * 3072 + GI * 1024 + h * 64 + 8 * g;
#pragma unroll
        for (int ks = 0; ks < 2; ++ks) qf[qt][ks] = *(const bf16x8*)(qp + 32 * ks); }
    f32x4 st[5][2][2];
    bf16x8 kf[5][2][2];
#pragma unroll
    for (int kb = 0; kb < 5; ++kb)
#pragma unroll
        for (int T = 0; T < 2; ++T) {
            int ik = i0 - 128 + 32 * kb + 8 * (r16 >> 2) + 4 * T + (r16 & 3); ik = ik < 0 ? 0 : ik;
            const bf16_t* kp = qk + (size_t)(ik * d + r) * 3072 + GI * 1024 + 512 + h * 64 + 8 * g;
            kf[kb][T][0] = *(const bf16x8*)kp; kf[kb][T][1] = *(const bf16x8*)(kp + 32);
        }
    __builtin_amdgcn_sched_barrier(0);
#pragma unroll
    for (int kb = 0; kb < 5; ++kb)
#pragma unroll
        for (int T = 0; T < 2; ++T)
#pragma unroll
            for (int qt = 0; qt < 2; ++qt) { f32x4 a = {0.f, 0.f, 0.f, 0.f};
                a = __builtin_amdgcn_mfma_f32_16x16x32_bf16(kf[kb][T][0], qf[qt][0], a, 0, 0, 0); a = __builtin_amdgcn_mfma_f32_16x16x32_bf16(kf[kb][T][1], qf[qt][1], a, 0, 0, 0); st[kb][T][qt] = a; }
    const bf16_t* vbase = vTg + (size_t)(h * 64 + r16) * MPV + 128 + (r * SD + i0 - 128 + 8 * g);
    bf16x8 vf[5][4];
#pragma unroll
    for (int kb = 0; kb < 5; ++kb)
#pragma unroll
        for (int dt = 0; dt < 4; ++dt) vf[kb][dt] = *(const bf16x8*)(vbase + (size_t)dt * 16 * MPV + 32 * kb);
    __builtin_amdgcn_sched_barrier(0);
    float mx[2] = {-1e30f, -1e30f};
    const LAS float* bl = biasL + (r16 - 8 * g);
#pragma unroll
    for (int kb = 0; kb < 5; ++kb)
#pragma unroll
        for (int T = 0; T < 2; ++T)
#pragma unroll
            for (int qt = 0; qt < 2; ++qt)
#pragma unroll
                for (int i = 0; i < 4; ++i) {
                    const int jc0 = 128 - 32 * kb + 16 * qt - 4 * T - i;
                    if (kb >= 1 && kb <= 3) st[kb][T][qt][i] += bl[jc0];
                    else { const int jo = jc0 + r16 - 8 * g; const int jc = jo < 0 ? 0 : (jo > 128 ? 128 : jo); st[kb][T][qt][i] += biasL[jc]; }
                }
    __builtin_amdgcn_sched_barrier(0);
#pragma unroll
    for (int T = 0; T < 2; ++T)
#pragma unroll
        for (int qt = 0; qt < 2; ++qt)
#pragma unroll
            for (int i = 0; i < 4; ++i) {
                const int j0 = 128 + 16 * qt + r16 - 8 * g - 4 * T - i, j4 = j0 - 128;
                st[0][T][qt][i] = (j0 <= 128) ? st[0][T][qt][i] : -1e30f;
                st[4][T][qt][i] = (j4 >= 0) ? st[4][T][qt][i] : -1e30f;
            }
    if (i0 < 128) {
#pragma unroll
        for (int kb = 0; kb < 4; ++kb)
#pragma unroll
            for (int T = 0; T < 2; ++T)
#pragma unroll
                for (int qt = 0; qt < 2; ++qt)
#pragma unroll
                    for (int i = 0; i < 4; ++i) { const int ik = i0 - 128 + 32 * kb + 8 * g + 4 * T + i; st[kb][T][qt][i] = (ik >= 0) ? st[kb][T][qt][i] : -1e30f; }
    }
#pragma unroll
    for (int kb = 0; kb < 5; ++kb)
#pragma unroll
        for (int T = 0; T < 2; ++T)
#pragma unroll
            for (int qt = 0; qt < 2; ++qt)
#pragma unroll
                for (int i = 0; i < 4; ++i) mx[qt] = fmaxf(mx[qt], st[kb][T][qt][i]);
    float sum[2];
#pragma unroll
    for (int qt = 0; qt < 2; ++qt) { mx[qt] = fmaxf(mx[qt], __shfl_xor(mx[qt], 16)); mx[qt] = fmaxf(mx[qt], __shfl_xor(mx[qt], 32)); sum[qt] = 0.f; }
#pragma unroll
    for (int kb = 0; kb < 5; ++kb)
#pragma unroll
        for (int T = 0; T < 2; ++T)
#pragma unroll
            for (int qt = 0; qt < 2; ++qt)
#pragma unroll
                for (int i = 0; i < 4; ++i) { const float p = __builtin_amdgcn_exp2f(st[kb][T][qt][i] - mx[qt]); st[kb][T][qt][i] = p; sum[qt] += p; }
#pragma unroll
    for (int qt = 0; qt < 2; ++qt) { sum[qt] += __shfl_xor(sum[qt], 16); sum[qt] += __shfl_xor(sum[qt], 32); }
    f32x4 oa[4][2];
#pragma unroll
    for (int dt = 0; dt < 4; ++dt)
#pragma unroll
        for (int qt = 0; qt < 2; ++qt) oa[dt][qt] = (f32x4){0.f, 0.f, 0.f, 0.f};
#pragma unroll
    for (int kb = 0; kb < 5; ++kb) {
        bf16x8 pf[2];
#pragma unroll
        for (int qt = 0; qt < 2; ++qt) { u32x4 pw; pw.x = cvt2(st[kb][0][qt][0], st[kb][0][qt][1]); pw.y = cvt2(st[kb][0][qt][2], st[kb][0][qt][3]); pw.z = cvt2(st[kb][1][qt][0], st[kb][1][qt][1]); pw.w = cvt2(st[kb][1][qt][2], st[kb][1][qt][3]);
            pf[qt] = __builtin_bit_cast(bf16x8, pw); }
#pragma unroll
        for (int dt = 0; dt < 4; ++dt)
#pragma unroll
            for (int qt = 0; qt < 2; ++qt) oa[dt][qt] = __builtin_amdgcn_mfma_f32_16x16x32_bf16(vf[kb][dt], pf[qt], oa[dt][qt], 0, 0, 0);
    }
#pragma unroll
    for (int qt = 0; qt < 2; ++qt) {
        const int tq = (i0 + 16 * qt + r16) * d + r;
        const float inv = 1.0f / sum[qt], lse = mx[qt] + __log2f(sum[qt]);
        float* scr = (float*)(act + (size_t)tq * FF);
        bf16_t* scb = act + (size_t)tq * FF;
        if (GI > 0) {
#pragma unroll
            for (int dt = 0; dt < 4; ++dt) { const f32x4 v = oa[dt][qt] * inv; u32x2 w; w.x = cvt2(v[0], v[1]); w.y = cvt2(v[2], v[3]); *(u32x2*)(scb + (GI - 1) * 512 + h * 64 + 16 * dt + 4 * g) = w; }
            if (g == 0) scr[1024 + (GI - 1) * 8 + h] = lse;
        } else {
            const float l1 = scr[1024 + h], l2 = scr[1024 + 8 + h];
            f32x4 o1[4], o2[4];
#pragma unroll
            for (int dt = 0; dt < 4; ++dt) { const int dim0 = h * 64 + 16 * dt + 4 * g; const u32x2 p1 = *(const u32x2*)(scb + dim0), p2 = *(const u32x2*)(scb + 512 + dim0);
                o1[dt] = (f32x4){bflo(p1.x), bfhi(p1.x), bflo(p1.y), bfhi(p1.y)}; o2[dt] = (f32x4){bflo(p2.x), bfhi(p2.x), bflo(p2.y), bfhi(p2.y)}; }
            const float mm = fmaxf(fmaxf(lse, l1), l2);
            const float w0 = __builtin_amdgcn_exp2f(lse - mm), w1 = __builtin_amdgcn_exp2f(l1 - mm), w2 = __builtin_amdgcn_exp2f(l2 - mm), iw = 1.0f / (w0 + w1 + w2);
            const float a0 = w0 * inv * iw, a1 = w1 * iw, a2 = w2 * iw;
#pragma unroll
            for (int dt = 0; dt < 4; ++dt) { const int dim0 = h * 64 + 16 * dt + 4 * g; const f32x4 v = oa[dt][qt] * a0 + o1[dt] * a1 + o2[dt] * a2;
                u32x2 w; w.x = cvt2(v[0], v[1]); w.y = cvt2(v[2], v[3]);
                ST8(ob, ((unsigned)tq * 512 + dim0) * 2u, w); }
        }
    }
}
__device__ __forceinline__ float wave_sum(float v) {
#pragma unroll
    for (int o = 1; o < 64; o <<= 1) v += __shfl_xor(v, o);
    return v;
}
__device__ __forceinline__ float wave_max(float v) {
#pragma unroll
    for (int o = 1; o < 64; o <<= 1) v = fmaxf(v, __shfl_xor(v, o));
    return v;
}
__device__ __forceinline__ void sample_attn_group(int g, int b, int h, const bf16_t* qk, const bf16_t* vnew, const float* ck, const float* cv, const float* biasT, LAS float* smp, int lane) {
    const int d = 1 << (2 * g), W = 128 << (2 * g), row = S + b, kq = lane >> 3, dc = lane & 7;
    float q[64];
    { const u32x4* qp = (const u32x4*)(qk + (size_t)row * 3072 + g * 1024 + h * 64);
#pragma unroll
      for (int c = 0; c < 8; ++c) { const u32x4 t = qp[c]; q[8 * c] = bflo(t.x); q[8 * c + 1] = bfhi(t.x); q[8 * c + 2] = bflo(t.y); q[8 * c + 3] = bfhi(t.y); q[8 * c + 4] = bflo(t.z); q[8 * c + 5] = bfhi(t.z); q[8 * c + 6] = bflo(t.w); q[8 * c + 7] = bfhi(t.w); } }
    float sc[3];
#pragma unroll
    for (int rnd = 0; rnd < 3; ++rnd) {
        const int j = lane + 64 * rnd; float s = -1e30f;
        if (j <= 128) { float a = 0.f;
            if (j == 0) { const u32x4* kp = (const u32x4*)(qk + (size_t)row * 3072 + g * 1024 + 512 + h * 64);
#pragma unroll
                for (int c = 0; c < 8; ++c) { const u32x4 t = kp[c]; a += q[8 * c] * bflo(t.x) + q[8 * c + 1] * bfhi(t.x) + q[8 * c + 2] * bflo(t.y) + q[8 * c + 3] * bfhi(t.y) + q[8 * c + 4] * bflo(t.z) + q[8 * c + 5] * bfhi(t.z) + q[8 * c + 6] * bflo(t.w) + q[8 * c + 7] * bfhi(t.w); } }
            else { const f32x4* kp = (const f32x4*)(ck + (((size_t)b * W + (W - j * d)) * 8 + h) * 64);
#pragma unroll
                for (int c = 0; c < 16; ++c) { const f32x4 t = __builtin_nontemporal_load(kp + c); a += q[4 * c] * t.x + q[4 * c + 1] * t.y + q[4 * c + 2] * t.z + q[4 * c + 3] * t.w; } }
            s = a + biasT[(g * 8 + h) * 132 + j]; }
        sc[rnd] = s;
    }
    const float mx = wave_max(fmaxf(fmaxf(sc[0], sc[1]), sc[2]));
    float p[3]; float sum = 0.f;
#pragma unroll
    for (int rnd = 0; rnd < 3; ++rnd) { p[rnd] = (sc[rnd] > -1e29f) ? __builtin_amdgcn_exp2f(sc[rnd] - mx) : 0.f; sum += p[rnd]; }
    sum = wave_sum(sum);
    const float inv = 1.0f / sum;
    float o[8] = {0.f, 0.f, 0.f, 0.f, 0.f, 0.f, 0.f, 0.f};
#pragma unroll
    for (int i = 0; i < 17; ++i) {
        const int j = kq + 8 * i, src = j & 63, rnd = j >> 6;
        const float p0 = __shfl(p[0], src), p1 = __shfl(p[1], src), p2 = __shfl(p[2], src);
        const float pj = (rnd == 0) ? p0 : ((rnd == 1) ? p1 : p2);
        if (j <= 128) {
            if (j == 0) { const u32x4 t = *(const u32x4*)(vnew + (size_t)b * 1536 + g * 512 + h * 64 + 8 * dc);
                o[0] += pj * bflo(t.x); o[1] += pj * bfhi(t.x); o[2] += pj * bflo(t.y); o[3] += pj * bfhi(t.y); o[4] += pj * bflo(t.z); o[5] += pj * bfhi(t.z); o[6] += pj * bflo(t.w); o[7] += pj * bfhi(t.w); }
            else { const f32x4* vp = (const f32x4*)(cv + (((size_t)b * W + (W - j * d)) * 8 + h) * 64 + 8 * dc); const f32x4 t0 = __builtin_nontemporal_load(vp), t1 = __builtin_nontemporal_load(vp + 1);
                o[0] += pj * t0.x; o[1] += pj * t0.y; o[2] += pj * t0.z; o[3] += pj * t0.w; o[4] += pj * t1.x; o[5] += pj * t1.y; o[6] += pj * t1.z; o[7] += pj * t1.w; }
        }
    }
#pragma unroll
    for (int e = 0; e < 8; ++e) { float v = o[e]; v += __shfl_xor(v, 8); v += __shfl_xor(v, 16); v += __shfl_xor(v, 32); if (kq == 0) smp[g * 72 + 8 * dc + e] = v * inv; }
    if (lane == 0) smp[g * 72 + 64] = mx + __log2f(sum);
}

template <int W>
__device__ __forceinline__ void pool_strip(const bf16_t* ub, const float* state_pool, rsrc_t rs_z, int r0, int ch) {
    if (r0 < S) {
        u32x4 raw[16 + W - 1];
#pragma unroll
        for (int i = 0; i < 16 + W - 1; ++i) { const int row = r0 - (W - 1) + i; raw[i] = (row >= 0) ? *(const u32x4*)(ub + (size_t)row * D + ch) : (u32x4){0u, 0u, 0u, 0u}; }
        float run[8] = {0.f, 0.f, 0.f, 0.f, 0.f, 0.f, 0.f, 0.f};
#pragma unroll
        for (int i = 0; i < W - 1; ++i) { run[0] += bflo(raw[i].x); run[1] += bfhi(raw[i].x); run[2] += bflo(raw[i].y); run[3] += bfhi(raw[i].y); run[4] += bflo(raw[i].z); run[5] += bfhi(raw[i].z); run[6] += bflo(raw[i].w); run[7] += bfhi(raw[i].w); }
#pragma unroll
        for (int i = 0; i < 16; ++i) {
            const u32x4 c = raw[i + W - 1]; const float cv[8] = {bflo(c.x), bfhi(c.x), bflo(c.y), bfhi(c.y), bflo(c.z), bfhi(c.z), bflo(c.w), bfhi(c.w)};
#pragma unroll
            for (int e = 0; e < 8; ++e) run[e] += cv[e];
            const int row = r0 + i; const float ic = 1.0f / (float)(W < row + 1 ? W : row + 1);
            u32x4 o; o.x = pk2(run[0] * ic - cv[0], run[1] * ic - cv[1]); o.y = pk2(run[2] * ic - cv[2], run[3] * ic - cv[3]); o.z = pk2(run[4] * ic - cv[4], run[5] * ic - cv[5]); o.w = pk2(run[6] * ic - cv[6], run[7] * ic - cv[7]);
            ST16(rs_z, ((unsigned)row * D + ch) * 2u, o);
            const u32x4 l = raw[i];
            run[0] -= bflo(l.x); run[1] -= bfhi(l.x); run[2] -= bflo(l.y); run[3] -= bfhi(l.y); run[4] -= bflo(l.z); run[5] -= bfhi(l.z); run[6] -= bflo(l.w); run[7] -= bfhi(l.w);
        }
    } else {
#pragma nounroll
        for (int i = 0; i < 16; ++i) {
            const int row = r0 + i; u32x4 o = {0u, 0u, 0u, 0u};
            if (row < MV) {
                const u32x4 c = *(const u32x4*)(ub + (size_t)row * D + ch); const float cv[8] = {bflo(c.x), bfhi(c.x), bflo(c.y), bfhi(c.y), bflo(c.z), bfhi(c.z), bflo(c.w), bfhi(c.w)};
                float a[8];
#pragma unroll
                for (int e = 0; e < 8; ++e) a[e] = cv[e];
                const float* sp = state_pool + (size_t)(row - S) * 15 * D + ch;
#pragma unroll
                for (int k = 1; k < W; ++k) { const f32x4 p0 = *(const f32x4*)(sp + (size_t)(15 - k) * D), p1 = *(const f32x4*)(sp + (size_t)(15 - k) * D + 4);
                    a[0] += p0.x; a[1] += p0.y; a[2] += p0.z; a[3] += p0.w; a[4] += p1.x; a[5] += p1.y; a[6] += p1.z; a[7] += p1.w; }
                const float ic = 1.0f / (float)W;
                o.x = pk2(a[0] * ic - cv[0], a[1] * ic - cv[1]); o.y = pk2(a[2] * ic - cv[2], a[3] * ic - cv[3]); o.z = pk2(a[4] * ic - cv[4], a[5] * ic - cv[5]); o.w = pk2(a[6] * ic - cv[6], a[7] * ic - cv[7]);
            }
            ST16(rs_z, ((unsigned)row * D + ch) * 2u, o);
        }
    }
}

struct Args { const float* in[26]; float* out; unsigned char* ws; };
enum { PH_GU0 = 0, PH_D0, PH_WIN, PH_POOL, PH_GRP, PH_WPO, PH_GU1, PH_D1, PH_GU2, PH_D2, PH_QKV, PH_ATT, PH_WAO, PH_GU3, PH_D3, NPHC };

constexpr int NWAVES = 8, NTHR = 512;
constexpr int LDS_BYTES = 147456;

__device__ __forceinline__ void tr_item(const float* W, int ldw, int k0, int n0, bf16_t* dst, int ldd, const float* kscale, const float* nscale, float f, LAS float* scr, int lane) {
    const rsrc_t rs = mkrs(dst, (size_t)1 << 30);
    float tv[32];
#pragma unroll
    for (int i = 0; i < 32; ++i) { const int kk = 2 * i + (lane >> 5); tv[i] = __builtin_nontemporal_load(W + (size_t)(k0 + kk) * ldw + n0 + (lane & 31)); }
#pragma unroll
    for (int i = 0; i < 32; ++i) { const int kk = 2 * i + (lane >> 5); float v = tv[i]; if (kscale) v *= kscale[k0 + kk]; scr[kk * 33 + (lane & 31)] = v; }
    LDS_WAIT(); asm volatile("" ::: "memory");
    const int c = lane & 7;
#pragma unroll
    for (int j = 0; j < 4; ++j) { const int n = (lane >> 3) + 8 * j; const LAS float* s = scr + (8 * c) * 33 + n; const float fn = nscale ? f * nscale[n0 + n] : f;
        u32x4 o; o.x = pk2(s[0 * 33] * fn, s[1 * 33] * fn); o.y = pk2(s[2 * 33] * fn, s[3 * 33] * fn); o.z = pk2(s[4 * 33] * fn, s[5 * 33] * fn); o.w = pk2(s[6 * 33] * fn, s[7 * 33] * fn);
        ST16(rs, (unsigned)(n * ldd + k0 + 8 * c) * 2u, o); }
    LDS_WAIT(); asm volatile("" ::: "memory");
}
__device__ __forceinline__ int t5_bucket(int dist) {
    if (dist < 16) return dist;
    const int b = 16 + (int)(log((double)dist / 16.0) / log(128.0) * 16.0);
    return b < 31 ? b : 31;
}

#ifndef PM
#define PM 0xffffff
#endif
#define ON(k) if ((PM >> (k)) & 1)
__global__ void __launch_bounds__(NTHR, 2) fwd_kernel(Args args) {
    extern __shared__ __attribute__((aligned(16))) unsigned char lds_raw[];
    LAS unsigned char* lds = (LAS unsigned char*)lds_raw;
    const int tid = threadIdx.x, lane = tid & 63, wave = __builtin_amdgcn_readfirstlane(tid >> 6);
    const int G = gridDim.x, bx = blockIdx.x;
    const int gw = bx * NWAVES + wave, NGW = G * NWAVES;
    const size_t gt = (size_t)bx * NTHR + tid, NGT = (size_t)G * NTHR;
    unsigned char* ws = args.ws; float* out = args.out;
    bf16_t* Wgu = (bf16_t*)(ws + WS_WGU); bf16_t* Wd = (bf16_t*)(ws + WS_WD); bf16_t* Win = (bf16_t*)(ws + WS_WIN); bf16_t* Wgrp = (bf16_t*)(ws + WS_WGRP);
    bf16_t* Wpo = (bf16_t*)(ws + WS_WPO); bf16_t* Wqkv = (bf16_t*)(ws + WS_WQKV); bf16_t* Wao = (bf16_t*)(ws + WS_WAO);
    float* biasT = (float*)(ws + WS_BIAS); float* part = (float*)(ws + WS_PART);
    bf16_t* xb = (bf16_t*)(ws + WS_XB); bf16_t* act = (bf16_t*)(ws + WS_ACT);
    bf16_t* ub = (bf16_t*)(ws + WS_U); bf16_t* zb = (bf16_t*)(ws + WS_Z); bf16_t* z2b = (bf16_t*)(ws + WS_Z2); bf16_t* qk = (bf16_t*)(ws + WS_QK); bf16_t* vT = (bf16_t*)(ws + WS_VT); bf16_t* ob = (bf16_t*)(ws + WS_O); bf16_t* vnew = (bf16_t*)(ws + WS_VNEW);
    const float* x_prompt = args.in[0]; const float* x_sample = args.in[1]; const float* state_pool = args.in[2];
    cg::grid_group grid = cg::this_grid();
    unsigned* ctl = (unsigned*)(ws + WS_CTL);
#define CNT(ph) (ctl + (size_t)(ph) * 72 * 64)
    constexpr size_t QOFF = (size_t)NPHC * 72 * 64 + 1024, QWORDS = (size_t)48 * 8 * 64;

    constexpr int I_GU = 16 * 88, I_D = 44 * 32, I_IN = 16 * 32, I_GRP = 4 * 8, I_QKV = 16 * 144, I_AO = 8 * 32;
#define TR_SCR ((LAS float*)(lds + wave * 16384))
#define CV_FOR(q, OFF_, CNT_) for (int q = gw - (OFF_) + (gw < (OFF_) ? NGW : 0); q < (CNT_); q += NGW)
#define CV_GU(f_, OFF_) CV_FOR(q2, OFF_, 2 * I_GU) { const int f = (f_), up = q2 / I_GU, q = q2 % I_GU, kb = q / 88, nb = q % 88, n0 = nb * 32, layer = f >> 1, second = f & 1; \
        tr_item(args.in[(second ? 22 : 10) + up] + (size_t)layer * D * FF, FF, kb * 64, n0, Wgu + (size_t)f * 2 * FF * D + (size_t)((n0 / 128) * 256 + (n0 % 128) + up * 128) * D, D, \
                args.in[second ? 21 : 9] + layer * D, nullptr, 1.0f, TR_SCR, lane_c); }
#define CV_D(f_, OFF_) CV_FOR(q, OFF_, I_D) { const int f = (f_), kb = q / 32, nb = q % 32, layer = f >> 1, second = f & 1; \
        tr_item(args.in[(second ? 22 : 10) + 2] + (size_t)layer * FF * D, D, kb * 64, nb * 32, Wd + (size_t)f * D * FF + (size_t)(nb * 32) * FF, FF, nullptr, nullptr, 0.5f, TR_SCR, lane_c); }
#define CV_IN(OFF_) CV_FOR(q, OFF_, I_IN) { const int kb = q / 32, nb = q % 32; tr_item(args.in[14], D, kb * 64, nb * 32, Win + (size_t)(nb * 32) * D, D, args.in[13], nullptr, 1.0f, TR_SCR, lane_c); }
#define CV_GRP(OFF_) CV_FOR(q2, OFF_, 4 * I_GRP) { const int gq = q2 / I_GRP, q = q2 % I_GRP, kb = q / 8, nb = q % 8; \
        tr_item(args.in[15] + (size_t)gq * 256 * 256, 256, kb * 64, nb * 32, Wgrp + (size_t)(gq * 256 + nb * 32) * 256, 256, nullptr, args.in[16] + gq * 256, 1.0f, TR_SCR, lane_c); }
#define CV_PO(OFF_) CV_FOR(q, OFF_, I_IN) { const int kb = q / 32, nb = q % 32; tr_item(args.in[17], D, kb * 64, nb * 32, Wpo + (size_t)(nb * 32) * D, D, nullptr, nullptr, 1.0f, TR_SCR, lane_c); }
#define CV_QKV(OFF_) CV_FOR(q, OFF_, I_QKV) { const int kb = q / 144, nb = q % 144, n0 = nb * 32; const float fs = ((n0 % 1536) < 512) ? 0.125f * 1.4426950408889634f : 1.0f; \
        const int gg = n0 / 1536, ss = (n0 % 1536) / 512, he = n0 % 512; const int drow = ss < 2 ? gg * 1024 + ss * 512 + he : 3072 + gg * 512 + he; \
        tr_item(args.in[18], QKVW, kb * 64, n0, Wqkv + (size_t)drow * D, D, args.in[13] + D, nullptr, fs, TR_SCR, lane_c); }
#define CV_AO(OFF_) CV_FOR(q, OFF_, I_AO) { const int kb = q / 32, nb = q % 32; tr_item(args.in[19], D, kb * 64, nb * 32, Wao + (size_t)(nb * 32) * 512, 512, nullptr, nullptr, 1.0f, TR_SCR, lane_c); }
#define WC(c) (ctl + (size_t)NPHC * 72 * 64 + (size_t)(c) * 64)
#define CONV_POINT(c, BODY) do { int lane_c = threadIdx.x; asm volatile("" : "+v"(lane_c)); lane_c &= 63; BODY VM_WAIT(); if (lane_c == 0) __hip_atomic_fetch_add(WC(c), 1u, RLX_AGENT); __syncthreads(); } while (0)
    ON(0) {
        LAS float* scr = (LAS float*)(lds + wave * 16384);
        { const int lane_c = lane; CV_GU(0, 0) CV_D(0, 768) }
        const bool xl = (G == 256); const rsrc_t rs_x0 = mkrs(xb, (size_t)MP * D * 2);
        for (int it = gw; it < MP; it += NGW) {
            int row = it;
            if (xl && it < 8 * NGW) { const int k = it / NGW, wx = (bx >> 3) * NWAVES + wave; row = 2048 * (bx & 7) + wx + 256 * k; }
            f32x4 v[4]; float s = 0.f;
            if (row < MV) { const f32x4* xr = (const f32x4*)(row < S ? x_prompt + (size_t)row * D : x_sample + (size_t)(row - S) * D) + lane;
#pragma unroll
                for (int j = 0; j < 4; ++j) { v[j] = __builtin_nontemporal_load(xr + 64 * j); s += (v[j].x * v[j].x + v[j].y * v[j].y) + (v[j].z * v[j].z + v[j].w * v[j].w); } }
            else {
#pragma unroll
                for (int j = 0; j < 4; ++j) v[j] = (f32x4){0.f, 0.f, 0.f, 0.f}; }
            s = wave_sum(s);
#pragma unroll
            for (int j = 0; j < 4; ++j) { u32x2 w; w.x = pk2(v[j].x, v[j].y); w.y = pk2(v[j].z, v[j].w); ST8(rs_x0, ((unsigned)row * D + 4 * (64 * j + lane)) * 2u, w); }
            if (lane < 4) part[(size_t)row * 4 + lane] = (lane == 0) ? s : 0.f;
        }
        for (size_t i = gt; i < 3 * 8 * 132; i += NGT) { const int j = (int)(i % 132), gh = (int)(i / 132), g = gh / 8, h = gh % 8;
            biasT[i] = (j <= 128) ? 1.4426950408889634f * args.in[20][t5_bucket(j * (1 << (2 * g))) * 24 + g * 8 + h] : 0.f; }
        for (size_t i = gt; i < (size_t)NS * 14 * (D / 4); i += NGT) { const size_t b = i / (14 * (D / 4)), rem = i % (14 * (D / 4));
            ((f32x4*)(out + O_PSS + b * 15 * D))[rem] = ((const f32x4*)(state_pool + b * 15 * D + D))[rem]; }
        for (size_t i = gt; i < QOFF + QWORDS; i += NGT) ctl[i] = 0u;
        for (size_t i = gt; i < (size_t)(MP - MV) * 64; i += NGT) ((u32x4*)(ob + (size_t)MV * 512))[i] = (u32x4){0u, 0u, 0u, 0u};
    }
    grid.sync();

    const int xcd = bx % 8;
    unsigned* qbase = ctl + QOFF; int qi = 0; int sk_id = 0; LAS unsigned* qslot = (LAS unsigned*)(lds + 131072 + 4096);
    CopyJob cjob{args.in, out, bx};
    const rsrc_t rs_act = mkrs(act, (size_t)MP * FF * 2), rs_xb = mkrs(xb, (size_t)MP * D * 2), rs_part = mkrs(part, (size_t)MP * 16);
    LAS float* red = (LAS float*)(lds + 131072);
    const unsigned* wdep_next = nullptr;
#define FLOW_GEMM(EPI_T, EPI_INIT, Aptr, LDA_, Bptr, LDB_, K_, NM_, NN_, APN_, BSIG_, DEP_, NEED_, DEPPN_, DEPSH_, PUB_, PUBPN_) do { \
        pg8::Gemm g{(const bf16_t*)(Aptr), (const bf16_t*)(Bptr), (LDA_), (LDB_), (K_), (APN_), (BSIG_)}; pg8::FlowOrder So; So.init((NM_), (NN_), 2, xcd, qbase, qi, qslot); \
        So.dep = (DEP_); So.need = (NEED_); So.need64 = (NEED_); So.dep_pn = (DEPPN_); So.dep_shift = (DEPSH_); So.pub = (PUB_); So.pub_pn = (PUBPN_); So.wdep = wdep_next; So.wneed = (unsigned)NGW; wdep_next = nullptr; \
        EPI_T E EPI_INIT; pg8::gemm_phase<EPI_T, pg8::FlowOrder>(lds, g, So, E); } while (0)
#define SKINNY(EPI_T, EPI_INIT, Aptr, LDA_, Bptr, LDB_, K_, NN_, APN_, DEP_, NEED_, PUB_) do { \
        const pg8::Gemm g{(const bf16_t*)(Aptr), (const bf16_t*)(Bptr), (LDA_), (LDB_), (K_), (APN_), 1}; \
        ++sk_id; \
        for (int j = 0; j < (NN_); ++j) if ((sk_id * 29 + j * 13 + 7) % G == bx) {        \
            EPI_T E EPI_INIT; const unsigned* dp = (DEP_); \
            if (dp) { if (tid < 64) { flow_poll1(dp + (size_t)64 * 64, (NEED_)); __builtin_amdgcn_fence(__ATOMIC_ACQUIRE, "agent"); VM_WAIT(); } } \
            __syncthreads(); skinny_unit<EPI_T>(lds, g, j, E); flow_publish((PUB_) + (size_t)64 * 64); __syncthreads(); } \
        } while (0)
#define SKINNY_Q(EPI_T, EPI_INIT, Aptr, LDA_, Bptr, LDB_, K_, NN_, APN_, DEP_, NEED_, PUB_) do { \
        const pg8::Gemm g{(const bf16_t*)(Aptr), (const bf16_t*)(Bptr), (LDA_), (LDB_), (K_), (APN_), 1}; pg8::FlowOrder So; So.init(1, (NN_), 1, xcd, qbase, qi, qslot); \
        EPI_T E EPI_INIT; Unit u; \
        while (So.next_blocking(u)) { const unsigned* dp = (DEP_); \
            if (dp) { if (tid < 64) { flow_poll1(dp + (size_t)64 * 64, (NEED_)); __builtin_amdgcn_fence(__ATOMIC_ACQUIRE, "agent"); VM_WAIT(); } } \
            __syncthreads(); skinny_unit<EPI_T>(lds, g, u.pn, E); flow_publish((PUB_) + (size_t)64 * 64); } \
        __syncthreads(); } while (0)
#define GU_PHASE(f, DEP_, PH_) do { FLOW_GEMM(EpiGU, ({{}, rs_act, part, &cjob}), xb, D, Wgu + (size_t)(f) * 2 * FF * D, D, D, 64, 22, 0, 1, DEP_, 32u, 0, 0, CNT(PH_), 0); \
        SKINNY(EpiGU, ({{}, rs_act, part, &cjob}), xb, D, Wgu + (size_t)(f) * 2 * FF * D, D, D, 22, 0, DEP_, 32u, CNT(PH_)); } while (0)
#define DN_PHASE(LAST_, RSXO_, f, DEP_, PH_) do { FLOW_GEMM(EpiRes<LAST_>, ({{}, xb, RSXO_, rs_xb, rs_part, red}), act, FF, Wd + (size_t)(f) * D * FF, FF, FF, 64, 4, 0, 1, DEP_, 176u, 0, 0, CNT(PH_), 0); \
        SKINNY(EpiRes<LAST_>, ({{}, xb, RSXO_, rs_xb, rs_part, red}), act, FF, Wd + (size_t)(f) * D * FF, FF, FF, 4, 0, DEP_, 176u, CNT(PH_)); } while (0)

#ifndef PM
#define PM 0xffffff
#endif
    ON(1) GU_PHASE(0, nullptr, PH_GU0);
    CONV_POINT(1, CV_IN(0) CV_GRP(512) CV_PO(640));
    ON(2) DN_PHASE(false, rs_xb, 0, CNT(PH_GU0), PH_D0);
    CONV_POINT(2, CV_GU(1, 0));
    wdep_next = WC(1);
    ON(3) { FLOW_GEMM(EpiU, ({{}, mkrs(ub, (size_t)MP * D * 2), part, out + O_PSP, out + O_PSS}), xb, D, Win, D, D, 64, 4, 0, 1, CNT(PH_D0), 32u, 0, 0, CNT(PH_WIN), 0);
            SKINNY(EpiU, ({{}, mkrs(ub, (size_t)MP * D * 2), part, out + O_PSP, out + O_PSS}), xb, D, Win, D, D, 4, 0, CNT(PH_D0), 32u, CNT(PH_WIN)); }
    ON(4)
    for (int sm = 0; sm < 2; ++sm) {
        pg8::FlowOrder So; So.init(sm ? 1 : 64, 4, sm ? 1 : 2, xcd, qbase, qi, qslot);
        const rsrc_t rs_z = mkrs(zb, (size_t)MP * D * 2);
        Unit u;
        while (So.next_blocking(u)) {
            const int pm = sm ? 64 : u.pm;
            if (tid < 64) { flow_poll1(CNT(PH_WIN) + (size_t)pm * 64, 32u); if (pm > 0 && pm < 64) flow_poll1(CNT(PH_WIN) + (size_t)(pm - 1) * 64, 32u);
                __builtin_amdgcn_fence(__ATOMIC_ACQUIRE, "agent"); VM_WAIT(); }
            __syncthreads();
            {
                const int chunk = tid & 31, strip = tid >> 5, ch = u.pn * 256 + chunk * 8, r0 = pm * 256 + strip * 16;
                if (u.pn == 0) pool_strip<2>(ub, state_pool, rs_z, r0, ch);
                else if (u.pn == 1) pool_strip<4>(ub, state_pool, rs_z, r0, ch);
                else if (u.pn == 2) pool_strip<8>(ub, state_pool, rs_z, r0, ch);
                else pool_strip<16>(ub, state_pool, rs_z, r0, ch);
            }
            flow_publish(CNT(PH_POOL) + (size_t)pm * 64);
        }
    }
    CONV_POINT(3, CV_D(1, 0));
    wdep_next = WC(1);
    ON(5) { FLOW_GEMM(EpiPlain, ({{}, mkrs(z2b, (size_t)MP * D * 2)}), zb, D, Wgrp, 256, 256, 64, 4, 256, 1, CNT(PH_POOL), 32u, 0, 0, CNT(PH_GRP), 0);
            SKINNY(EpiPlain, ({{}, mkrs(z2b, (size_t)MP * D * 2)}), zb, D, Wgrp, 256, 256, 4, 256, CNT(PH_POOL), 32u, CNT(PH_GRP)); }
    wdep_next = WC(1);
    ON(6) { FLOW_GEMM(EpiRes<false>, ({{}, xb, rs_xb, rs_xb, rs_part, red}), z2b, D, Wpo, D, D, 64, 4, 0, 1, CNT(PH_GRP), 32u, 0, 0, CNT(PH_WPO), 0);
            SKINNY(EpiRes<false>, ({{}, xb, rs_xb, rs_xb, rs_part, red}), z2b, D, Wpo, D, D, 4, 0, CNT(PH_GRP), 32u, CNT(PH_WPO)); }
    CONV_POINT(4, CV_GU(2, 0));
    wdep_next = WC(2);
    ON(7) GU_PHASE(1, CNT(PH_WPO), PH_GU1);
    CONV_POINT(5, CV_D(2, 0));
    wdep_next = WC(3);
    ON(8) DN_PHASE(false, rs_xb, 1, CNT(PH_GU1), PH_D1);
    CONV_POINT(6, CV_QKV(0));
    wdep_next = WC(4);
    ON(9) GU_PHASE(2, CNT(PH_D1), PH_GU2);
    CONV_POINT(7, CV_AO(0) CV_GU(3, 256));
    wdep_next = WC(5);
    ON(10) DN_PHASE(false, rs_xb, 2, CNT(PH_GU2), PH_D2);
    CONV_POINT(8, CV_D(3, 0));
    wdep_next = WC(6);
    ON(11) { FLOW_GEMM(EpiQK, ({{}, mkrs(qk, (size_t)MP * 3072 * 2), part, out, mkrs(vnew, (size_t)NS * 1536 * 2)}), xb, D, Wqkv, D, D, 64, 12, 0, 1, CNT(PH_D2), 32u, 0, 0, CNT(PH_QKV), 0);
             SKINNY(EpiQK, ({{}, mkrs(qk, (size_t)MP * 3072 * 2), part, out, mkrs(vnew, (size_t)NS * 1536 * 2)}), xb, D, Wqkv, D, D, 18, 0, CNT(PH_D2), 32u, CNT(PH_QKV)); }
    ON(12)
#pragma unroll
    for (int gi = 0; gi < 3; ++gi)
        FLOW_GEMM(EpiVT, ({mkrs(vT + (size_t)gi * 512 * MPV, (size_t)512 * MPV * 2), part, out, gi, 1 << (2 * gi)}), Wqkv + (size_t)(3072 + gi * 512) * D, D, xb, D, D, 2, 64, 0, 1 << (2 * gi), CNT(PH_D2), 32u, 1, 0, CNT(PH_QKV), 1);
    ON(13) {
        LAS float* biasL = (LAS float*)lds;
        LAS float* smp = (LAS float*)(lds + 2048);
        const rsrc_t rs_o = mkrs(ob, (size_t)MP * 512 * 2);
        pg8::FlowOrder So; So.init(32, 8, 1, xcd, qbase, qi, qslot);
        Unit u;
        while (So.next_blocking(u)) {
            const int sp = u.pm, h = u.pn;
            if (tid < 64) { const int p0 = 2 * sp - 8 < 0 ? 0 : 2 * sp - 8, idx = p0 + lane; unsigned spn = 0;
                for (;;) { const unsigned v = (idx <= 2 * sp + 1) ? __hip_atomic_load(CNT(PH_QKV) + (size_t)idx * 64, RLX_AGENT) : 144u;
                    if (__all(v >= 144u)) break; __builtin_amdgcn_s_sleep(2); if (++spn > FLOW_SPIN_CAP) break; }
                            __builtin_amdgcn_fence(__ATOMIC_ACQUIRE, "agent"); VM_WAIT(); }
            __syncthreads();
            for (int j = tid; j < 3 * 132; j += NTHR) biasL[j] = biasT[((j / 132) * 8 + h) * 132 + (j % 132)];
            __syncthreads();
#pragma nounroll
            for (int k = 0; k < 2; ++k) attn_job<2>(qk, vT + (size_t)2 * 512 * MPV, biasL + 2 * 132, act, rs_o, h, wave + 8 * k, 32 * sp, lane);
#pragma nounroll
            for (int k = 0; k < 2; ++k) attn_job<1>(qk, vT + (size_t)1 * 512 * MPV, biasL + 1 * 132, act, rs_o, h, wave & 3, 128 * sp + 32 * ((wave >> 2) + 2 * k), lane);
            __syncthreads();
#pragma nounroll
            for (int k = 0; k < 2; ++k) attn_job<0>(qk, vT, biasL, act, rs_o, h, 0, 512 * sp + 32 * (wave + 8 * k), lane);
            flow_publish(CNT(PH_ATT) + (size_t)sp * 64);
        }
        pg8::FlowOrder Ss; Ss.init(NS, 8, 1, xcd, qbase, qi, qslot);
        while (Ss.next_blocking(u)) {
            const int b = u.pm, h = u.pn;
            if (tid < 64) { flow_poll1(CNT(PH_QKV) + (size_t)64 * 64, 144u); __builtin_amdgcn_fence(__ATOMIC_ACQUIRE, "agent"); VM_WAIT(); }
            __syncthreads();
            if (wave < 3) sample_attn_group(wave, b, h, qk, vnew, args.in[3 + 2 * wave], args.in[4 + 2 * wave], biasT, smp, lane);
            __syncthreads();
            if (wave == 0 && lane < 32) { const float l0 = smp[64], l1 = smp[72 + 64], l2 = smp[144 + 64], mm = fmaxf(fmaxf(l0, l1), l2);
                const float w0 = __builtin_amdgcn_exp2f(l0 - mm), w1 = __builtin_amdgcn_exp2f(l1 - mm), w2 = __builtin_amdgcn_exp2f(l2 - mm), iw = 1.0f / (w0 + w1 + w2);
                const float r0 = (w0 * smp[2 * lane] + w1 * smp[72 + 2 * lane] + w2 * smp[144 + 2 * lane]) * iw, r1 = (w0 * smp[2 * lane + 1] + w1 * smp[72 + 2 * lane + 1] + w2 * smp[144 + 2 * lane + 1]) * iw;
                ST4(rs_o, ((unsigned)(S + b) * 512 + h * 64 + 2 * lane) * 2u, pk2(r0, r1)); }
            flow_publish(CNT(PH_ATT) + (size_t)32 * 64);
        }
        __syncthreads();
    }
    wdep_next = WC(7);
    ON(14) { FLOW_GEMM(EpiRes<false>, ({{}, xb, rs_xb, rs_xb, rs_part, red}), ob, 512, Wao, 512, 512, 64, 4, 0, 1, CNT(PH_ATT), 64u, 0, 1, CNT(PH_WAO), 0);
             SKINNY(EpiRes<false>, ({{}, xb, rs_xb, rs_xb, rs_part, red}), ob, 512, Wao, 512, 512, 4, 0, CNT(PH_ATT) - (size_t)32 * 64, (unsigned)(NS * 8 * 8), CNT(PH_WAO)); }
    wdep_next = WC(7);
    ON(15) { FLOW_GEMM(EpiGU, ({{}, rs_act, part, &cjob}), xb, D, Wgu + (size_t)3 * 2 * FF * D, D, D, 64, 22, 0, 1, CNT(PH_WAO), 32u, 0, 0, CNT(PH_GU3), 0);
             SKINNY_Q(EpiGU, ({{}, rs_act, part, &cjob}), xb, D, Wgu + (size_t)3 * 2 * FF * D, D, D, 22, 0, CNT(PH_WAO), 32u, CNT(PH_GU3)); }
    wdep_next = WC(8);
    ON(16) { FLOW_GEMM(EpiRes<false>, ({{}, xb, rs_xb, rs_xb, rs_part, red}), act, FF, Wd + (size_t)3 * D * FF, FF, FF, 64, 4, 0, 1, CNT(PH_GU3), 176u, 0, 0, CNT(PH_D3), 0);
             SKINNY_Q(EpiRes<false>, ({{}, xb, rs_xb, rs_xb, rs_part, red}), act, FF, Wd + (size_t)3 * D * FF, FF, FF, 4, 0, CNT(PH_GU3), 176u, CNT(PH_D3)); }
    ON(17) {
        pg8::FlowOrder So; So.init(NPANEL, 4, 1, xcd, qbase, qi, qslot);
        const float* gf = args.in[25]; Unit u;
        while (So.next_blocking(u)) {
            if (tid < 64) { flow_poll1(CNT(PH_D3) + (size_t)u.pm * 64, 32u); __builtin_amdgcn_fence(__ATOMIC_ACQUIRE, "agent"); VM_WAIT(); }
            __syncthreads();
            u32x2 xw[8][4]; float rsv[8];
#pragma unroll
            for (int k = 0; k < 8; ++k) { int row = u.pm * 256 + u.pn * 64 + wave + 8 * k; if (row >= MV) row = MV - 1;
                rsv[k] = rstd_of(part, row); const u32x2* xr = (const u32x2*)(xb + (size_t)row * D) + lane;
#pragma unroll
                for (int j = 0; j < 4; ++j) xw[k][j] = xr[64 * j]; }
            f32x4 gg[4];
#pragma unroll
            for (int j = 0; j < 4; ++j) gg[j] = ((const f32x4*)gf + lane)[64 * j];
#pragma unroll
            for (int k = 0; k < 8; ++k) { const int row = u.pm * 256 + u.pn * 64 + wave + 8 * k;
                if (row < MV) { f32x4* xr = (f32x4*)(out + (size_t)row * D) + lane;
#pragma unroll
                    for (int j = 0; j < 4; ++j) { const f32x4 xv = {bflo(xw[k][j].x), bfhi(xw[k][j].x), bflo(xw[k][j].y), bfhi(xw[k][j].y)}; __builtin_nontemporal_store(xv * rsv[k] * gg[j], xr + 64 * j); } } }
        }
    }
    for (int chunk = cjob.next; chunk < CP_CHUNKS; chunk += 256) {
#pragma unroll
        for (int q = 0; q < 4; ++q) { const f32x4* src; f32x4* dst; if (cp_addr(args.in, out, chunk * 32 + wave * 4 + q, lane, src, dst)) { const f32x4 a0 = __builtin_nontemporal_load(src), a1 = __builtin_nontemporal_load(src + 64); __builtin_nontemporal_store(a0, dst); __builtin_nontemporal_store(a1, dst + 64); } }
    }
}

extern "C" void kernel_launch(void* const* d_in, const int* in_sizes, int n_in, void* d_out, int out_size, void* d_ws, size_t ws_size, hipStream_t stream) {
    static int grid = 0;
    if (grid == 0) {
        if (n_in != 26 || (size_t)out_size != OUT_TOTAL || ws_size < WS_END) { fprintf(stderr, "kernel_launch: unexpected shapes: n_in %d out %d (want %zu) ws %zu (need %zu)\n", n_in, out_size, (size_t)OUT_TOTAL, ws_size, (size_t)WS_END); grid = -1; return; }
        int dev = 0, cus = 0, per_cu = 0;
        hipGetDevice(&dev); hipDeviceGetAttribute(&cus, hipDeviceAttributeMultiprocessorCount, dev);
        hipFuncSetAttribute((const void*)fwd_kernel, hipFuncAttributeMaxDynamicSharedMemorySize, LDS_BYTES);
        hipOccupancyMaxActiveBlocksPerMultiprocessor(&per_cu, (const void*)fwd_kernel, NTHR, LDS_BYTES);
        if (per_cu < 1) { fprintf(stderr, "kernel_launch: occupancy query says %d blocks per CU\n", per_cu); per_cu = 1; }
        grid = cus;
        (void)hipGetLastError();
    }
    if (grid < 0) return;
    Args a{};
    for (int i = 0; i < 26; ++i) a.in[i] = (const float*)d_in[i];
    a.out = (float*)d_out; a.ws = (unsigned char*)d_ws;
    void* kargs[] = {&a};
    hipError_t e = hipLaunchCooperativeKernel((const void*)fwd_kernel, dim3(grid), dim3(NTHR), kargs, LDS_BYTES, stream);
    if (e != hipSuccess) fprintf(stderr, "cooperative launch failed: %s (grid %d)\n", hipGetErrorString(e), grid);
}
```

```cpp
#include <hip/hip_runtime.h>
#include <hip/hip_cooperative_groups.h>
#include <cstdio>
#include <cstdint>
namespace cg = cooperative_groups;


#define LAS __attribute__((address_space(3)))
typedef unsigned short bf16_t;
typedef short bf16x8 __attribute__((ext_vector_type(8)));
typedef float f32x4 __attribute__((ext_vector_type(4)));
typedef float f32x2 __attribute__((ext_vector_type(2)));
typedef unsigned u32x4 __attribute__((ext_vector_type(4)));
typedef unsigned u32x2 __attribute__((ext_vector_type(2)));

constexpr int D = 1024, S = 16384, NS = 32, FF = 2816, MP = 16640, NPANEL = 65, MV = S + NS;
constexpr int QKVW = 4608;
constexpr int MPV = MP + 128;
constexpr float EPS = 1e-6f;

__device__ __forceinline__ unsigned f2bf(float f) { unsigned u = __builtin_bit_cast(unsigned, f); return (u + 0x7fffu + ((u >> 16) & 1u)) >> 16; }
__device__ __forceinline__ unsigned pk2(float lo, float hi) { return f2bf(lo) | (f2bf(hi) << 16); }
__device__ __forceinline__ float bf2f(unsigned short b) { return __builtin_bit_cast(float, ((unsigned)b) << 16); }
__device__ __forceinline__ float bflo(unsigned w) { return __builtin_bit_cast(float, w << 16); }
__device__ __forceinline__ float bfhi(unsigned w) { return __builtin_bit_cast(float, w & 0xffff0000u); }
#define LDS_WAIT() asm volatile("s_waitcnt lgkmcnt(0)" ::: "memory")
#define VM_WAIT() asm volatile("s_waitcnt vmcnt(0)" ::: "memory")
typedef __amdgpu_buffer_rsrc_t rsrc_t;
__device__ __forceinline__ rsrc_t mkrs(const void* p, size_t bytes) { return __builtin_amdgcn_make_buffer_rsrc((void*)p, 0, (int)bytes, 0x00020000); }
#define ST16(rs, off, v) __builtin_amdgcn_raw_buffer_store_b128((v), (rs), (unsigned)(off), 0, 16)
#define ST8(rs, off, v) __builtin_amdgcn_raw_buffer_store_b64((v), (rs), (unsigned)(off), 0, 16)
#define ST4(rs, off, v) __builtin_amdgcn_raw_buffer_store_b32((v), (rs), (unsigned)(off), 0, 16)
#define F4U(v) __builtin_bit_cast(u32x4, (v))
#define RLX_AGENT __ATOMIC_RELAXED, __HIP_MEMORY_SCOPE_AGENT

namespace pg8 {
constexpr int BM = 256, BK = 64, HALF = 128, HTB = HALF * BK * 2, STAGE_BYTES = 8 * HTB, NXCD = 8, WGM = 8;
__host__ __device__ __forceinline__ int lds_byte(int r, int c) { const int st = (r >> 4) * 2 + (c >> 5), rr = r & 15, cc = c & 31, ob = rr * 64 + cc * 2; return st * 1024 + (ob ^ (((ob >> 9) & 1) << 5)); }
__host__ __device__ __forceinline__ void stage_rc(int b, int& R, int& C) { const int st = b / 1024, sb = b % 1024, swz = sb ^ (((sb >> 9) & 1) << 5); R = (st >> 1) * 16 + swz / 64; C = (st & 1) * 32 + (swz % 64) / 2; }
__host__ __device__ __forceinline__ int perm32(int rho) { const int n = rho >> 4, i = rho & 15; return 8 * (i >> 2) + 4 * n + (i & 3); }
__host__ __device__ __forceinline__ int sigma_row(int d, int v) { const int q = 256 / d; return (v % q) * d + v / q; }

struct Unit { int pm, pn; };
struct Gemm { const bf16_t* A; const bf16_t* Bt; int lda, ldb, K, a_pn, bsig; };

#define FLOW_SPIN_CAP (1u << 21)
__device__ __forceinline__ void flow_poll1(const unsigned* c, unsigned need) {
    unsigned sp = 0;
    while ((unsigned)__builtin_amdgcn_readfirstlane(__hip_atomic_load(c, RLX_AGENT)) < need) { __builtin_amdgcn_s_sleep(2); if (++sp > FLOW_SPIN_CAP) break; }
}
__device__ __forceinline__ void flow_publish(unsigned* c) {
    asm volatile("s_waitcnt vmcnt(0)" ::: "memory");
    if ((threadIdx.x & 63) == 0) __hip_atomic_fetch_add(c, 1u, RLX_AGENT);
}
struct FlowOrder {
    int nM, nN, wgm, base, nx;
    unsigned* head;
    LAS unsigned* slot;
    unsigned claimed;
    const unsigned* wdep; unsigned wneed;
    const unsigned* dep; unsigned need, need64; int dep_pn, dep_shift;
    unsigned* pub; int pub_pn;
    __device__ __forceinline__ void init(int nM_, int nN_, int wgm_, int xcd, unsigned* qbase, int& qi, LAS unsigned* slot_) {
        nM = nM_; nN = nN_; wgm = wgm_;
        const int nwg = nM * nN, q = nwg / NXCD, r = nwg % NXCD;
        nx = q + (xcd < r ? 1 : 0); base = xcd < r ? xcd * (q + 1) : r * (q + 1) + (xcd - r) * q;
        head = qbase + (size_t)(qi * NXCD + xcd) * 64; ++qi; slot = slot_; claimed = 0u;
        wdep = nullptr; wneed = 0; dep = nullptr; need = 0; need64 = 0; dep_pn = 0; dep_shift = 0; pub = nullptr; pub_pn = 0;
    }
    __device__ __forceinline__ bool decode(unsigned l, Unit& u) const {
        if (l >= (unsigned)nx) return false;
        const int wgid = base + (int)l, nig = wgm * nN, gid = wgid / nig, fm = gid * wgm, gsz = (nM - fm) < wgm ? (nM - fm) : wgm;
        u.pm = fm + ((wgid % nig) % gsz); u.pn = (wgid % nig) / gsz; return true;
    }
    __device__ __forceinline__ bool next_blocking(Unit& u) {
        __syncthreads();
        if (threadIdx.x == 0) { const unsigned tk = __hip_atomic_fetch_add(head, 1u, RLX_AGENT);
            if (wdep) { unsigned sp = 0; while (__hip_atomic_load(wdep, RLX_AGENT) < wneed) { __builtin_amdgcn_s_sleep(2); if (++sp > FLOW_SPIN_CAP) break; } }
            *slot = tk; }
        __syncthreads();
        return decode(*slot, u);
    }
    __device__ __forceinline__ void claim_issue() { if (threadIdx.x == 0) claimed = __hip_atomic_fetch_add(head, 1u, RLX_AGENT); }
    __device__ __forceinline__ bool ready_next(Unit& u) {
        if (threadIdx.x < 64) {
            const unsigned l = (unsigned)__builtin_amdgcn_readfirstlane((int)claimed);
            Unit t; const bool ok = decode(l, t);
            if (ok && dep) { const int panel = dep_pn ? t.pn : t.pm;
                flow_poll1(dep + (size_t)(panel >> dep_shift) * 64, panel == 64 ? need64 : need);
                __builtin_amdgcn_fence(__ATOMIC_ACQUIRE, "agent");
                asm volatile("s_waitcnt vmcnt(0)" ::: "memory"); }
            if (threadIdx.x == 0) *slot = l;
        }
        asm volatile("s_waitcnt lgkmcnt(0)" ::: "memory"); __builtin_amdgcn_s_barrier(); asm volatile("" ::: "memory");
        return decode(*slot, u);
    }
    __device__ __forceinline__ void a_ready(const Unit& u) const {
        if (dep) {
            if (threadIdx.x < 64) { const int panel = dep_pn ? u.pn : u.pm;
                flow_poll1(dep + (size_t)(panel >> dep_shift) * 64, panel == 64 ? need64 : need);
                __builtin_amdgcn_fence(__ATOMIC_ACQUIRE, "agent");
                asm volatile("s_waitcnt vmcnt(0)" ::: "memory"); }
            asm volatile("" ::: "memory"); __builtin_amdgcn_s_barrier(); asm volatile("" ::: "memory");
        }
    }
    __device__ __forceinline__ void done(const Unit& u) const { if (pub) flow_publish(pub + (size_t)(pub_pn ? u.pn : u.pm) * 64); }
};

__device__ __forceinline__ unsigned cvt_pk_bf16(float lo, float hi) { unsigned r; asm volatile("v_cvt_pk_bf16_f32 %0, %1, %2" : "=v"(r) : "v"(lo), "v"(hi)); return r; }

template <class Epi, class Sched>
__device__ __forceinline__ void gemm_phase(LAS unsigned char* lds, const Gemm g, Sched& S, const Epi& E) {
    int tid = threadIdx.x; asm volatile("" : "+v"(tid));
    const int wid = __builtin_amdgcn_readfirstlane(tid >> 6), lane = tid & 63, wr = wid >> 2, wc = wid & 3, fr = lane & 15, fq = lane >> 4;
    const int K = g.K, nt = K / BK;
    unsigned voffA[2], voffB[2];
#pragma unroll
    for (int i = 0; i < 2; ++i) { int R, C; stage_rc(tid * 16 + i * 8192, R, C); const int Rb = sigma_row(g.bsig, (R & ~31) + perm32(R & 31));
        voffA[i] = (unsigned)(R * g.lda + C) * 2u; voffB[i] = (unsigned)(Rb * g.ldb + C) * 2u; }
    const size_t kstep = (size_t)(BK * 2);
    const size_t hstepA = (size_t)HALF * g.lda * 2, hstepB = (size_t)sigma_row(g.bsig, HALF) * g.ldb * 2;
    const size_t tstepA = 2 * hstepA, tstepB = (size_t)BM * g.ldb * 2;
    const unsigned ldsw = (unsigned)wid * 1024u;
    const int aoff = lds_byte(wr * 64 + fr, fq * 8), boff = lds_byte(wc * 32 + fr, fq * 8);
#define PG8_SA(b, h) (((b) * 2 + (h)) * HTB)
#define PG8_SB(b, h) ((4 + (b) * 2 + (h)) * HTB)
#define PG8_STAGE(bufoff, gbase, voff) do { _Pragma("unroll") for (int _i = 0; _i < 2; ++_i) \
        __builtin_amdgcn_global_load_lds((const unsigned*)((const char*)(gbase) + (voff)[_i]), (LAS unsigned*)(lds + (bufoff) + ldsw + _i * 8192), 16, 0, 0); } while (0)
#define PG8_LDA(dst, b, h) do { _Pragma("unroll") for (int m = 0; m < 4; ++m) _Pragma("unroll") for (int k = 0; k < 2; ++k) dst[m][k] = *(const LAS bf16x8*)(lds + PG8_SA(b, h) + aoff + m * 2048 + k * 1024); } while (0)
#define PG8_LDB(dst, b, h) do { _Pragma("unroll") for (int n = 0; n < 2; ++n) _Pragma("unroll") for (int k = 0; k < 2; ++k) dst[n][k] = *(const LAS bf16x8*)(lds + PG8_SB(b, h) + boff + n * 2048 + k * 1024); } while (0)
#define PG8_MMA(ai, bj, At, Bt) do { __builtin_amdgcn_s_setprio(1); _Pragma("unroll") for (int m = 0; m < 4; ++m) _Pragma("unroll") for (int n = 0; n < 2; ++n) _Pragma("unroll") for (int k = 0; k < 2; ++k) \
        acc[ai][bj][m][n] = __builtin_amdgcn_mfma_f32_16x16x32_bf16(Bt[n][k], At[m][k], acc[ai][bj][m][n], 0, 0, 0); __builtin_amdgcn_s_setprio(0); } while (0)
#define PG8_WAIT_V(n) asm volatile("s_waitcnt vmcnt(" #n ")" ::: "memory")
#define PG8_WAIT_L(n) asm volatile("s_waitcnt lgkmcnt(" #n ")" ::: "memory")
#define PG8_BAR __builtin_amdgcn_s_barrier()
#define PG8_SCHED __builtin_amdgcn_sched_barrier(0)
    Unit cur, nxt; int ui = 0;
    if (!S.next_blocking(cur)) return;
    f32x4 acc[2][2][4][2];
#pragma unroll
    for (int a = 0; a < 2; ++a)
#pragma unroll
        for (int b = 0; b < 2; ++b)
#pragma unroll
            for (int m = 0; m < 4; ++m)
#pragma unroll
                for (int n = 0; n < 2; ++n) acc[a][b][m][n] = (f32x4){0.f, 0.f, 0.f, 0.f};
    bf16x8 At[4][2], B0[2][2], B1[2][2];
    const char* cA = (const char*)g.A + (size_t)cur.pm * tstepA + (size_t)cur.pn * g.a_pn * 2; const char* cB = (const char*)g.Bt + (size_t)cur.pn * tstepB;
    PG8_STAGE(PG8_SB(0, 0), cB, voffB); PG8_STAGE(PG8_SB(0, 1), cB + hstepB, voffB);
    S.a_ready(cur);
    PG8_STAGE(PG8_SA(0, 0), cA, voffA); PG8_STAGE(PG8_SA(0, 1), cA + hstepA, voffA);
    if (wr == 1) PG8_BAR;
    PG8_WAIT_V(2); PG8_BAR;
    PG8_STAGE(PG8_SB(1, 0), cB + kstep, voffB); PG8_STAGE(PG8_SA(1, 0), cA + kstep, voffA); PG8_STAGE(PG8_SB(1, 1), cB + hstepB + kstep, voffB);
    PG8_WAIT_V(6); PG8_BAR;
    for (;;) {
        bool has_next = false; const char* nA = cA; const char* nB = cB;
        const int t_claim = nt >= 4 ? nt - 4 : 0;
#pragma nounroll
        for (int t = 0; t < nt; t += 2) {
            const bool last = (t == nt - 2);
            const char* a1 = cA + (size_t)(t + 1) * kstep;
            if (t == t_claim) S.claim_issue();
            if (last) { has_next = S.ready_next(nxt);
                if (has_next) { nA = (const char*)g.A + (size_t)nxt.pm * tstepA + (size_t)nxt.pn * g.a_pn * 2; nB = (const char*)g.Bt + (size_t)nxt.pn * tstepB; } }
            const char* a2 = last ? nA : cA + (size_t)(t + 2) * kstep; const char* b2 = last ? nB : cB + (size_t)(t + 2) * kstep;
            const char* a3 = a2 + kstep; const char* b3 = b2 + kstep;
            PG8_LDB(B0, 0, 0); PG8_LDB(B1, 0, 1); PG8_SCHED; PG8_LDA(At, 0, 0); PG8_STAGE(PG8_SA(1, 1), a1 + hstepA, voffA);
            PG8_WAIT_V(8); PG8_WAIT_L(0); PG8_BAR; PG8_MMA(0, 0, At, B0); PG8_MMA(0, 1, At, B1); PG8_BAR; PG8_SCHED;
            PG8_LDA(At, 0, 1); PG8_STAGE(PG8_SB(0, 0), b2, voffB); PG8_STAGE(PG8_SB(0, 1), b2 + hstepB, voffB); PG8_STAGE(PG8_SA(0, 0), a2, voffA);
            PG8_WAIT_V(8); PG8_WAIT_L(0); PG8_BAR; PG8_MMA(1, 0, At, B0); PG8_MMA(1, 1, At, B1); PG8_BAR; PG8_SCHED;
            PG8_LDB(B0, 1, 0); PG8_LDB(B1, 1, 1); PG8_SCHED; PG8_LDA(At, 1, 0); PG8_STAGE(PG8_SA(0, 1), a2 + hstepA, voffA);
            PG8_WAIT_V(8); PG8_WAIT_L(0); PG8_BAR; PG8_MMA(0, 0, At, B0); PG8_MMA(0, 1, At, B1); PG8_BAR; PG8_SCHED;
            PG8_LDA(At, 1, 1); PG8_STAGE(PG8_SB(1, 0), b3, voffB); PG8_STAGE(PG8_SB(1, 1), b3 + hstepB, voffB); PG8_STAGE(PG8_SA(1, 0), a3, voffA);
            PG8_WAIT_V(8); PG8_WAIT_L(0); PG8_BAR; PG8_MMA(1, 0, At, B0); PG8_MMA(1, 1, At, B1); PG8_BAR; PG8_SCHED;
        }
        if (wr == 0) PG8_BAR;
        E(acc, cur, wr, wc, fr, fq); S.done(cur);
        if (!has_next) break;
#pragma unroll
        for (int a = 0; a < 2; ++a)
#pragma unroll
            for (int b = 0; b < 2; ++b)
#pragma unroll
                for (int m = 0; m < 4; ++m)
#pragma unroll
                    for (int n = 0; n < 2; ++n) acc[a][b][m][n] = (f32x4){0.f, 0.f, 0.f, 0.f};
        cur = nxt; cA = nA; cB = nB; ++ui;
        if (wr == 1) PG8_BAR;
    }
    PG8_WAIT_V(0);
    PG8_BAR;
#undef PG8_SA
#undef PG8_SB
#undef PG8_STAGE
#undef PG8_LDA
#undef PG8_LDB
#undef PG8_MMA
#undef PG8_WAIT_V
#undef PG8_WAIT_L
#undef PG8_BAR
#undef PG8_SCHED
}
}
using pg8::Unit;
using pg8::cvt_pk_bf16;
using pg8::flow_poll1;
using pg8::flow_publish;

constexpr size_t MiB = 1u << 20;
constexpr size_t al(size_t x) { return (x + 4095) & ~(size_t)4095; }
constexpr size_t WS_CTL = 0;
constexpr size_t WS_WGU = 1 * MiB;
constexpr size_t SZ_WGU = (size_t)2 * FF * D * 2;
constexpr size_t WS_WD = WS_WGU + 4 * SZ_WGU;
constexpr size_t SZ_WD = (size_t)D * FF * 2;
constexpr size_t WS_WIN = WS_WD + 4 * SZ_WD;
constexpr size_t WS_WGRP = WS_WIN + (size_t)D * D * 2;
constexpr size_t WS_WPO = WS_WGRP + (size_t)D * 256 * 2;
constexpr size_t WS_WQKV = WS_WPO + (size_t)D * D * 2;
constexpr size_t WS_WAO = WS_WQKV + (size_t)QKVW * D * 2;
constexpr size_t WS_BIAS = WS_WAO + (size_t)D * 512 * 2;
constexpr size_t WS_PART = al(WS_BIAS + 3 * 8 * 132 * 4);
constexpr size_t WS_XB = al(WS_PART + (size_t)MP * 4 * 4);
constexpr size_t WS_XF = WS_XB + (size_t)MP * D * 2;
constexpr size_t WS_ACT = WS_XF + (size_t)MP * D * 4;
constexpr size_t WS_U = WS_ACT + (size_t)MP * FF * 2;
constexpr size_t WS_Z = WS_U + (size_t)MP * D * 2;
constexpr size_t WS_Z2 = WS_Z + (size_t)MP * D * 2;
constexpr size_t WS_QK = WS_Z2 + (size_t)MP * D * 2;
constexpr size_t WS_VT = WS_QK + (size_t)MP * 3072 * 2;
constexpr size_t WS_O = WS_VT + (size_t)3 * 512 * MPV * 2;
constexpr size_t WS_VNEW = WS_O + (size_t)MP * 512 * 2;
constexpr size_t WS_END = WS_VNEW + (size_t)NS * 1536 * 2;

constexpr size_t O_YP = 0, O_YS = (size_t)S * D, O_PSP = O_YS + (size_t)NS * D, O_PSS = O_PSP + 15 * D, O_KV0 = O_PSS + (size_t)NS * 15 * D;
__host__ __device__ constexpr size_t kv_group_base(int g) {
    size_t o = O_KV0;
    for (int i = 0; i < g; ++i) { const size_t W = (size_t)128 << (2 * i); o += 2 * W * 512 + 2 * (size_t)NS * W * 512; }
    return o;
}
constexpr size_t OUT_TOTAL = kv_group_base(3);

constexpr int CP_ROWS_TOTAL = 2 * NS * (127 + 511 + 2047);
constexpr int CP_CHUNKS = (CP_ROWS_TOTAL + 31) / 32;
__device__ __forceinline__ bool cp_addr(const float* const* in, float* out, int rho, int lane, const f32x4*& src, f32x4*& dst) {
    if (rho >= CP_ROWS_TOTAL) return false;
    int g = 0, kv = 0, rem = rho;
    if (rem >= 2 * NS * 127) { rem -= 2 * NS * 127; g = 1; if (rem >= 2 * NS * 511) { rem -= 2 * NS * 511; g = 2; } }
    const int W = 128 << (2 * g), per = NS * (W - 1);
    if (rem >= per) { rem -= per; kv = 1; }
    const int b = rem / (W - 1), t = rem % (W - 1);
    src = (const f32x4*)in[3 + 2 * g + kv] + ((size_t)b * W + t + 1) * 128 + lane;
    dst = (f32x4*)(out + kv_group_base(g) + 2 * (size_t)W * 512 + (size_t)kv * NS * W * 512) + ((size_t)b * W + t) * 128 + lane;
    return true;
}
struct CopyJob { const float* const* in; float* out; int next; };

__device__ __forceinline__ float rstd_of(const float* part, int row) {
    const f32x4 a = *(const f32x4*)(part + (size_t)row * 4);
    return __builtin_amdgcn_rsqf(((a.x + a.y) + (a.z + a.w)) * (1.0f / D) + EPS);
}
__device__ __forceinline__ float silu_mul(float g, float u) { return g * __builtin_amdgcn_rcpf(1.0f + __expf(-g)) * u; }
__device__ __forceinline__ u32x4 pack8(const f32x4 v0, const f32x4 v1) { u32x4 w; w.x = cvt_pk_bf16(v0[0], v0[1]); w.y = cvt_pk_bf16(v0[2], v0[3]); w.z = cvt_pk_bf16(v1[0], v1[1]); w.w = cvt_pk_bf16(v1[2], v1[3]); return w; }

template <class Derived> struct EpiBase {
    __device__ __forceinline__ void operator()(f32x4 (&acc)[2][2][4][2], const Unit& u, int wr, int wc, int fr, int fq) const {
        const Derived& self = *static_cast<const Derived*>(this);
        const int row0 = u.pm * 256 + wr * 64 + fr;
        float ctx[2][4];
#pragma unroll
        for (int ai = 0; ai < 2; ++ai)
#pragma unroll
            for (int m = 0; m < 4; ++m) ctx[ai][m] = self.pre_row(acc[ai][0][m], acc[ai][1][m], row0 + ai * 128 + m * 16, u.pn, wc, fq);
        __builtin_amdgcn_sched_barrier(0);
#pragma unroll
        for (int ai = 0; ai < 2; ++ai)
#pragma unroll
            for (int m = 0; m < 4; ++m) { const f32x4 v[2][2] = {{acc[ai][0][m][0], acc[ai][0][m][1]}, {acc[ai][1][m][0], acc[ai][1][m][1]}};
                self.row_op(v, row0 + ai * 128 + m * 16, u.pn, wc, fq, ai * 128 + wr * 64 + m * 16 + fr, ctx[ai][m]); }
        self.finish(u.pm, u.pn, 256);
    }
    __device__ __forceinline__ void small(f32x4 (&accS)[2][2][2], int pn, int wc, int fr, int fq, bool active) const {
        const Derived& self = *static_cast<const Derived*>(this);
        if (active) {
            float ctx[2];
#pragma unroll
            for (int m = 0; m < 2; ++m) ctx[m] = self.pre_row(accS[0][m], accS[1][m], S + m * 16 + fr, pn, wc, fq);
            __builtin_amdgcn_sched_barrier(0);
#pragma unroll
            for (int m = 0; m < 2; ++m) { const f32x4 v[2][2] = {{accS[0][m][0], accS[0][m][1]}, {accS[1][m][0], accS[1][m][1]}};
                self.row_op(v, S + m * 16 + fr, pn, wc, fq, m * 16 + fr, ctx[m]); }
        }
        self.finish(64, pn, 32);
    }
    __device__ __forceinline__ void finish(int, int, int) const {}
};

struct EpiGU : EpiBase<EpiGU> {
    rsrc_t act; const float* part; CopyJob* cj;
    __device__ __forceinline__ float pre_row(f32x4 (&)[2], f32x4 (&)[2], int row, int, int, int) const { return rstd_of(part, row); }
    __device__ __forceinline__ u32x4 silu_pack(const f32x4 (&v)[2][2], float rs) const {
        const float c = -1.4426950408889634f * rs, r2 = rs * rs;
        f32x4 o0, o1;
#pragma unroll
        for (int e = 0; e < 4; ++e) { o0[e] = (v[0][0][e] * v[1][0][e]) * (r2 * __builtin_amdgcn_rcpf(1.0f + __builtin_amdgcn_exp2f(v[0][0][e] * c))); o1[e] = (v[0][1][e] * v[1][1][e]) * (r2 * __builtin_amdgcn_rcpf(1.0f + __builtin_amdgcn_exp2f(v[0][1][e] * c))); }
        return pack8(o0, o1);
    }
    __device__ __forceinline__ void row_op(const f32x4 (&v)[2][2], int row, int pn, int wc, int fq, int, float rs) const {
        ST16(act, ((unsigned)row * FF + pn * 128 + wc * 32 + 8 * fq) * 2u, silu_pack(v, rs));
    }
    __device__ __forceinline__ void operator()(f32x4 (&acc)[2][2][4][2], const Unit& u, int wr, int wc, int fr, int fq) const {
        const int row0 = u.pm * 256 + wr * 64 + fr, lane = fr + 16 * fq, wave = wr * 4 + wc;
        float rs[2][4];
#pragma unroll
        for (int ai = 0; ai < 2; ++ai)
#pragma unroll
            for (int m = 0; m < 4; ++m) rs[ai][m] = rstd_of(part, row0 + ai * 128 + m * 16);
        f32x4 cv[4][2]; f32x4* cd[4]; const int chunk = cj->next;
        if (chunk < CP_CHUNKS) {
#pragma unroll
            for (int q = 0; q < 4; ++q) { const f32x4* src; cd[q] = nullptr; if (cp_addr(cj->in, cj->out, chunk * 32 + wave * 4 + q, lane, src, cd[q])) { cv[q][0] = __builtin_nontemporal_load(src); cv[q][1] = __builtin_nontemporal_load(src + 64); } }
        }
        __builtin_amdgcn_sched_barrier(0);
        u32x4 w[2][4];
#pragma unroll
        for (int ai = 0; ai < 2; ++ai)
#pragma unroll
            for (int m = 0; m < 4; ++m) { const f32x4 v[2][2] = {{acc[ai][0][m][0], acc[ai][0][m][1]}, {acc[ai][1][m][0], acc[ai][1][m][1]}}; w[ai][m] = silu_pack(v, rs[ai][m]); }
        __builtin_amdgcn_sched_barrier(0);
        if (chunk < CP_CHUNKS) {
#pragma unroll
            for (int q = 0; q < 4; ++q) if (cd[q]) { __builtin_nontemporal_store(cv[q][0], cd[q]); __builtin_nontemporal_store(cv[q][1], cd[q] + 64); }
            cj->next = chunk + 256;
        }
#pragma unroll
        for (int ai = 0; ai < 2; ++ai)
#pragma unroll
            for (int m = 0; m < 4; ++m) ST16(act, ((unsigned)(row0 + ai * 128 + m * 16) * FF + u.pn * 128 + wc * 32 + 8 * fq) * 2u, w[ai][m]);
    }
};
template <bool LAST> struct EpiRes : EpiBase<EpiRes<LAST>> {
    const bf16_t* xr; rsrc_t xo; rsrc_t xb; rsrc_t part; LAS float* red;
    __device__ __forceinline__ void operator()(f32x4 (&acc)[2][2][4][2], const Unit& u, int wr, int wc, int fr, int fq) const {
        const int row0 = u.pm * 256 + wr * 64 + fr, coff = u.pn * 256 + wc * 32 + 8 * fq;
        u32x4 xn[2][4][2];
#pragma unroll
        for (int ai = 0; ai < 2; ++ai)
#pragma unroll
            for (int m = 0; m < 4; ++m) { const bf16_t* xi = xr + (size_t)(row0 + ai * 128 + m * 16) * D + coff; xn[ai][m][0] = *(const u32x4*)xi; xn[ai][m][1] = *(const u32x4*)(xi + 128); }
        __builtin_amdgcn_sched_barrier(0);
#pragma unroll
        for (int ai = 0; ai < 2; ++ai)
#pragma unroll
            for (int m = 0; m < 4; ++m) {
                f32x4 v[2][2];
#pragma unroll
                for (int bj = 0; bj < 2; ++bj) { const u32x4 t = xn[ai][m][bj];
                    v[bj][0] = acc[ai][bj][m][0] + (f32x4){bflo(t.x), bfhi(t.x), bflo(t.y), bfhi(t.y)}; v[bj][1] = acc[ai][bj][m][1] + (f32x4){bflo(t.z), bfhi(t.z), bflo(t.w), bfhi(t.w)}; }
                row_op(v, row0 + ai * 128 + m * 16, u.pn, wc, fq, ai * 128 + wr * 64 + m * 16 + fr, 0.f);
            }
        finish(u.pm, u.pn, 256);
    }
    __device__ __forceinline__ float pre_row(f32x4 (&a0)[2], f32x4 (&a1)[2], int row, int pn, int wc, int fq) const {
        const bf16_t* xi = xr + (size_t)row * D + pn * 256 + wc * 32 + 8 * fq;
        const u32x4 t0 = *(const u32x4*)xi, t1 = *(const u32x4*)(xi + 128);
        a0[0] += (f32x4){bflo(t0.x), bfhi(t0.x), bflo(t0.y), bfhi(t0.y)}; a0[1] += (f32x4){bflo(t0.z), bfhi(t0.z), bflo(t0.w), bfhi(t0.w)};
        a1[0] += (f32x4){bflo(t1.x), bfhi(t1.x), bflo(t1.y), bfhi(t1.y)}; a1[1] += (f32x4){bflo(t1.z), bfhi(t1.z), bflo(t1.w), bfhi(t1.w)};
        return 0.f;
    }
    __device__ __forceinline__ void row_op(const f32x4 (&v)[2][2], int row, int pn, int wc, int fq, int lrow, float) const {
        const int col0 = pn * 256 + wc * 32 + 8 * fq;
        float ss = 0.f;
#pragma unroll
        for (int bj = 0; bj < 2; ++bj) {
            const f32x4 v0 = v[bj][0], v1 = v[bj][1];
            ss += (v0[0] * v0[0] + v0[1] * v0[1]) + (v0[2] * v0[2] + v0[3] * v0[3]) + (v1[0] * v1[0] + v1[1] * v1[1]) + (v1[2] * v1[2] + v1[3] * v1[3]);
            if (LAST) { const unsigned o = ((unsigned)row * D + col0 + bj * 128) * 4u; ST16(xo, o, F4U(v0)); ST16(xo, o + 16u, F4U(v1)); }
            else ST16(xb, ((unsigned)row * D + col0 + bj * 128) * 2u, pack8(v0, v1));
        }
        ss += __shfl_xor(ss, 16); ss += __shfl_xor(ss, 32);
        if (fq == 0) red[lrow * 4 + wc] = ss;
    }
    __device__ __forceinline__ void finish(int pm, int pn, int nrows) const {
        asm volatile("s_waitcnt lgkmcnt(0)" ::: "memory"); __builtin_amdgcn_s_barrier(); asm volatile("" ::: "memory");
        if ((int)threadIdx.x < nrows) { const f32x4 v = *(const LAS f32x4*)(red + threadIdx.x * 4); ST4(part, ((unsigned)(pm * 256 + threadIdx.x) * 4 + pn) * 4u, __builtin_bit_cast(unsigned, (v.x + v.y) + (v.z + v.w))); }
    }
};
struct EpiU : EpiBase<EpiU> {
    rsrc_t ub; const float* part; float* psp; float* pss;
    __device__ __forceinline__ float pre_row(f32x4 (&)[2], f32x4 (&)[2], int row, int, int, int) const { return rstd_of(part, row); }
    __device__ __forceinline__ void row_op(const f32x4 (&v)[2][2], int row, int pn, int wc, int fq, int, float rs) const {
        const int col0 = pn * 256 + wc * 32 + 8 * fq;
        float* po = nullptr;
        if (row >= S - 15 && row < S) po = psp + (size_t)(row - (S - 15)) * D; else if (row >= S && row < MV) po = pss + ((size_t)(row - S) * 15 + 14) * D;
#pragma unroll
        for (int bj = 0; bj < 2; ++bj) {
            const f32x4 v0 = v[bj][0] * rs, v1 = v[bj][1] * rs;
            ST16(ub, ((unsigned)row * D + col0 + bj * 128) * 2u, pack8(v0, v1));
            if (po) { *(f32x4*)(po + col0 + bj * 128) = v0; *(f32x4*)(po + col0 + bj * 128 + 4) = v1; }
        }
    }
};
struct EpiPlain : EpiBase<EpiPlain> {
    rsrc_t o;
    __device__ __forceinline__ float pre_row(f32x4 (&)[2], f32x4 (&)[2], int, int, int, int) const { return 0.f; }
    __device__ __forceinline__ void row_op(const f32x4 (&v)[2][2], int row, int pn, int wc, int fq, int, float) const {
        const int col0 = pn * 256 + wc * 32 + 8 * fq;
#pragma unroll
        for (int bj = 0; bj < 2; ++bj) ST16(o, ((unsigned)row * D + col0 + bj * 128) * 2u, pack8(v[bj][0], v[bj][1]));
    }
};
struct EpiQK : EpiBase<EpiQK> {
    rsrc_t qk; const float* part; float* out; rsrc_t vnew;
    __device__ __forceinline__ float pre_row(f32x4 (&)[2], f32x4 (&)[2], int row, int, int, int) const { return rstd_of(part, row); }
    __device__ __forceinline__ void row_op(const f32x4 (&v)[2][2], int row, int pn, int wc, int fq, int, float rs) const {
        const int colt = pn * 256, cw = wc * 32 + 8 * fq;
        const bool isv = colt >= 3072;
        const int g = isv ? (colt - 3072) / 512 : colt / 1024, s = isv ? 2 : (colt % 1024) / 512;
        const int W = 128 << (2 * g);
        const size_t gb = kv_group_base(g);
        const size_t o_p = gb, o_s = gb + 2 * (size_t)W * 512 + (isv ? (size_t)NS * W * 512 : 0);
        float* po = nullptr;
        if (s != 0) { if (row >= S - W && row < S) po = out + o_p + (size_t)(row - (S - W)) * 512; else if (row >= S && row < MV) po = out + o_s + ((size_t)(row - S) * W + (W - 1)) * 512; }
#pragma unroll
        for (int bj = 0; bj < 2; ++bj) {
            const f32x4 v0 = v[bj][0] * rs, v1 = v[bj][1] * rs;
            if (!isv) ST16(qk, ((unsigned)row * 3072 + colt + cw + bj * 128) * 2u, pack8(v0, v1));
            else ST16(vnew, ((unsigned)(row - S) * 1536 + (colt - 3072) + cw + bj * 128) * 2u, pack8(v0, v1));
            if (po) { const int he = (colt + cw + bj * 128) % 512; *(f32x4*)(po + he) = v0; *(f32x4*)(po + he + 4) = v1; }
        }
    }
};
struct EpiVT {
    rsrc_t vTg; const float* part; float* out; int g, d;
    __device__ __forceinline__ void operator()(f32x4 (&acc)[2][2][4][2], const Unit& u, int wr, int wc, int fr, int fq) const {
        const int dim0 = u.pm * 256 + wr * 64 + fr;
        const int W = 128 << (2 * g), q = 256 / d;
        const size_t o_p = kv_group_base(g) + (size_t)W * 512;
        const bool tail = (u.pn * 256 + 255 >= S - W);
        float rsa[2][8];
#pragma unroll
        for (int bj = 0; bj < 2; ++bj) { const int v0 = 128 * bj + 32 * wc + 8 * fq, r = v0 / q, ii0 = v0 % q, tok0 = u.pn * 256 + ii0 * d + r;
#pragma unroll
            for (int e = 0; e < 8; ++e) rsa[bj][e] = rstd_of(part, tok0 + e * d);
            __builtin_amdgcn_sched_barrier(0); }
#pragma unroll
        for (int bj = 0; bj < 2; ++bj) {
            const int v0 = 128 * bj + 32 * wc + 8 * fq, r = v0 / q, ii0 = v0 % q;
            const int tok0 = u.pn * 256 + ii0 * d + r;
            float rs[8];
#pragma unroll
            for (int e = 0; e < 8; ++e) rs[e] = rsa[bj][e];
            const size_t sidx = (size_t)r * (S / d) + (size_t)(u.pn * 256) / d + ii0;
            const unsigned vp = (unsigned)(((size_t)dim0 * MPV + 128 + sidx) * 2);
#pragma unroll
            for (int ai = 0; ai < 2; ++ai)
#pragma unroll
                for (int m = 0; m < 4; ++m) {
                    const f32x4 a0 = acc[ai][bj][m][0], a1 = acc[ai][bj][m][1];
                    u32x4 w; w.x = cvt_pk_bf16(a0[0] * rs[0], a0[1] * rs[1]); w.y = cvt_pk_bf16(a0[2] * rs[2], a0[3] * rs[3]); w.z = cvt_pk_bf16(a1[0] * rs[4], a1[1] * rs[5]); w.w = cvt_pk_bf16(a1[2] * rs[6], a1[3] * rs[7]);
                    ST16(vTg, vp + (unsigned)(ai * 128 + m * 16) * (unsigned)(MPV * 2), w);
                    asm volatile("" ::: "memory");
                }
            if (tail) {
#pragma unroll
                for (int e = 0; e < 8; ++e) { const int t = tok0 + e * d;
                    if (t >= S - W) { float* po = out + o_p + (size_t)(t - (S - W)) * 512 + dim0;
#pragma unroll
                        for (int ai = 0; ai < 2; ++ai)
#pragma unroll
                            for (int m = 0; m < 4; ++m) po[ai * 128 + m * 16] = acc[ai][bj][m][e >> 2][e & 3] * rs[e]; }
                    asm volatile("" ::: "memory"); }
            }
        }
    }
};

template <class Epi>
__device__ __forceinline__ void skinny_unit(LAS unsigned char* lds, const pg8::Gemm g, int pn, const Epi& E) {
    int tid = threadIdx.x; asm volatile("" : "+v"(tid));
    const int wid = __builtin_amdgcn_readfirstlane(tid >> 6), lane = tid & 63, kh = wid >> 2, wc = wid & 3, fr = lane & 15, fq = lane >> 4;
    const int Kh = g.K / 2;
    const bf16_t* ap = g.A + (size_t)(S + fr) * g.lda + (size_t)pn * g.a_pn + kh * Kh + 8 * fq;
    const bf16_t* bp = g.Bt + (size_t)(pn * 256 + wc * 32 + 8 * (fr >> 2) + (fr & 3)) * g.ldb + kh * Kh + 8 * fq;
    f32x4 acc[2][2][2];
#pragma unroll
    for (int a = 0; a < 2; ++a)
#pragma unroll
        for (int b = 0; b < 2; ++b)
#pragma unroll
            for (int c = 0; c < 2; ++c) acc[a][b][c] = (f32x4){0.f, 0.f, 0.f, 0.f};
#pragma unroll 4
    for (int k0 = 0; k0 < Kh; k0 += 32) {
        bf16x8 af[2], bf[2][2];
#pragma unroll
        for (int m = 0; m < 2; ++m) af[m] = *(const bf16x8*)(ap + (size_t)(16 * m) * g.lda + k0);
#pragma unroll
        for (int bj = 0; bj < 2; ++bj)
#pragma unroll
            for (int n = 0; n < 2; ++n) bf[bj][n] = *(const bf16x8*)(bp + (size_t)(128 * bj + 4 * n) * g.ldb + k0);
#pragma unroll
        for (int bj = 0; bj < 2; ++bj)
#pragma unroll
            for (int m = 0; m < 2; ++m)
#pragma unroll
                for (int n = 0; n < 2; ++n) acc[bj][m][n] = __builtin_amdgcn_mfma_f32_16x16x32_bf16(bf[bj][n], af[m], acc[bj][m][n], 0, 0, 0);
    }
    LAS f32x4* xs = (LAS f32x4*)lds + (wc * 64 + lane) * 8;
    __syncthreads();
    if (kh == 1) {
#pragma unroll
        for (int bj = 0; bj < 2; ++bj)
#pragma unroll
            for (int m = 0; m < 2; ++m)
#pragma unroll
                for (int n = 0; n < 2; ++n) xs[(bj * 2 + m) * 2 + n] = acc[bj][m][n];
    }
    __syncthreads();
    if (kh == 0) {
#pragma unroll
        for (int bj = 0; bj < 2; ++bj)
#pragma unroll
            for (int m = 0; m < 2; ++m)
#pragma unroll
                for (int n = 0; n < 2; ++n) acc[bj][m][n] += xs[(bj * 2 + m) * 2 + n];
    }
    E.small(acc, pn, wc, fr, fq, kh == 0);
}

typedef float f32x16 __attribute__((ext_vector_type(16)));
typedef __bf16 bf16v2 __attribute__((ext_vector_type(2)));
#define MFMA32(a, b, c) __builtin_amdgcn_mfma_f32_32x32x16_bf16((a), (b), (c), 0, 0, 0)
__device__ __forceinline__ unsigned cvt2(float a, float b) { const f32x2 v = {a, b}; return __builtin_bit_cast(unsigned, __builtin_convertvector(v, bf16v2)); }

template <int GI>
__device__ __forceinline__ void attn_job(const bf16_t* qk, const bf16_t* vTg, const LAS float* biasL, bf16_t* act, rsrc_t ob, int h, int r, int i0, int lane,
                                         const LAS unsigned char* lk = nullptr, const LAS unsigned char* lv = nullptr, int kl0 = 0) {
    constexpr int d = 1 << (2 * GI), SD = S / d;
    int r16 = lane & 15, g = lane >> 4;
    asm volatile("" : "+v"(r16), "+v"(g));
    bf16x8 qf[2][2];
#pragma unroll
    for (int qt = 0; qt < 2; ++qt) { const bf16_t* qp = qk + (size_t)((i0 + 16 * qt + r16) * d + r) * 3072 + GI * 1024 + h * 64 + 8 * g;
#pragma unroll
        for (int ks = 0; ks < 2; ++ks) qf[qt][ks] = *(const bf16x8*)(qp + 32 * ks); }
    f32x4 st[5][2][2];
    if constexpr (GI == 0) {
#pragma unroll
        for (int kb = 0; kb < 5; ++kb)
#pragma unroll
            for (int T = 0; T < 2; ++T) { const int kl = kl0 + 32 * kb + 8 * (r16 >> 2) + 4 * T + (r16 & 3); const LAS unsigned char* kp = lk + kl * 128; const int sw = (kl >> 1) & 7;
                const bf16x8 k0 = *(const LAS bf16x8*)(kp + ((g ^ sw) << 4)), k1 = *(const LAS bf16x8*)(kp + (((g + 4) ^ sw) << 4));
#pragma unroll
                for (int qt = 0; qt < 2; ++qt) { f32x4 a = {0.f, 0.f, 0.f, 0.f};
                    a = __builtin_amdgcn_mfma_f32_16x16x32_bf16(k0, qf[qt][0], a, 0, 0, 0); a = __builtin_amdgcn_mfma_f32_16x16x32_bf16(k1, qf[qt][1], a, 0, 0, 0); st[kb][T][qt] = a; } }
    } else {
    bf16x8 kf[5][2][2];
#pragma unroll
    for (int kb = 0; kb < 5; ++kb)
#pragma unroll
        for (int T = 0; T < 2; ++T) {
            int ik = i0 - 128 + 32 * kb + 8 * (r16 >> 2) + 4 * T + (r16 & 3); ik = ik < 0 ? 0 : ik;
            const bf16_t* kp = qk + (size_t)(ik * d + r) * 3072 + GI * 1024 + 512 + h * 64 + 8 * g;
            kf[kb][T][0] = *(const bf16x8*)kp; kf[kb][T][1] = *(const bf16x8*)(kp + 32);
        }
    __builtin_amdgcn_sched_barrier(0);
#pragma unroll
    for (int kb = 0; kb < 5; ++kb)
#pragma unroll
        for (int T = 0; T < 2; ++T)
#pragma unroll
            for (int qt = 0; qt < 2; ++qt) { f32x4 a = {0.f, 0.f, 0.f, 0.f};
                a = __builtin_amdgcn_mfma_f32_16x16x32_bf16(kf[kb][T][0], qf[qt][0], a, 0, 0, 0); a = __builtin_amdgcn_mfma_f32_16x16x32_bf16(kf[kb][T][1], qf[qt][1], a, 0, 0, 0); st[kb][T][qt] = a; }
    }
    const bf16_t* vbase = vTg + (size_t)(h * 64 + r16) * MPV + 128 + (r * SD + i0 - 128 + 8 * g);
    bf16x8 vf[5][4];
#pragma unroll
    for (int kb = 0; kb < 5; ++kb)
#pragma unroll
        for (int dt = 0; dt < 4; ++dt) { if constexpr (GI != 0) vf[kb][dt] = *(const bf16x8*)(vbase + (size_t)dt * 16 * MPV + 32 * kb); }
    __builtin_amdgcn_sched_barrier(0);
    float mx[2] = {-1e30f, -1e30f};
    const LAS float* bl = biasL + (r16 - 8 * g);
#pragma unroll
    for (int kb = 0; kb < 5; ++kb)
#pragma unroll
        for (int T = 0; T < 2; ++T)
#pragma unroll
            for (int qt = 0; qt < 2; ++qt)
#pragma unroll
                for (int i = 0; i < 4; ++i) {
                    const int jc0 = 128 - 32 * kb + 16 * qt - 4 * T - i;
                    if (kb >= 1 && kb <= 3) st[kb][T][qt][i] += bl[jc0];
                    else { const int jo = jc0 + r16 - 8 * g; const int jc = jo < 0 ? 0 : (jo > 128 ? 128 : jo); st[kb][T][qt][i] += biasL[jc]; }
                }
    __builtin_amdgcn_sched_barrier(0);
#pragma unroll
    for (int T = 0; T < 2; ++T)
#pragma unroll
        for (int qt = 0; qt < 2; ++qt)
#pragma unroll
            for (int i = 0; i < 4; ++i) {
                const int j0 = 128 + 16 * qt + r16 - 8 * g - 4 * T - i, j4 = j0 - 128;
                st[0][T][qt][i] = (j0 <= 128) ? st[0][T][qt][i] : -1e30f;
                st[4][T][qt][i] = (j4 >= 0) ? st[4][T][qt][i] : -1e30f;
            }
    if (i0 < 128) {
#pragma unroll
        for (int kb = 0; kb < 4; ++kb)
#pragma unroll
            for (int T = 0; T < 2; ++T)
#pragma unroll
                for (int qt = 0; qt < 2; ++qt)
#pragma unroll
                    for (int i = 0; i < 4; ++i) { const int ik = i0 - 128 + 32 * kb + 8 * g + 4 * T + i; st[kb][T][qt][i] = (ik >= 0) ? st[kb][T][qt][i] : -1e30f; }
    }
#pragma unroll
    for (int kb = 0; kb < 5; ++kb)
#pragma unroll
        for (int T = 0; T < 2; ++T)
#pragma unroll
            for (int qt = 0; qt < 2; ++qt)
#pragma unroll
                for (int i = 0; i < 4; ++i) mx[qt] = fmaxf(mx[qt], st[kb][T][qt][i]);
    float sum[2];
#pragma unroll
    for (int qt = 0; qt < 2; ++qt) { mx[qt] = fmaxf(mx[qt], __shfl_xor(mx[qt], 16)); mx[qt] = fmaxf(mx[qt], __shfl_xor(mx[qt], 32)); sum[qt] = 0.f; }
#pragma unroll
    for (int kb = 0; kb < 5; ++kb)
#pragma unroll
        for (int T = 0; T < 2; ++T)
#pragma unroll
            for (int qt = 0; qt < 2; ++qt)
#pragma unroll
                for (int i = 0; i < 4; ++i) { const float p = __builtin_amdgcn_exp2f(st[kb][T][qt][i] - mx[qt]); st[kb][T][qt][i] = p; sum[qt] += p; }
#pragma unroll
    for (int qt = 0; qt < 2; ++qt) { sum[qt] += __shfl_xor(sum[qt], 16); sum[qt] += __shfl_xor(sum[qt], 32); }
    f32x4 oa[4][2];
#pragma unroll
    for (int dt = 0; dt < 4; ++dt)
#pragma unroll
        for (int qt = 0; qt < 2; ++qt) oa[dt][qt] = (f32x4){0.f, 0.f, 0.f, 0.f};
#pragma unroll
    for (int kb = 0; kb < 5; ++kb) {
        bf16x8 pf[2];
#pragma unroll
        for (int qt = 0; qt < 2; ++qt) { u32x4 pw; pw.x = cvt2(st[kb][0][qt][0], st[kb][0][qt][1]); pw.y = cvt2(st[kb][0][qt][2], st[kb][0][qt][3]); pw.z = cvt2(st[kb][1][qt][0], st[kb][1][qt][1]); pw.w = cvt2(st[kb][1][qt][2], st[kb][1][qt][3]);
            pf[qt] = __builtin_bit_cast(bf16x8, pw); }
#pragma unroll
        for (int dt = 0; dt < 4; ++dt)
#pragma unroll
            for (int qt = 0; qt < 2; ++qt) {
                if constexpr (GI == 0) { if (qt == 0) vf[kb][dt] = *(const LAS bf16x8*)(lv + (16 * dt + r16) * 768 + ((((kl0 >> 3) + 4 * kb + g) ^ r16) << 4)); }
                oa[dt][qt] = __builtin_amdgcn_mfma_f32_16x16x32_bf16(vf[kb][dt], pf[qt], oa[dt][qt], 0, 0, 0); }
    }
#pragma unroll
    for (int qt = 0; qt < 2; ++qt) {
        const int tq = (i0 + 16 * qt + r16) * d + r;
        const float inv = 1.0f / sum[qt], lse = mx[qt] + __log2f(sum[qt]);
        float* scr = (float*)(act + (size_t)tq * FF);
        bf16_t* scb = act + (size_t)tq * FF;
        if (GI > 0) {
#pragma unroll
            for (int dt = 0; dt < 4; ++dt) { const f32x4 v = oa[dt][qt] * inv; u32x2 w; w.x = cvt2(v[0], v[1]); w.y = cvt2(v[2], v[3]); *(u32x2*)(scb + (GI - 1) * 512 + h * 64 + 16 * dt + 4 * g) = w; }
            if (g == 0) scr[1024 + (GI - 1) * 8 + h] = lse;
        } else {
            const float l1 = scr[1024 + h], l2 = scr[1024 + 8 + h];
            f32x4 o1[4], o2[4];
#pragma unroll
            for (int dt = 0; dt < 4; ++dt) { const int dim0 = h * 64 + 16 * dt + 4 * g; const u32x2 p1 = *(const u32x2*)(scb + dim0), p2 = *(const u32x2*)(scb + 512 + dim0);
                o1[dt] = (f32x4){bflo(p1.x), bfhi(p1.x), bflo(p1.y), bfhi(p1.y)}; o2[dt] = (f32x4){bflo(p2.x), bfhi(p2.x), bflo(p2.y), bfhi(p2.y)}; }
            const float mm = fmaxf(fmaxf(lse, l1), l2);
            const float w0 = __builtin_amdgcn_exp2f(lse - mm), w1 = __builtin_amdgcn_exp2f(l1 - mm), w2 = __builtin_amdgcn_exp2f(l2 - mm), iw = 1.0f / (w0 + w1 + w2);
            const float a0 = w0 * inv * iw, a1 = w1 * iw, a2 = w2 * iw;
#pragma unroll
            for (int dt = 0; dt < 4; ++dt) { const int dim0 = h * 64 + 16 * dt + 4 * g; const f32x4 v = oa[dt][qt] * a0 + o1[dt] * a1 + o2[dt] * a2;
                u32x2 w; w.x = cvt2(v[0], v[1]); w.y = cvt2(v[2], v[3]);
                ST8(ob, ((unsigned)tq * 512 + dim0) * 2u, w); }
        }
    }
}
__device__ __forceinline__ float wave_sum(float v) {
#pragma unroll
    for (int o = 1; o < 64; o <<= 1) v += __shfl_xor(v, o);
    return v;
}
__device__ __forceinline__ float wave_max(float v) {
#pragma unroll
    for (int o = 1; o < 64; o <<= 1) v = fmaxf(v, __shfl_xor(v, o));
    return v;
}
__device__ __forceinline__ void sample_attn_group(int g, int b, int h, const bf16_t* qk, const bf16_t* vnew, const float* ck, const float* cv, const float* biasT, LAS float* smp, int lane) {
    const int d = 1 << (2 * g), W = 128 << (2 * g), row = S + b, kq = lane >> 3, dc = lane & 7;
    float q[64];
    { const u32x4* qp = (const u32x4*)(qk + (size_t)row * 3072 + g * 1024 + h * 64);
#pragma unroll
      for (int c = 0; c < 8; ++c) { const u32x4 t = qp[c]; q[8 * c] = bflo(t.x); q[8 * c + 1] = bfhi(t.x); q[8 * c + 2] = bflo(t.y); q[8 * c + 3] = bfhi(t.y); q[8 * c + 4] = bflo(t.z); q[8 * c + 5] = bfhi(t.z); q[8 * c + 6] = bflo(t.w); q[8 * c + 7] = bfhi(t.w); } }
    float sc[3];
#pragma unroll
    for (int rnd = 0; rnd < 3; ++rnd) {
        const int j = lane + 64 * rnd; float s = -1e30f;
        if (j <= 128) { float a = 0.f;
            if (j == 0) { const u32x4* kp = (const u32x4*)(qk + (size_t)row * 3072 + g * 1024 + 512 + h * 64);
#pragma unroll
                for (int c = 0; c < 8; ++c) { const u32x4 t = kp[c]; a += q[8 * c] * bflo(t.x) + q[8 * c + 1] * bfhi(t.x) + q[8 * c + 2] * bflo(t.y) + q[8 * c + 3] * bfhi(t.y) + q[8 * c + 4] * bflo(t.z) + q[8 * c + 5] * bfhi(t.z) + q[8 * c + 6] * bflo(t.w) + q[8 * c + 7] * bfhi(t.w); } }
            else { const f32x4* kp = (const f32x4*)(ck + (((size_t)b * W + (W - j * d)) * 8 + h) * 64);
#pragma unroll
                for (int c = 0; c < 16; ++c) { const f32x4 t = __builtin_nontemporal_load(kp + c); a += q[4 * c] * t.x + q[4 * c + 1] * t.y + q[4 * c + 2] * t.z + q[4 * c + 3] * t.w; } }
            s = a + biasT[(g * 8 + h) * 132 + j]; }
        sc[rnd] = s;
    }
    const float mx = wave_max(fmaxf(fmaxf(sc[0], sc[1]), sc[2]));
    float p[3]; float sum = 0.f;
#pragma unroll
    for (int rnd = 0; rnd < 3; ++rnd) { p[rnd] = (sc[rnd] > -1e29f) ? __builtin_amdgcn_exp2f(sc[rnd] - mx) : 0.f; sum += p[rnd]; }
    sum = wave_sum(sum);
    const float inv = 1.0f / sum;
    float o[8] = {0.f, 0.f, 0.f, 0.f, 0.f, 0.f, 0.f, 0.f};
#pragma unroll
    for (int i = 0; i < 17; ++i) {
        const int j = kq + 8 * i, src = j & 63, rnd = j >> 6;
        const float p0 = __shfl(p[0], src), p1 = __shfl(p[1], src), p2 = __shfl(p[2], src);
        const float pj = (rnd == 0) ? p0 : ((rnd == 1) ? p1 : p2);
        if (j <= 128) {
            if (j == 0) { const u32x4 t = *(const u32x4*)(vnew + (size_t)b * 1536 + g * 512 + h * 64 + 8 * dc);
                o[0] += pj * bflo(t.x); o[1] += pj * bfhi(t.x); o[2] += pj * bflo(t.y); o[3] += pj * bfhi(t.y); o[4] += pj * bflo(t.z); o[5] += pj * bfhi(t.z); o[6] += pj * bflo(t.w); o[7] += pj * bfhi(t.w); }
            else { const f32x4* vp = (const f32x4*)(cv + (((size_t)b * W + (W - j * d)) * 8 + h) * 64 + 8 * dc); const f32x4 t0 = __builtin_nontemporal_load(vp), t1 = __builtin_nontemporal_load(vp + 1);
                o[0] += pj * t0.x; o[1] += pj * t0.y; o[2] += pj * t0.z; o[3] += pj * t0.w; o[4] += pj * t1.x; o[5] += pj * t1.y; o[6] += pj * t1.z; o[7] += pj * t1.w; }
        }
    }
#pragma unroll
    for (int e = 0; e < 8; ++e) { float v = o[e]; v += __shfl_xor(v, 8); v += __shfl_xor(v, 16); v += __shfl_xor(v, 32); if (kq == 0) smp[g * 72 + 8 * dc + e] = v * inv; }
    if (lane == 0) smp[g * 72 + 64] = mx + __log2f(sum);
}

template <int W>
__device__ __forceinline__ void pool_strip(const bf16_t* ub, const float* state_pool, rsrc_t rs_z, int r0, int ch) {
    if (r0 < S) {
        u32x4 raw[16 + W - 1];
#pragma unroll
        for (int i = 0; i < 16 + W - 1; ++i) { const int row = r0 - (W - 1) + i; raw[i] = (row >= 0) ? *(const u32x4*)(ub + (size_t)row * D + ch) : (u32x4){0u, 0u, 0u, 0u}; }
        float run[8] = {0.f, 0.f, 0.f, 0.f, 0.f, 0.f, 0.f, 0.f};
#pragma unroll
        for (int i = 0; i < W - 1; ++i) { run[0] += bflo(raw[i].x); run[1] += bfhi(raw[i].x); run[2] += bflo(raw[i].y); run[3] += bfhi(raw[i].y); run[4] += bflo(raw[i].z); run[5] += bfhi(raw[i].z); run[6] += bflo(raw[i].w); run[7] += bfhi(raw[i].w); }
#pragma unroll
        for (int i = 0; i < 16; ++i) {
            const u32x4 c = raw[i + W - 1]; const float cv[8] = {bflo(c.x), bfhi(c.x), bflo(c.y), bfhi(c.y), bflo(c.z), bfhi(c.z), bflo(c.w), bfhi(c.w)};
#pragma unroll
            for (int e = 0; e < 8; ++e) run[e] += cv[e];
            const int row = r0 + i; const float ic = 1.0f / (float)(W < row + 1 ? W : row + 1);
            u32x4 o; o.x = pk2(run[0] * ic - cv[0], run[1] * ic - cv[1]); o.y = pk2(run[2] * ic - cv[2], run[3] * ic - cv[3]); o.z = pk2(run[4] * ic - cv[4], run[5] * ic - cv[5]); o.w = pk2(run[6] * ic - cv[6], run[7] * ic - cv[7]);
            ST16(rs_z, ((unsigned)row * D + ch) * 2u, o);
            const u32x4 l = raw[i];
            run[0] -= bflo(l.x); run[1] -= bfhi(l.x); run[2] -= bflo(l.y); run[3] -= bfhi(l.y); run[4] -= bflo(l.z); run[5] -= bfhi(l.z); run[6] -= bflo(l.w); run[7] -= bfhi(l.w);
        }
    } else {
#pragma nounroll
        for (int i = 0; i < 16; ++i) {
            const int row = r0 + i; u32x4 o = {0u, 0u, 0u, 0u};
            if (row < MV) {
                const u32x4 c = *(const u32x4*)(ub + (size_t)row * D + ch); const float cv[8] = {bflo(c.x), bfhi(c.x), bflo(c.y), bfhi(c.y), bflo(c.z), bfhi(c.z), bflo(c.w), bfhi(c.w)};
                float a[8];
#pragma unroll
                for (int e = 0; e < 8; ++e) a[e] = cv[e];
                const float* sp = state_pool + (size_t)(row - S) * 15 * D + ch;
#pragma unroll
                for (int k = 1; k < W; ++k) { const f32x4 p0 = *(const f32x4*)(sp + (size_t)(15 - k) * D), p1 = *(const f32x4*)(sp + (size_t)(15 - k) * D + 4);
                    a[0] += p0.x; a[1] += p0.y; a[2] += p0.z; a[3] += p0.w; a[4] += p1.x; a[5] += p1.y; a[6] += p1.z; a[7] += p1.w; }
                const float ic = 1.0f / (float)W;
                o.x = pk2(a[0] * ic - cv[0], a[1] * ic - cv[1]); o.y = pk2(a[2] * ic - cv[2], a[3] * ic - cv[3]); o.z = pk2(a[4] * ic - cv[4], a[5] * ic - cv[5]); o.w = pk2(a[6] * ic - cv[6], a[7] * ic - cv[7]);
            }
            ST16(rs_z, ((unsigned)row * D + ch) * 2u, o);
        }
    }
}

struct Args { const float* in[26]; float* out; unsigned char* ws; };
enum { PH_GU0 = 0, PH_D0, PH_WIN, PH_POOL, PH_GRP, PH_WPO, PH_GU1, PH_D1, PH_GU2, PH_D2, PH_QKV, PH_ATT, PH_WAO, PH_GU3, PH_D3, NPHC };

constexpr int NWAVES = 8, NTHR = 512;
constexpr int LDS_BYTES = 147456;

__device__ __forceinline__ void tr_item(const float* W, int ldw, int k0, int n0, bf16_t* dst, int ldd, const float* kscale, const float* nscale, float f, LAS float* scr, int lane) {
    const rsrc_t rs = mkrs(dst, (size_t)1 << 30);
    float tv[32];
#pragma unroll
    for (int i = 0; i < 32; ++i) { const int kk = 2 * i + (lane >> 5); tv[i] = __builtin_nontemporal_load(W + (size_t)(k0 + kk) * ldw + n0 + (lane & 31)); }
#pragma unroll
    for (int i = 0; i < 32; ++i) { const int kk = 2 * i + (lane >> 5); float v = tv[i]; if (kscale) v *= kscale[k0 + kk]; scr[kk * 33 + (lane & 31)] = v; }
    LDS_WAIT(); asm volatile("" ::: "memory");
    const int c = lane & 7;
#pragma unroll
    for (int j = 0; j < 4; ++j) { const int n = (lane >> 3) + 8 * j; const LAS float* s = scr + (8 * c) * 33 + n; const float fn = nscale ? f * nscale[n0 + n] : f;
        u32x4 o; o.x = pk2(s[0 * 33] * fn, s[1 * 33] * fn); o.y = pk2(s[2 * 33] * fn, s[3 * 33] * fn); o.z = pk2(s[4 * 33] * fn, s[5 * 33] * fn); o.w = pk2(s[6 * 33] * fn, s[7 * 33] * fn);
        ST16(rs, (unsigned)(n * ldd + k0 + 8 * c) * 2u, o); }
    LDS_WAIT(); asm volatile("" ::: "memory");
}
__device__ __forceinline__ int t5_bucket(int dist) {
    if (dist < 16) return dist;
    const int b = 16 + (int)(log((double)dist / 16.0) / log(128.0) * 16.0);
    return b < 31 ? b : 31;
}

#ifndef PM
#define PM 0xffffff
#endif
#define ON(k) if ((PM >> (k)) & 1)
__global__ void __launch_bounds__(NTHR, 2) fwd_kernel(Args args) {
    extern __shared__ __attribute__((aligned(16))) unsigned char lds_raw[];
    LAS unsigned char* lds = (LAS unsigned char*)lds_raw;
    const int tid = threadIdx.x, lane = tid & 63, wave = __builtin_amdgcn_readfirstlane(tid >> 6);
    const int G = gridDim.x, bx = blockIdx.x;
    const int gw = bx * NWAVES + wave, NGW = G * NWAVES;
    const size_t gt = (size_t)bx * NTHR + tid, NGT = (size_t)G * NTHR;
    unsigned char* ws = args.ws; float* out = args.out;
    bf16_t* Wgu = (bf16_t*)(ws + WS_WGU); bf16_t* Wd = (bf16_t*)(ws + WS_WD); bf16_t* Win = (bf16_t*)(ws + WS_WIN); bf16_t* Wgrp = (bf16_t*)(ws + WS_WGRP);
    bf16_t* Wpo = (bf16_t*)(ws + WS_WPO); bf16_t* Wqkv = (bf16_t*)(ws + WS_WQKV); bf16_t* Wao = (bf16_t*)(ws + WS_WAO);
    float* biasT = (float*)(ws + WS_BIAS); float* part = (float*)(ws + WS_PART);
    bf16_t* xb = (bf16_t*)(ws + WS_XB); bf16_t* act = (bf16_t*)(ws + WS_ACT);
    bf16_t* ub = (bf16_t*)(ws + WS_U); bf16_t* zb = (bf16_t*)(ws + WS_Z); bf16_t* z2b = (bf16_t*)(ws + WS_Z2); bf16_t* qk = (bf16_t*)(ws + WS_QK); bf16_t* vT = (bf16_t*)(ws + WS_VT); bf16_t* ob = (bf16_t*)(ws + WS_O); bf16_t* vnew = (bf16_t*)(ws + WS_VNEW);
    const float* x_prompt = args.in[0]; const float* x_sample = args.in[1]; const float* state_pool = args.in[2];
    cg::grid_group grid = cg::this_grid();
    unsigned* ctl = (unsigned*)(ws + WS_CTL);
#define CNT(ph) (ctl + (size_t)(ph) * 72 * 64)
    constexpr size_t QOFF = (size_t)NPHC * 72 * 64 + 1024, QWORDS = (size_t)48 * 8 * 64;

    constexpr int I_GU = 16 * 88, I_D = 44 * 32, I_IN = 16 * 32, I_GRP = 4 * 8, I_QKV = 16 * 144, I_AO = 8 * 32;
#define TR_SCR ((LAS float*)(lds + wave * 16384))
#define CV_FOR(q, OFF_, CNT_) for (int q = gw - (OFF_) + (gw < (OFF_) ? NGW : 0); q < (CNT_); q += NGW)
#define CV_GU(f_, OFF_) CV_FOR(q2, OFF_, 2 * I_GU) { const int f = (f_), up = q2 / I_GU, q = q2 % I_GU, kb = q / 88, nb = q % 88, n0 = nb * 32, layer = f >> 1, second = f & 1; \
        tr_item(args.in[(second ? 22 : 10) + up] + (size_t)layer * D * FF, FF, kb * 64, n0, Wgu + (size_t)f * 2 * FF * D + (size_t)((n0 / 128) * 256 + (n0 % 128) + up * 128) * D, D, \
                args.in[second ? 21 : 9] + layer * D, nullptr, 1.0f, TR_SCR, lane_c); }
#define CV_D(f_, OFF_) CV_FOR(q, OFF_, I_D) { const int f = (f_), kb = q / 32, nb = q % 32, layer = f >> 1, second = f & 1; \
        tr_item(args.in[(second ? 22 : 10) + 2] + (size_t)layer * FF * D, D, kb * 64, nb * 32, Wd + (size_t)f * D * FF + (size_t)(nb * 32) * FF, FF, nullptr, nullptr, 0.5f, TR_SCR, lane_c); }
#define CV_IN(OFF_) CV_FOR(q, OFF_, I_IN) { const int kb = q / 32, nb = q % 32; tr_item(args.in[14], D, kb * 64, nb * 32, Win + (size_t)(nb * 32) * D, D, args.in[13], nullptr, 1.0f, TR_SCR, lane_c); }
#define CV_GRP(OFF_) CV_FOR(q2, OFF_, 4 * I_GRP) { const int gq = q2 / I_GRP, q = q2 % I_GRP, kb = q / 8, nb = q % 8; \
        tr_item(args.in[15] + (size_t)gq * 256 * 256, 256, kb * 64, nb * 32, Wgrp + (size_t)(gq * 256 + nb * 32) * 256, 256, nullptr, args.in[16] + gq * 256, 1.0f, TR_SCR, lane_c); }
#define CV_PO(OFF_) CV_FOR(q, OFF_, I_IN) { const int kb = q / 32, nb = q % 32; tr_item(args.in[17], D, kb * 64, nb * 32, Wpo + (size_t)(nb * 32) * D, D, nullptr, nullptr, 1.0f, TR_SCR, lane_c); }
#define CV_QKV(OFF_) CV_FOR(q, OFF_, I_QKV) { const int kb = q / 144, nb = q % 144, n0 = nb * 32; const float fs = ((n0 % 1536) < 512) ? 0.125f * 1.4426950408889634f : 1.0f; \
        const int gg = n0 / 1536, ss = (n0 % 1536) / 512, he = n0 % 512; const int drow = ss < 2 ? gg * 1024 + ss * 512 + he : 3072 + gg * 512 + he; \
        tr_item(args.in[18], QKVW, kb * 64, n0, Wqkv + (size_t)drow * D, D, args.in[13] + D, nullptr, fs, TR_SCR, lane_c); }
#define CV_AO(OFF_) CV_FOR(q, OFF_, I_AO) { const int kb = q / 32, nb = q % 32; tr_item(args.in[19], D, kb * 64, nb * 32, Wao + (size_t)(nb * 32) * 512, 512, nullptr, nullptr, 1.0f, TR_SCR, lane_c); }
#define WC(c) (ctl + (size_t)NPHC * 72 * 64 + (size_t)(c) * 64)
#define CONV_POINT(c, BODY) do { int lane_c = threadIdx.x; asm volatile("" : "+v"(lane_c)); lane_c &= 63; BODY VM_WAIT(); if (lane_c == 0) __hip_atomic_fetch_add(WC(c), 1u, RLX_AGENT); __syncthreads(); } while (0)
    ON(0) {
        LAS float* scr = (LAS float*)(lds + wave * 16384);
        { const int lane_c = lane; CV_GU(0, 0) CV_D(0, 768) }
        for (int row = gw; row < MP; row += NGW) {
            f32x4 v[4]; float s = 0.f;
            if (row < MV) { const f32x4* xr = (const f32x4*)(row < S ? x_prompt + (size_t)row * D : x_sample + (size_t)(row - S) * D) + lane;
#pragma unroll
                for (int j = 0; j < 4; ++j) { v[j] = __builtin_nontemporal_load(xr + 64 * j); s += (v[j].x * v[j].x + v[j].y * v[j].y) + (v[j].z * v[j].z + v[j].w * v[j].w); } }
            else {
#pragma unroll
                for (int j = 0; j < 4; ++j) v[j] = (f32x4){0.f, 0.f, 0.f, 0.f}; }
            s = wave_sum(s);
            u32x2* o8 = (u32x2*)(xb + (size_t)row * D) + lane;
#pragma unroll
            for (int j = 0; j < 4; ++j) { u32x2 w; w.x = pk2(v[j].x, v[j].y); w.y = pk2(v[j].z, v[j].w); o8[64 * j] = w; }
            if (lane < 4) part[(size_t)row * 4 + lane] = (lane == 0) ? s : 0.f;
        }
        for (size_t i = gt; i < 3 * 8 * 132; i += NGT) { const int j = (int)(i % 132), gh = (int)(i / 132), g = gh / 8, h = gh % 8;
            biasT[i] = (j <= 128) ? 1.4426950408889634f * args.in[20][t5_bucket(j * (1 << (2 * g))) * 24 + g * 8 + h] : 0.f; }
        for (size_t i = gt; i < (size_t)NS * 14 * (D / 4); i += NGT) { const size_t b = i / (14 * (D / 4)), rem = i % (14 * (D / 4));
            ((f32x4*)(out + O_PSS + b * 15 * D))[rem] = ((const f32x4*)(state_pool + b * 15 * D + D))[rem]; }
        for (size_t i = gt; i < QOFF + QWORDS; i += NGT) ctl[i] = 0u;
        for (size_t i = gt; i < (size_t)(MP - MV) * 64; i += NGT) ((u32x4*)(ob + (size_t)MV * 512))[i] = (u32x4){0u, 0u, 0u, 0u};
    }
    grid.sync();

    const int xcd = bx % 8;
    unsigned* qbase = ctl + QOFF; int qi = 0; int sk_id = 0; LAS unsigned* qslot = (LAS unsigned*)(lds + 131072 + 4096);
    CopyJob cjob{args.in, out, bx};
    const rsrc_t rs_act = mkrs(act, (size_t)MP * FF * 2), rs_xb = mkrs(xb, (size_t)MP * D * 2), rs_part = mkrs(part, (size_t)MP * 16);
    LAS float* red = (LAS float*)(lds + 131072);
    const unsigned* wdep_next = nullptr;
#define FLOW_GEMM(EPI_T, EPI_INIT, Aptr, LDA_, Bptr, LDB_, K_, NM_, NN_, APN_, BSIG_, DEP_, NEED_, DEPPN_, DEPSH_, PUB_, PUBPN_) do { \
        pg8::Gemm g{(const bf16_t*)(Aptr), (const bf16_t*)(Bptr), (LDA_), (LDB_), (K_), (APN_), (BSIG_)}; pg8::FlowOrder So; So.init((NM_), (NN_), 2, xcd, qbase, qi, qslot); \
        So.dep = (DEP_); So.need = (NEED_); So.need64 = (NEED_); So.dep_pn = (DEPPN_); So.dep_shift = (DEPSH_); So.pub = (PUB_); So.pub_pn = (PUBPN_); So.wdep = wdep_next; So.wneed = (unsigned)NGW; wdep_next = nullptr; \
        EPI_T E EPI_INIT; pg8::gemm_phase<EPI_T, pg8::FlowOrder>(lds, g, So, E); } while (0)
#define SKINNY(EPI_T, EPI_INIT, Aptr, LDA_, Bptr, LDB_, K_, NN_, APN_, DEP_, NEED_, PUB_) do { \
        const pg8::Gemm g{(const bf16_t*)(Aptr), (const bf16_t*)(Bptr), (LDA_), (LDB_), (K_), (APN_), 1}; \
        ++sk_id; \
        for (int j = 0; j < (NN_); ++j) if ((sk_id * 29 + j * 13 + 7) % G == bx) {        \
            EPI_T E EPI_INIT; const unsigned* dp = (DEP_); \
            if (dp) { if (tid < 64) { flow_poll1(dp + (size_t)64 * 64, (NEED_)); __builtin_amdgcn_fence(__ATOMIC_ACQUIRE, "agent"); VM_WAIT(); } } \
            __syncthreads(); skinny_unit<EPI_T>(lds, g, j, E); flow_publish((PUB_) + (size_t)64 * 64); __syncthreads(); } \
        } while (0)
#define SKINNY_Q(EPI_T, EPI_INIT, Aptr, LDA_, Bptr, LDB_, K_, NN_, APN_, DEP_, NEED_, PUB_) do { \
        const pg8::Gemm g{(const bf16_t*)(Aptr), (const bf16_t*)(Bptr), (LDA_), (LDB_), (K_), (APN_), 1}; pg8::FlowOrder So; So.init(1, (NN_), 1, xcd, qbase, qi, qslot); \
        EPI_T E EPI_INIT; Unit u; \
        while (So.next_blocking(u)) { const unsigned* dp = (DEP_); \
            if (dp) { if (tid < 64) { flow_poll1(dp + (size_t)64 * 64, (NEED_)); __builtin_amdgcn_fence(__ATOMIC_ACQUIRE, "agent"); VM_WAIT(); } } \
            __syncthreads(); skinny_unit<EPI_T>(lds, g, u.pn, E); flow_publish((PUB_) + (size_t)64 * 64); } \
        __syncthreads(); } while (0)
#define GU_PHASE(f, DEP_, PH_) do { FLOW_GEMM(EpiGU, ({{}, rs_act, part, &cjob}), xb, D, Wgu + (size_t)(f) * 2 * FF * D, D, D, 64, 22, 0, 1, DEP_, 32u, 0, 0, CNT(PH_), 0); \
        SKINNY(EpiGU, ({{}, rs_act, part, &cjob}), xb, D, Wgu + (size_t)(f) * 2 * FF * D, D, D, 22, 0, DEP_, 32u, CNT(PH_)); } while (0)
#define DN_PHASE(LAST_, RSXO_, f, DEP_, PH_) do { FLOW_GEMM(EpiRes<LAST_>, ({{}, xb, RSXO_, rs_xb, rs_part, red}), act, FF, Wd + (size_t)(f) * D * FF, FF, FF, 64, 4, 0, 1, DEP_, 176u, 0, 0, CNT(PH_), 0); \
        SKINNY(EpiRes<LAST_>, ({{}, xb, RSXO_, rs_xb, rs_part, red}), act, FF, Wd + (size_t)(f) * D * FF, FF, FF, 4, 0, DEP_, 176u, CNT(PH_)); } while (0)

#ifndef PM
#define PM 0xffffff
#endif
    ON(1) GU_PHASE(0, nullptr, PH_GU0);
    CONV_POINT(1, CV_IN(0) CV_GRP(512) CV_PO(640));
    ON(2) DN_PHASE(false, rs_xb, 0, CNT(PH_GU0), PH_D0);
    CONV_POINT(2, CV_GU(1, 0));
    wdep_next = WC(1);
    ON(3) { FLOW_GEMM(EpiU, ({{}, mkrs(ub, (size_t)MP * D * 2), part, out + O_PSP, out + O_PSS}), xb, D, Win, D, D, 64, 4, 0, 1, CNT(PH_D0), 32u, 0, 0, CNT(PH_WIN), 0);
            SKINNY(EpiU, ({{}, mkrs(ub, (size_t)MP * D * 2), part, out + O_PSP, out + O_PSS}), xb, D, Win, D, D, 4, 0, CNT(PH_D0), 32u, CNT(PH_WIN)); }
    ON(4)
    for (int sm = 0; sm < 2; ++sm) {
        pg8::FlowOrder So; So.init(sm ? 1 : 64, 4, sm ? 1 : 2, xcd, qbase, qi, qslot);
        const rsrc_t rs_z = mkrs(zb, (size_t)MP * D * 2);
        Unit u;
        while (So.next_blocking(u)) {
            const int pm = sm ? 64 : u.pm;
            if (tid < 64) { flow_poll1(CNT(PH_WIN) + (size_t)pm * 64, 32u); if (pm > 0 && pm < 64) flow_poll1(CNT(PH_WIN) + (size_t)(pm - 1) * 64, 32u);
                __builtin_amdgcn_fence(__ATOMIC_ACQUIRE, "agent"); VM_WAIT(); }
            __syncthreads();
            {
                const int chunk = tid & 31, strip = tid >> 5, ch = u.pn * 256 + chunk * 8, r0 = pm * 256 + strip * 16;
                if (u.pn == 0) pool_strip<2>(ub, state_pool, rs_z, r0, ch);
                else if (u.pn == 1) pool_strip<4>(ub, state_pool, rs_z, r0, ch);
                else if (u.pn == 2) pool_strip<8>(ub, state_pool, rs_z, r0, ch);
                else pool_strip<16>(ub, state_pool, rs_z, r0, ch);
            }
            flow_publish(CNT(PH_POOL) + (size_t)pm * 64);
        }
    }
    CONV_POINT(3, CV_D(1, 0));
    wdep_next = WC(1);
    ON(5) { FLOW_GEMM(EpiPlain, ({{}, mkrs(z2b, (size_t)MP * D * 2)}), zb, D, Wgrp, 256, 256, 64, 4, 256, 1, CNT(PH_POOL), 32u, 0, 0, CNT(PH_GRP), 0);
            SKINNY(EpiPlain, ({{}, mkrs(z2b, (size_t)MP * D * 2)}), zb, D, Wgrp, 256, 256, 4, 256, CNT(PH_POOL), 32u, CNT(PH_GRP)); }
    wdep_next = WC(1);
    ON(6) { FLOW_GEMM(EpiRes<false>, ({{}, xb, rs_xb, rs_xb, rs_part, red}), z2b, D, Wpo, D, D, 64, 4, 0, 1, CNT(PH_GRP), 32u, 0, 0, CNT(PH_WPO), 0);
            SKINNY(EpiRes<false>, ({{}, xb, rs_xb, rs_xb, rs_part, red}), z2b, D, Wpo, D, D, 4, 0, CNT(PH_GRP), 32u, CNT(PH_WPO)); }
    CONV_POINT(4, CV_GU(2, 0));
    wdep_next = WC(2);
    ON(7) GU_PHASE(1, CNT(PH_WPO), PH_GU1);
    CONV_POINT(5, CV_D(2, 0));
    wdep_next = WC(3);
    ON(8) DN_PHASE(false, rs_xb, 1, CNT(PH_GU1), PH_D1);
    CONV_POINT(6, CV_QKV(0));
    wdep_next = WC(4);
    ON(9) GU_PHASE(2, CNT(PH_D1), PH_GU2);
    CONV_POINT(7, CV_AO(0) CV_GU(3, 256));
    wdep_next = WC(5);
    ON(10) DN_PHASE(false, rs_xb, 2, CNT(PH_GU2), PH_D2);
    CONV_POINT(8, CV_D(3, 0));
    wdep_next = WC(6);
    ON(11) { FLOW_GEMM(EpiQK, ({{}, mkrs(qk, (size_t)MP * 3072 * 2), part, out, mkrs(vnew, (size_t)NS * 1536 * 2)}), xb, D, Wqkv, D, D, 64, 12, 0, 1, CNT(PH_D2), 32u, 0, 0, CNT(PH_QKV), 0);
             SKINNY(EpiQK, ({{}, mkrs(qk, (size_t)MP * 3072 * 2), part, out, mkrs(vnew, (size_t)NS * 1536 * 2)}), xb, D, Wqkv, D, D, 18, 0, CNT(PH_D2), 32u, CNT(PH_QKV)); }
    ON(12)
#pragma unroll
    for (int gi = 0; gi < 3; ++gi)
        FLOW_GEMM(EpiVT, ({mkrs(vT + (size_t)gi * 512 * MPV, (size_t)512 * MPV * 2), part, out, gi, 1 << (2 * gi)}), Wqkv + (size_t)(3072 + gi * 512) * D, D, xb, D, D, 2, 64, 0, 1 << (2 * gi), CNT(PH_D2), 32u, 1, 0, CNT(PH_QKV), 1);
    ON(13) {
        LAS float* biasL = (LAS float*)(lds + 131072);
        LAS float* smp = (LAS float*)(lds + 131072 + 2048);
        const rsrc_t rs_o = mkrs(ob, (size_t)MP * 512 * 2);
        pg8::FlowOrder So; So.init(32, 8, 1, xcd, qbase, qi, qslot);
        Unit u;
        while (So.next_blocking(u)) {
            const int sp = u.pm, h = u.pn;
            if (tid < 64) { const int p0 = 2 * sp - 8 < 0 ? 0 : 2 * sp - 8, idx = p0 + lane; unsigned spn = 0;
                for (;;) { const unsigned v = (idx <= 2 * sp + 1) ? __hip_atomic_load(CNT(PH_QKV) + (size_t)idx * 64, RLX_AGENT) : 144u;
                    if (__all(v >= 144u)) break; __builtin_amdgcn_s_sleep(2); if (++spn > FLOW_SPIN_CAP) break; }
                            __builtin_amdgcn_fence(__ATOMIC_ACQUIRE, "agent"); VM_WAIT(); }
            __syncthreads();
            for (int j = tid; j < 3 * 132; j += NTHR) biasL[j] = biasT[((j / 132) * 8 + h) * 132 + (j % 132)];
            __syncthreads();
#pragma nounroll
            for (int k = 0; k < 2; ++k) attn_job<2>(qk, vT + (size_t)2 * 512 * MPV, biasL + 2 * 132, act, rs_o, h, wave + 8 * k, 32 * sp, lane);
#pragma nounroll
            for (int k = 0; k < 2; ++k) attn_job<1>(qk, vT + (size_t)1 * 512 * MPV, biasL + 1 * 132, act, rs_o, h, wave & 3, 128 * sp + 32 * ((wave >> 2) + 2 * k), lane);
            __syncthreads();
#pragma nounroll
            for (int k = 0; k < 2; ++k) {
                const int key0 = 512 * sp + 256 * k - 128;
                if (k) __syncthreads();
#pragma unroll
                for (int j = 0; j < 6; ++j) { const int p = (wave * 6 + j) * 1024 + lane * 16;
                    { const int key = p >> 7, c = ((p >> 4) & 7) ^ ((key >> 1) & 7); int tok = key0 + key; tok = tok < 0 ? 0 : tok;
                      __builtin_amdgcn_global_load_lds((const unsigned*)(qk + (size_t)tok * 3072 + 512 + h * 64 + c * 8), (LAS unsigned*)(lds + (wave * 6 + j) * 1024), 16, 0, 0); }
                    { const int dim = p / 768, c = ((p % 768) >> 4) ^ (dim & 15);
                      __builtin_amdgcn_global_load_lds((const unsigned*)(vT + (size_t)(h * 64 + dim) * MPV + 128 + key0 + c * 8), (LAS unsigned*)(lds + 49152 + (wave * 6 + j) * 1024), 16, 0, 0); } }
                VM_WAIT(); __syncthreads();
                attn_job<0>(qk, vT, biasL, act, rs_o, h, 0, 512 * sp + 32 * (wave + 8 * k), lane, lds, lds + 49152, 32 * wave);
            }
            flow_publish(CNT(PH_ATT) + (size_t)sp * 64);
        }
        pg8::FlowOrder Ss; Ss.init(NS, 8, 1, xcd, qbase, qi, qslot);
        while (Ss.next_blocking(u)) {
            const int b = u.pm, h = u.pn;
            if (tid < 64) { flow_poll1(CNT(PH_QKV) + (size_t)64 * 64, 144u); __builtin_amdgcn_fence(__ATOMIC_ACQUIRE, "agent"); VM_WAIT(); }
            __syncthreads();
            if (wave < 3) sample_attn_group(wave, b, h, qk, vnew, args.in[3 + 2 * wave], args.in[4 + 2 * wave], biasT, smp, lane);
            __syncthreads();
            if (wave == 0 && lane < 32) { const float l0 = smp[64], l1 = smp[72 + 64], l2 = smp[144 + 64], mm = fmaxf(fmaxf(l0, l1), l2);
                const float w0 = __builtin_amdgcn_exp2f(l0 - mm), w1 = __builtin_amdgcn_exp2f(l1 - mm), w2 = __builtin_amdgcn_exp2f(l2 - mm), iw = 1.0f / (w0 + w1 + w2);
                const float r0 = (w0 * smp[2 * lane] + w1 * smp[72 + 2 * lane] + w2 * smp[144 + 2 * lane]) * iw, r1 = (w0 * smp[2 * lane + 1] + w1 * smp[72 + 2 * lane + 1] + w2 * smp[144 + 2 * lane + 1]) * iw;
                ST4(rs_o, ((unsigned)(S + b) * 512 + h * 64 + 2 * lane) * 2u, pk2(r0, r1)); }
            flow_publish(CNT(PH_ATT) + (size_t)32 * 64);
        }
        __syncthreads();
    }
    wdep_next = WC(7);
    ON(14) { FLOW_GEMM(EpiRes<false>, ({{}, xb, rs_xb, rs_xb, rs_part, red}), ob, 512, Wao, 512, 512, 64, 4, 0, 1, CNT(PH_ATT), 64u, 0, 1, CNT(PH_WAO), 0);
             SKINNY(EpiRes<false>, ({{}, xb, rs_xb, rs_xb, rs_part, red}), ob, 512, Wao, 512, 512, 4, 0, CNT(PH_ATT) - (size_t)32 * 64, (unsigned)(NS * 8 * 8), CNT(PH_WAO)); }
    wdep_next = WC(7);
    ON(15) { FLOW_GEMM(EpiGU, ({{}, rs_act, part, &cjob}), xb, D, Wgu + (size_t)3 * 2 * FF * D, D, D, 64, 22, 0, 1, CNT(PH_WAO), 32u, 0, 0, CNT(PH_GU3), 0);
             SKINNY_Q(EpiGU, ({{}, rs_act, part, &cjob}), xb, D, Wgu + (size_t)3 * 2 * FF * D, D, D, 22, 0, CNT(PH_WAO), 32u, CNT(PH_GU3)); }
    wdep_next = WC(8);
    ON(16) { FLOW_GEMM(EpiRes<false>, ({{}, xb, rs_xb, rs_xb, rs_part, red}), act, FF, Wd + (size_t)3 * D * FF, FF, FF, 64, 4, 0, 1, CNT(PH_GU3), 176u, 0, 0, CNT(PH_D3), 0);
             SKINNY_Q(EpiRes<false>, ({{}, xb, rs_xb, rs_xb, rs_part, red}), act, FF, Wd + (size_t)3 * D * FF, FF, FF, 4, 0, CNT(PH_GU3), 176u, CNT(PH_D3)); }
    ON(17) {
        pg8::FlowOrder So; So.init(NPANEL, 4, 1, xcd, qbase, qi, qslot);
        const float* gf = args.in[25]; Unit u;
        while (So.next_blocking(u)) {
            if (tid < 64) { flow_poll1(CNT(PH_D3) + (size_t)u.pm * 64, 32u); __builtin_amdgcn_fence(__ATOMIC_ACQUIRE, "agent"); VM_WAIT(); }
            __syncthreads();
            u32x2 xw[8][4]; float rsv[8];
#pragma unroll
            for (int k = 0; k < 8; ++k) { int row = u.pm * 256 + u.pn * 64 + wave + 8 * k; if (row >= MV) row = MV - 1;
                rsv[k] = rstd_of(part, row); const u32x2* xr = (const u32x2*)(xb + (size_t)row * D) + lane;
#pragma unroll
                for (int j = 0; j < 4; ++j) xw[k][j] = xr[64 * j]; }
            f32x4 gg[4];
#pragma unroll
            for (int j = 0; j < 4; ++j) gg[j] = ((const f32x4*)gf + lane)[64 * j];
#pragma unroll
            for (int k = 0; k < 8; ++k) { const int row = u.pm * 256 + u.pn * 64 + wave + 8 * k;
                if (row < MV) { f32x4* xr = (f32x4*)(out + (size_t)row * D) + lane;
#pragma unroll
                    for (int j = 0; j < 4; ++j) { const f32x4 xv = {bflo(xw[k][j].x), bfhi(xw[k][j].x), bflo(xw[k][j].y), bfhi(xw[k][j].y)}; __builtin_nontemporal_store(xv * rsv[k] * gg[j], xr + 64 * j); } } }
        }
    }
    for (int chunk = cjob.next; chunk < CP_CHUNKS; chunk += 256) {
#pragma unroll
        for (int q = 0; q < 4; ++q) { const f32x4* src; f32x4* dst; if (cp_addr(args.in, out, chunk * 32 + wave * 4 + q, lane, src, dst)) { const f32x4 a0 = __builtin_nontemporal_load(src), a1 = __builtin_nontemporal_load(src + 64); __builtin_nontemporal_store(a0, dst); __builtin_nontemporal_store(a1, dst + 64); } }
    }
}

extern "C" void kernel_launch(void* const* d_in, const int* in_sizes, int n_in, void* d_out, int out_size, void* d_ws, size_t ws_size, hipStream_t stream) {
    static int grid = 0;
    if (grid == 0) {
        if (n_in != 26 || (size_t)out_size != OUT_TOTAL || ws_size < WS_END) { fprintf(stderr, "kernel_launch: unexpected shapes: n_in %d out %d (want %zu) ws %zu (need %zu)\n", n_in, out_size, (size_t)OUT_TOTAL, ws_size, (size_t)WS_END); grid = -1; return; }
        int dev = 0, cus = 0, per_cu = 0;
        hipGetDevice(&dev); hipDeviceGetAttribute(&cus, hipDeviceAttributeMultiprocessorCount, dev);
        hipFuncSetAttribute((const void*)fwd_kernel, hipFuncAttributeMaxDynamicSharedMemorySize, LDS_BYTES);
        hipOccupancyMaxActiveBlocksPerMultiprocessor(&per_cu, (const void*)fwd_kernel, NTHR, LDS_BYTES);
        if (per_cu < 1) { fprintf(stderr, "kernel_launch: occupancy query says %d blocks per CU\n", per_cu); per_cu = 1; }
        grid = cus;
        (void)hipGetLastError();
    }
    if (grid < 0) return;
    Args a{};
    for (int i = 0; i < 26; ++i) a.in[i] = (const float*)d_in[i];
    a.out = (float*)d_out; a.ws = (unsigned char*)d_ws;
    void* kargs[] = {&a};
    hipError_t e = hipLaunchCooperativeKernel((const void*)fwd_kernel, dim3(grid), dim3(NTHR), kargs, LDS_BYTES, stream);
    if (e != hipSuccess) fprintf(stderr, "cooperative launch failed: %s (grid %d)\n", hipGetErrorString(e), grid);
}
```

```cpp
#include <hip/hip_runtime.h>
#include <hip/hip_cooperative_groups.h>
#include <cstdio>
#include <cstdint>
namespace cg = cooperative_groups;


#define LAS __attribute__((address_space(3)))
typedef unsigned short bf16_t;
typedef short bf16x8 __attribute__((ext_vector_type(8)));
typedef float f32x4 __attribute__((ext_vector_type(4)));
typedef float f32x2 __attribute__((ext_vector_type(2)));
typedef unsigned u32x4 __attribute__((ext_vector_type(4)));
typedef unsigned u32x2 __attribute__((ext_vector_type(2)));

constexpr int D = 1024, S = 16384, NS = 32, FF = 2816, MP = 16640, NPANEL = 65, MV = S + NS;
constexpr int QKVW = 4608;
constexpr int MPV = MP + 128;
constexpr float EPS = 1e-6f;

__device__ __forceinline__ unsigned f2bf(float f) { unsigned u = __builtin_bit_cast(unsigned, f); return (u + 0x7fffu + ((u >> 16) & 1u)) >> 16; }
__device__ __forceinline__ unsigned pk2(float lo, float hi) { return f2bf(lo) | (f2bf(hi) << 16); }
__device__ __forceinline__ float bf2f(unsigned short b) { return __builtin_bit_cast(float, ((unsigned)b) << 16); }
__device__ __forceinline__ float bflo(unsigned w) { return __builtin_bit_cast(float, w << 16); }
__device__ __forceinline__ float bfhi(unsigned w) { return __builtin_bit_cast(float, w & 0xffff0000u); }
#define LDS_WAIT() asm volatile("s_waitcnt lgkmcnt(0)" ::: "memory")
#define VM_WAIT() asm volatile("s_waitcnt vmcnt(0)" ::: "memory")
typedef __amdgpu_buffer_rsrc_t rsrc_t;
__device__ __forceinline__ rsrc_t mkrs(const void* p, size_t bytes) { return __builtin_amdgcn_make_buffer_rsrc((void*)p, 0, (int)bytes, 0x00020000); }
#define ST16(rs, off, v) __builtin_amdgcn_raw_buffer_store_b128((v), (rs), (unsigned)(off), 0, 16)
#define ST8(rs, off, v) __builtin_amdgcn_raw_buffer_store_b64((v), (rs), (unsigned)(off), 0, 16)
#define ST4(rs, off, v) __builtin_amdgcn_raw_buffer_store_b32((v), (rs), (unsigned)(off), 0, 16)
#define F4U(v) __builtin_bit_cast(u32x4, (v))
#define RLX_AGENT __ATOMIC_RELAXED, __HIP_MEMORY_SCOPE_AGENT

namespace pg8 {
constexpr int BM = 256, BK = 64, HALF = 128, HTB = HALF * BK * 2, STAGE_BYTES = 8 * HTB, NXCD = 8, WGM = 8;
__host__ __device__ __forceinline__ int lds_byte(int r, int c) { const int st = (r >> 4) * 2 + (c >> 5), rr = r & 15, cc = c & 31, ob = rr * 64 + cc * 2; return st * 1024 + (ob ^ (((ob >> 9) & 1) << 5)); }
__host__ __device__ __forceinline__ void stage_rc(int b, int& R, int& C) { const int st = b / 1024, sb = b % 1024, swz = sb ^ (((sb >> 9) & 1) << 5); R = (st >> 1) * 16 + swz / 64; C = (st & 1) * 32 + (swz % 64) / 2; }
__host__ __device__ __forceinline__ int perm32(int rho) { const int n = rho >> 4, i = rho & 15; return 8 * (i >> 2) + 4 * n + (i & 3); }
__host__ __device__ __forceinline__ int sigma_row(int d, int v) { const int q = 256 / d; return (v % q) * d + v / q; }

struct Unit { int pm, pn; };
struct Gemm { const bf16_t* A; const bf16_t* Bt; int lda, ldb, K, a_pn, bsig; };

#define FLOW_SPIN_CAP (1u << 21)
__device__ __forceinline__ void flow_poll1(const unsigned* c, unsigned need) {
    unsigned sp = 0;
    while ((unsigned)__builtin_amdgcn_readfirstlane(__hip_atomic_load(c, RLX_AGENT)) < need) { __builtin_amdgcn_s_sleep(2); if (++sp > FLOW_SPIN_CAP) break; }
}
__device__ __forceinline__ void flow_publish(unsigned* c) {
    asm volatile("s_waitcnt vmcnt(0)" ::: "memory");
    if ((threadIdx.x & 63) == 0) __hip_atomic_fetch_add(c, 1u, RLX_AGENT);
}
struct FlowOrder {
    int nM, nN, wgm, base, nx;
    unsigned* head;
    LAS unsigned* slot;
    unsigned claimed;
    const unsigned* wdep; unsigned wneed;
    const unsigned* dep; unsigned need, need64; int dep_pn, dep_shift;
    unsigned* pub; int pub_pn;
    __device__ __forceinline__ void init(int nM_, int nN_, int wgm_, int xcd, unsigned* qbase, int& qi, LAS unsigned* slot_) {
        nM = nM_; nN = nN_; wgm = wgm_;
        const int nwg = nM * nN, q = nwg / NXCD, r = nwg % NXCD;
        nx = q + (xcd < r ? 1 : 0); base = xcd < r ? xcd * (q + 1) : r * (q + 1) + (xcd - r) * q;
        head = qbase + (size_t)(qi * NXCD + xcd) * 64; ++qi; slot = slot_; claimed = 0u;
        wdep = nullptr; wneed = 0; dep = nullptr; need = 0; need64 = 0; dep_pn = 0; dep_shift = 0; pub = nullptr; pub_pn = 0;
    }
    __device__ __forceinline__ bool decode(unsigned l, Unit& u) const {
        if (l >= (unsigned)nx) return false;
        const int wgid = base + (int)l, nig = wgm * nN, gid = wgid / nig, fm = gid * wgm, gsz = (nM - fm) < wgm ? (nM - fm) : wgm;
        u.pm = fm + ((wgid % nig) % gsz); u.pn = (wgid % nig) / gsz; return true;
    }
    __device__ __forceinline__ bool next_blocking(Unit& u) {
        __syncthreads();
        if (threadIdx.x == 0) { const unsigned tk = __hip_atomic_fetch_add(head, 1u, RLX_AGENT);
            if (wdep) { unsigned sp = 0; while (__hip_atomic_load(wdep, RLX_AGENT) < wneed) { __builtin_amdgcn_s_sleep(2); if (++sp > FLOW_SPIN_CAP) break; } }
            *slot = tk; }
        __syncthreads();
        return decode(*slot, u);
    }
    __device__ __forceinline__ void claim_issue() { if (threadIdx.x == 0) claimed = __hip_atomic_fetch_add(head, 1u, RLX_AGENT); }
    __device__ __forceinline__ bool ready_next(Unit& u) {
        if (threadIdx.x < 64) {
            const unsigned l = (unsigned)__builtin_amdgcn_readfirstlane((int)claimed);
            Unit t; const bool ok = decode(l, t);
            if (ok && dep) { const int panel = dep_pn ? t.pn : t.pm;
                flow_poll1(dep + (size_t)(panel >> dep_shift) * 64, panel == 64 ? need64 : need);
                __builtin_amdgcn_fence(__ATOMIC_ACQUIRE, "agent");
                asm volatile("s_waitcnt vmcnt(0)" ::: "memory"); }
            if (threadIdx.x == 0) *slot = l;
        }
        asm volatile("s_waitcnt lgkmcnt(0)" ::: "memory"); __builtin_amdgcn_s_barrier(); asm volatile("" ::: "memory");
        return decode(*slot, u);
    }
    __device__ __forceinline__ void a_ready(const Unit& u) const {
        if (dep) {
            if (threadIdx.x < 64) { const int panel = dep_pn ? u.pn : u.pm;
                flow_poll1(dep + (size_t)(panel >> dep_shift) * 64, panel == 64 ? need64 : need);
                __builtin_amdgcn_fence(__ATOMIC_ACQUIRE, "agent");
                asm volatile("s_waitcnt vmcnt(0)" ::: "memory"); }
            asm volatile("" ::: "memory"); __builtin_amdgcn_s_barrier(); asm volatile("" ::: "memory");
        }
    }
    __device__ __forceinline__ void done(const Unit& u) const { if (pub) flow_publish(pub + (size_t)(pub_pn ? u.pn : u.pm) * 64); }
};

__device__ __forceinline__ unsigned cvt_pk_bf16(float lo, float hi) { unsigned r; asm volatile("v_cvt_pk_bf16_f32 %0, %1, %2" : "=v"(r) : "v"(lo), "v"(hi)); return r; }

template <class Epi, class Sched>
__device__ __forceinline__ void gemm_phase(LAS unsigned char* lds, const Gemm g, Sched& S, const Epi& E) {
    int tid = threadIdx.x; asm volatile("" : "+v"(tid));
    const int wid = __builtin_amdgcn_readfirstlane(tid >> 6), lane = tid & 63, wr = wid >> 2, wc = wid & 3, fr = lane & 15, fq = lane >> 4;
    const int K = g.K, nt = K / BK;
    unsigned voffA[2], voffB[2];
#pragma unroll
    for (int i = 0; i < 2; ++i) { int R, C; stage_rc(tid * 16 + i * 8192, R, C); const int Rb = sigma_row(g.bsig, (R & ~31) + perm32(R & 31));
        voffA[i] = (unsigned)(R * g.lda + C) * 2u; voffB[i] = (unsigned)(Rb * g.ldb + C) * 2u; }
    const size_t kstep = (size_t)(BK * 2);
    const size_t hstepA = (size_t)HALF * g.lda * 2, hstepB = (size_t)sigma_row(g.bsig, HALF) * g.ldb * 2;
    const size_t tstepA = 2 * hstepA, tstepB = (size_t)BM * g.ldb * 2;
    const unsigned ldsw = (unsigned)wid * 1024u;
    const int aoff = lds_byte(wr * 64 + fr, fq * 8), boff = lds_byte(wc * 32 + fr, fq * 8);
#define PG8_SA(b, h) (((b) * 2 + (h)) * HTB)
#define PG8_SB(b, h) ((4 + (b) * 2 + (h)) * HTB)
#define PG8_STAGE(bufoff, gbase, voff) do { _Pragma("unroll") for (int _i = 0; _i < 2; ++_i) \
        __builtin_amdgcn_global_load_lds((const unsigned*)((const char*)(gbase) + (voff)[_i]), (LAS unsigned*)(lds + (bufoff) + ldsw + _i * 8192), 16, 0, 0); } while (0)
#define PG8_LDA(dst, b, h) do { _Pragma("unroll") for (int m = 0; m < 4; ++m) _Pragma("unroll") for (int k = 0; k < 2; ++k) dst[m][k] = *(const LAS bf16x8*)(lds + PG8_SA(b, h) + aoff + m * 2048 + k * 1024); } while (0)
#define PG8_LDB(dst, b, h) do { _Pragma("unroll") for (int n = 0; n < 2; ++n) _Pragma("unroll") for (int k = 0; k < 2; ++k) dst[n][k] = *(const LAS bf16x8*)(lds + PG8_SB(b, h) + boff + n * 2048 + k * 1024); } while (0)
#define PG8_MMA(ai, bj, At, Bt) do { __builtin_amdgcn_s_setprio(1); _Pragma("unroll") for (int m = 0; m < 4; ++m) _Pragma("unroll") for (int n = 0; n < 2; ++n) _Pragma("unroll") for (int k = 0; k < 2; ++k) \
        acc[ai][bj][m][n] = __builtin_amdgcn_mfma_f32_16x16x32_bf16(Bt[n][k], At[m][k], acc[ai][bj][m][n], 0, 0, 0); __builtin_amdgcn_s_setprio(0); } while (0)
#define PG8_WAIT_V(n) asm volatile("s_waitcnt vmcnt(" #n ")" ::: "memory")
#define PG8_WAIT_L(n) asm volatile("s_waitcnt lgkmcnt(" #n ")" ::: "memory")
#define PG8_BAR __builtin_amdgcn_s_barrier()
#define PG8_SCHED __builtin_amdgcn_sched_barrier(0)
    Unit cur, nxt; int ui = 0;
    if (!S.next_blocking(cur)) return;
    f32x4 acc[2][2][4][2];
#pragma unroll
    for (int a = 0; a < 2; ++a)
#pragma unroll
        for (int b = 0; b < 2; ++b)
#pragma unroll
            for (int m = 0; m < 4; ++m)
#pragma unroll
                for (int n = 0; n < 2; ++n) acc[a][b][m][n] = (f32x4){0.f, 0.f, 0.f, 0.f};
    bf16x8 At[4][2], B0[2][2], B1[2][2];
    const char* cA = (const char*)g.A + (size_t)cur.pm * tstepA + (size_t)cur.pn * g.a_pn * 2; const char* cB = (const char*)g.Bt + (size_t)cur.pn * tstepB;
    PG8_STAGE(PG8_SB(0, 0), cB, voffB); PG8_STAGE(PG8_SB(0, 1), cB + hstepB, voffB);
    S.a_ready(cur);
    PG8_STAGE(PG8_SA(0, 0), cA, voffA); PG8_STAGE(PG8_SA(0, 1), cA + hstepA, voffA);
    if (wr == 1) PG8_BAR;
    PG8_WAIT_V(2); PG8_BAR;
    PG8_STAGE(PG8_SB(1, 0), cB + kstep, voffB); PG8_STAGE(PG8_SA(1, 0), cA + kstep, voffA); PG8_STAGE(PG8_SB(1, 1), cB + hstepB + kstep, voffB);
    PG8_WAIT_V(6); PG8_BAR;
    for (;;) {
        bool has_next = false; const char* nA = cA; const char* nB = cB;
        const int t_claim = nt >= 4 ? nt - 4 : 0;
#pragma nounroll
        for (int t = 0; t < nt; t += 2) {
            const bool last = (t == nt - 2);
            const char* a1 = cA + (size_t)(t + 1) * kstep;
            if (t == t_claim) S.claim_issue();
            if (last) { has_next = S.ready_next(nxt);
                if (has_next) { nA = (const char*)g.A + (size_t)nxt.pm * tstepA + (size_t)nxt.pn * g.a_pn * 2; nB = (const char*)g.Bt + (size_t)nxt.pn * tstepB; } }
            const char* a2 = last ? nA : cA + (size_t)(t + 2) * kstep; const char* b2 = last ? nB : cB + (size_t)(t + 2) * kstep;
            const char* a3 = a2 + kstep; const char* b3 = b2 + kstep;
            PG8_LDB(B0, 0, 0); PG8_LDB(B1, 0, 1); PG8_SCHED; PG8_LDA(At, 0, 0); PG8_STAGE(PG8_SA(1, 1), a1 + hstepA, voffA);
            PG8_WAIT_V(8); PG8_WAIT_L(0); PG8_BAR; PG8_MMA(0, 0, At, B0); PG8_MMA(0, 1, At, B1); PG8_BAR; PG8_SCHED;
            PG8_LDA(At, 0, 1); PG8_STAGE(PG8_SB(0, 0), b2, voffB); PG8_STAGE(PG8_SB(0, 1), b2 + hstepB, voffB); PG8_STAGE(PG8_SA(0, 0), a2, voffA);
            PG8_WAIT_V(8); PG8_WAIT_L(0); PG8_BAR; PG8_MMA(1, 0, At, B0); PG8_MMA(1, 1, At, B1); PG8_BAR; PG8_SCHED;
            PG8_LDB(B0, 1, 0); PG8_LDB(B1, 1, 1); PG8_SCHED; PG8_LDA(At, 1, 0); PG8_STAGE(PG8_SA(0, 1), a2 + hstepA, voffA);
            PG8_WAIT_V(8); PG8_WAIT_L(0); PG8_BAR; PG8_MMA(0, 0, At, B0); PG8_MMA(0, 1, At, B1); PG8_BAR; PG8_SCHED;
            PG8_LDA(At, 1, 1); PG8_STAGE(PG8_SB(1, 0), b3, voffB); PG8_STAGE(PG8_SB(1, 1), b3 + hstepB, voffB); PG8_STAGE(PG8_SA(1, 0), a3, voffA);
            PG8_WAIT_V(8); PG8_WAIT_L(0); PG8_BAR; PG8_MMA(1, 0, At, B0); PG8_MMA(1, 1, At, B1); PG8_BAR; PG8_SCHED;
        }
        if (wr == 0) PG8_BAR;
        E(acc, cur, wr, wc, fr, fq); S.done(cur);
        if (!has_next) break;
#pragma unroll
        for (int a = 0; a < 2; ++a)
#pragma unroll
            for (int b = 0; b < 2; ++b)
#pragma unroll
                for (int m = 0; m < 4; ++m)
#pragma unroll
                    for (int n = 0; n < 2; ++n) acc[a][b][m][n] = (f32x4){0.f, 0.f, 0.f, 0.f};
        cur = nxt; cA = nA; cB = nB; ++ui;
        if (wr == 1) PG8_BAR;
    }
    PG8_WAIT_V(0);
    PG8_BAR;
#undef PG8_SA
#undef PG8_SB
#undef PG8_STAGE
#undef PG8_LDA
#undef PG8_LDB
#undef PG8_MMA
#undef PG8_WAIT_V
#undef PG8_WAIT_L
#undef PG8_BAR
#undef PG8_SCHED
}
}
using pg8::Unit;
using pg8::cvt_pk_bf16;
using pg8::flow_poll1;
using pg8::flow_publish;

constexpr size_t MiB = 1u << 20;
constexpr size_t al(size_t x) { return (x + 4095) & ~(size_t)4095; }
constexpr size_t WS_CTL = 0;
constexpr size_t WS_WGU = 1 * MiB;
constexpr size_t SZ_WGU = (size_t)2 * FF * D * 2;
constexpr size_t WS_WD = WS_WGU + 4 * SZ_WGU;
constexpr size_t SZ_WD = (size_t)D * FF * 2;
constexpr size_t WS_WIN = WS_WD + 4 * SZ_WD;
constexpr size_t WS_WGRP = WS_WIN + (size_t)D * D * 2;
constexpr size_t WS_WPO = WS_WGRP + (size_t)D * 256 * 2;
constexpr size_t WS_WQKV = WS_WPO + (size_t)D * D * 2;
constexpr size_t WS_WAO = WS_WQKV + (size_t)QKVW * D * 2;
constexpr size_t WS_BIAS = WS_WAO + (size_t)D * 512 * 2;
constexpr size_t WS_PART = al(WS_BIAS + 3 * 8 * 132 * 4);
constexpr size_t WS_XB = al(WS_PART + (size_t)MP * 4 * 4);
constexpr size_t WS_XF = WS_XB + (size_t)MP * D * 2;
constexpr size_t WS_ACT = WS_XF + (size_t)MP * D * 4;
constexpr size_t WS_U = WS_ACT + (size_t)MP * FF * 2;
constexpr size_t WS_Z = WS_U + (size_t)MP * D * 2;
constexpr size_t WS_Z2 = WS_Z + (size_t)MP * D * 2;
constexpr size_t WS_QK = WS_Z2 + (size_t)MP * D * 2;
constexpr size_t WS_VT = WS_QK + (size_t)MP * 3072 * 2;
constexpr size_t WS_O = WS_VT + (size_t)3 * 512 * MPV * 2;
constexpr size_t WS_VNEW = WS_O + (size_t)MP * 512 * 2;
constexpr size_t WS_END = WS_VNEW + (size_t)NS * 1536 * 2;

constexpr size_t O_YP = 0, O_YS = (size_t)S * D, O_PSP = O_YS + (size_t)NS * D, O_PSS = O_PSP + 15 * D, O_KV0 = O_PSS + (size_t)NS * 15 * D;
__host__ __device__ constexpr size_t kv_group_base(int g) {
    size_t o = O_KV0;
    for (int i = 0; i < g; ++i) { const size_t W = (size_t)128 << (2 * i); o += 2 * W * 512 + 2 * (size_t)NS * W * 512; }
    return o;
}
constexpr size_t OUT_TOTAL = kv_group_base(3);

constexpr int CP_ROWS_TOTAL = 2 * NS * (127 + 511 + 2047);
constexpr int CP_CHUNKS = (CP_ROWS_TOTAL + 31) / 32;
__device__ __forceinline__ bool cp_addr(const float* const* in, float* out, int rho, int lane, const f32x4*& src, f32x4*& dst) {
    if (rho >= CP_ROWS_TOTAL) return false;
    int g = 0, kv = 0, rem = rho;
    if (rem >= 2 * NS * 127) { rem -= 2 * NS * 127; g = 1; if (rem >= 2 * NS * 511) { rem -= 2 * NS * 511; g = 2; } }
    const int W = 128 << (2 * g), per = NS * (W - 1);
    if (rem >= per) { rem -= per; kv = 1; }
    const int b = rem / (W - 1), t = rem % (W - 1);
    src = (const f32x4*)in[3 + 2 * g + kv] + ((size_t)b * W + t + 1) * 128 + lane;
    dst = (f32x4*)(out + kv_group_base(g) + 2 * (size_t)W * 512 + (size_t)kv * NS * W * 512) + ((size_t)b * W + t) * 128 + lane;
    return true;
}
struct CopyJob { const float* const* in; float* out; int next; };

__device__ __forceinline__ float rstd_of(const float* part, int row) {
    const f32x4 a = *(const f32x4*)(part + (size_t)row * 4);
    return __builtin_amdgcn_rsqf(((a.x + a.y) + (a.z + a.w)) * (1.0f / D) + EPS);
}
__device__ __forceinline__ float silu_mul(float g, float u) { return g * __builtin_amdgcn_rcpf(1.0f + __expf(-g)) * u; }
__device__ __forceinline__ u32x4 pack8(const f32x4 v0, const f32x4 v1) { u32x4 w; w.x = cvt_pk_bf16(v0[0], v0[1]); w.y = cvt_pk_bf16(v0[2], v0[3]); w.z = cvt_pk_bf16(v1[0], v1[1]); w.w = cvt_pk_bf16(v1[2], v1[3]); return w; }

template <class Derived> struct EpiBase {
    __device__ __forceinline__ void operator()(f32x4 (&acc)[2][2][4][2], const Unit& u, int wr, int wc, int fr, int fq) const {
        const Derived& self = *static_cast<const Derived*>(this);
        const int row0 = u.pm * 256 + wr * 64 + fr;
        float ctx[2][4];
#pragma unroll
        for (int ai = 0; ai < 2; ++ai)
#pragma unroll
            for (int m = 0; m < 4; ++m) ctx[ai][m] = self.pre_row(acc[ai][0][m], acc[ai][1][m], row0 + ai * 128 + m * 16, u.pn, wc, fq);
        __builtin_amdgcn_sched_barrier(0);
#pragma unroll
        for (int ai = 0; ai < 2; ++ai)
#pragma unroll
            for (int m = 0; m < 4; ++m) { const f32x4 v[2][2] = {{acc[ai][0][m][0], acc[ai][0][m][1]}, {acc[ai][1][m][0], acc[ai][1][m][1]}};
                self.row_op(v, row0 + ai * 128 + m * 16, u.pn, wc, fq, ai * 128 + wr * 64 + m * 16 + fr, ctx[ai][m]); }
        self.finish(u.pm, u.pn, 256);
    }
    __device__ __forceinline__ void small(f32x4 (&accS)[2][2][2], int pn, int wc, int fr, int fq, bool active) const {
        const Derived& self = *static_cast<const Derived*>(this);
        if (active) {
            float ctx[2];
#pragma unroll
            for (int m = 0; m < 2; ++m) ctx[m] = self.pre_row(accS[0][m], accS[1][m], S + m * 16 + fr, pn, wc, fq);
            __builtin_amdgcn_sched_barrier(0);
#pragma unroll
            for (int m = 0; m < 2; ++m) { const f32x4 v[2][2] = {{accS[0][m][0], accS[0][m][1]}, {accS[1][m][0], accS[1][m][1]}};
                self.row_op(v, S + m * 16 + fr, pn, wc, fq, m * 16 + fr, ctx[m]); }
        }
        self.finish(64, pn, 32);
    }
    __device__ __forceinline__ void finish(int, int, int) const {}
};

struct EpiGU : EpiBase<EpiGU> {
    rsrc_t act; const float* part; CopyJob* cj;
    __device__ __forceinline__ float pre_row(f32x4 (&)[2], f32x4 (&)[2], int row, int, int, int) const { return rstd_of(part, row); }
    __device__ __forceinline__ u32x4 silu_pack(const f32x4 (&v)[2][2], float rs) const {
        const float c = -1.4426950408889634f * rs, r2 = rs * rs;
        f32x4 o0, o1;
#pragma unroll
        for (int e = 0; e < 4; ++e) { o0[e] = (v[0][0][e] * v[1][0][e]) * (r2 * __builtin_amdgcn_rcpf(1.0f + __builtin_amdgcn_exp2f(v[0][0][e] * c))); o1[e] = (v[0][1][e] * v[1][1][e]) * (r2 * __builtin_amdgcn_rcpf(1.0f + __builtin_amdgcn_exp2f(v[0][1][e] * c))); }
        return pack8(o0, o1);
    }
    __device__ __forceinline__ void row_op(const f32x4 (&v)[2][2], int row, int pn, int wc, int fq, int, float rs) const {
        ST16(act, ((unsigned)row * FF + pn * 128 + wc * 32 + 8 * fq) * 2u, silu_pack(v, rs));
    }
    __device__ __forceinline__ void operator()(f32x4 (&acc)[2][2][4][2], const Unit& u, int wr, int wc, int fr, int fq) const {
        const int row0 = u.pm * 256 + wr * 64 + fr, lane = fr + 16 * fq, wave = wr * 4 + wc;
        float rs[2][4];
#pragma unroll
        for (int ai = 0; ai < 2; ++ai)
#pragma unroll
            for (int m = 0; m < 4; ++m) rs[ai][m] = rstd_of(part, row0 + ai * 128 + m * 16);
        f32x4 cv[4][2]; f32x4* cd[4]; const int chunk = cj->next;
        if (chunk < CP_CHUNKS) {
#pragma unroll
            for (int q = 0; q < 4; ++q) { const f32x4* src; cd[q] = nullptr; if (cp_addr(cj->in, cj->out, chunk * 32 + wave * 4 + q, lane, src, cd[q])) { cv[q][0] = __builtin_nontemporal_load(src); cv[q][1] = __builtin_nontemporal_load(src + 64); } }
        }
        __builtin_amdgcn_sched_barrier(0);
        u32x4 w[2][4];
#pragma unroll
        for (int ai = 0; ai < 2; ++ai)
#pragma unroll
            for (int m = 0; m < 4; ++m) { const f32x4 v[2][2] = {{acc[ai][0][m][0], acc[ai][0][m][1]}, {acc[ai][1][m][0], acc[ai][1][m][1]}}; w[ai][m] = silu_pack(v, rs[ai][m]); }
        __builtin_amdgcn_sched_barrier(0);
        if (chunk < CP_CHUNKS) {
#pragma unroll
            for (int q = 0; q < 4; ++q) if (cd[q]) { __builtin_nontemporal_store(cv[q][0], cd[q]); __builtin_nontemporal_store(cv[q][1], cd[q] + 64); }
            cj->next = chunk + 256;
        }
#pragma unroll
        for (int ai = 0; ai < 2; ++ai)
#pragma unroll
            for (int m = 0; m < 4; ++m) ST16(act, ((unsigned)(row0 + ai * 128 + m * 16) * FF + u.pn * 128 + wc * 32 + 8 * fq) * 2u, w[ai][m]);
    }
};
template <bool LAST> struct EpiRes : EpiBase<EpiRes<LAST>> {
    const bf16_t* xr; rsrc_t xo; rsrc_t xb; rsrc_t part; LAS float* red;
    __device__ __forceinline__ void operator()(f32x4 (&acc)[2][2][4][2], const Unit& u, int wr, int wc, int fr, int fq) const {
        const int row0 = u.pm * 256 + wr * 64 + fr, coff = u.pn * 256 + wc * 32 + 8 * fq;
        u32x4 xn[2][4][2];
#pragma unroll
        for (int ai = 0; ai < 2; ++ai)
#pragma unroll
            for (int m = 0; m < 4; ++m) { const bf16_t* xi = xr + (size_t)(row0 + ai * 128 + m * 16) * D + coff; xn[ai][m][0] = *(const u32x4*)xi; xn[ai][m][1] = *(const u32x4*)(xi + 128); }
        __builtin_amdgcn_sched_barrier(0);
#pragma unroll
        for (int ai = 0; ai < 2; ++ai)
#pragma unroll
            for (int m = 0; m < 4; ++m) {
                f32x4 v[2][2];
#pragma unroll
                for (int bj = 0; bj < 2; ++bj) { const u32x4 t = xn[ai][m][bj];
                    v[bj][0] = acc[ai][bj][m][0] + (f32x4){bflo(t.x), bfhi(t.x), bflo(t.y), bfhi(t.y)}; v[bj][1] = acc[ai][bj][m][1] + (f32x4){bflo(t.z), bfhi(t.z), bflo(t.w), bfhi(t.w)}; }
                row_op(v, row0 + ai * 128 + m * 16, u.pn, wc, fq, ai * 128 + wr * 64 + m * 16 + fr, 0.f);
            }
        finish(u.pm, u.pn, 256);
    }
    __device__ __forceinline__ float pre_row(f32x4 (&a0)[2], f32x4 (&a1)[2], int row, int pn, int wc, int fq) const {
        const bf16_t* xi = xr + (size_t)row * D + pn * 256 + wc * 32 + 8 * fq;
        const u32x4 t0 = *(const u32x4*)xi, t1 = *(const u32x4*)(xi + 128);
        a0[0] += (f32x4){bflo(t0.x), bfhi(t0.x), bflo(t0.y), bfhi(t0.y)}; a0[1] += (f32x4){bflo(t0.z), bfhi(t0.z), bflo(t0.w), bfhi(t0.w)};
        a1[0] += (f32x4){bflo(t1.x), bfhi(t1.x), bflo(t1.y), bfhi(t1.y)}; a1[1] += (f32x4){bflo(t1.z), bfhi(t1.z), bflo(t1.w), bfhi(t1.w)};
        return 0.f;
    }
    __device__ __forceinline__ void row_op(const f32x4 (&v)[2][2], int row, int pn, int wc, int fq, int lrow, float) const {
        const int col0 = pn * 256 + wc * 32 + 8 * fq;
        float ss = 0.f;
#pragma unroll
        for (int bj = 0; bj < 2; ++bj) {
            const f32x4 v0 = v[bj][0], v1 = v[bj][1];
            ss += (v0[0] * v0[0] + v0[1] * v0[1]) + (v0[2] * v0[2] + v0[3] * v0[3]) + (v1[0] * v1[0] + v1[1] * v1[1]) + (v1[2] * v1[2] + v1[3] * v1[3]);
            if (LAST) { const unsigned o = ((unsigned)row * D + col0 + bj * 128) * 4u; ST16(xo, o, F4U(v0)); ST16(xo, o + 16u, F4U(v1)); }
            else ST16(xb, ((unsigned)row * D + col0 + bj * 128) * 2u, pack8(v0, v1));
        }
        ss += __shfl_xor(ss, 16); ss += __shfl_xor(ss, 32);
        if (fq == 0) red[lrow * 4 + wc] = ss;
    }
    __device__ __forceinline__ void finish(int pm, int pn, int nrows) const {
        asm volatile("s_waitcnt lgkmcnt(0)" ::: "memory"); __builtin_amdgcn_s_barrier(); asm volatile("" ::: "memory");
        if ((int)threadIdx.x < nrows) { const f32x4 v = *(const LAS f32x4*)(red + threadIdx.x * 4); ST4(part, ((unsigned)(pm * 256 + threadIdx.x) * 4 + pn) * 4u, __builtin_bit_cast(unsigned, (v.x + v.y) + (v.z + v.w))); }
    }
};
struct EpiU : EpiBase<EpiU> {
    rsrc_t ub; const float* part; float* psp; float* pss;
    __device__ __forceinline__ float pre_row(f32x4 (&)[2], f32x4 (&)[2], int row, int, int, int) const { return rstd_of(part, row); }
    __device__ __forceinline__ void row_op(const f32x4 (&v)[2][2], int row, int pn, int wc, int fq, int, float rs) const {
        const int col0 = pn * 256 + wc * 32 + 8 * fq;
        float* po = nullptr;
        if (row >= S - 15 && row < S) po = psp + (size_t)(row - (S - 15)) * D; else if (row >= S && row < MV) po = pss + ((size_t)(row - S) * 15 + 14) * D;
#pragma unroll
        for (int bj = 0; bj < 2; ++bj) {
            const f32x4 v0 = v[bj][0] * rs, v1 = v[bj][1] * rs;
            ST16(ub, ((unsigned)row * D + col0 + bj * 128) * 2u, pack8(v0, v1));
            if (po) { *(f32x4*)(po + col0 + bj * 128) = v0; *(f32x4*)(po + col0 + bj * 128 + 4) = v1; }
        }
    }
};
struct EpiPlain : EpiBase<EpiPlain> {
    rsrc_t o;
    __device__ __forceinline__ float pre_row(f32x4 (&)[2], f32x4 (&)[2], int, int, int, int) const { return 0.f; }
    __device__ __forceinline__ void row_op(const f32x4 (&v)[2][2], int row, int pn, int wc, int fq, int, float) const {
        const int col0 = pn * 256 + wc * 32 + 8 * fq;
#pragma unroll
        for (int bj = 0; bj < 2; ++bj) ST16(o, ((unsigned)row * D + col0 + bj * 128) * 2u, pack8(v[bj][0], v[bj][1]));
    }
};
struct EpiQK : EpiBase<EpiQK> {
    rsrc_t qk; const float* part; float* out; rsrc_t vnew;
    __device__ __forceinline__ float pre_row(f32x4 (&)[2], f32x4 (&)[2], int row, int, int, int) const { return rstd_of(part, row); }
    __device__ __forceinline__ void row_op(const f32x4 (&v)[2][2], int row, int pn, int wc, int fq, int, float rs) const {
        const int colt = pn * 256, cw = wc * 32 + 8 * fq;
        const bool isv = colt >= 3072;
        const int g = isv ? (colt - 3072) / 512 : colt / 1024, s = isv ? 2 : (colt % 1024) / 512;
        const int W = 128 << (2 * g);
        const size_t gb = kv_group_base(g);
        const size_t o_p = gb, o_s = gb + 2 * (size_t)W * 512 + (isv ? (size_t)NS * W * 512 : 0);
        float* po = nullptr;
        if (s != 0) { if (row >= S - W && row < S) po = out + o_p + (size_t)(row - (S - W)) * 512; else if (row >= S && row < MV) po = out + o_s + ((size_t)(row - S) * W + (W - 1)) * 512; }
#pragma unroll
        for (int bj = 0; bj < 2; ++bj) {
            const f32x4 v0 = v[bj][0] * rs, v1 = v[bj][1] * rs;
            if (!isv) ST16(qk, ((unsigned)row * 3072 + colt + cw + bj * 128) * 2u, pack8(v0, v1));
            else ST16(vnew, ((unsigned)(row - S) * 1536 + (colt - 3072) + cw + bj * 128) * 2u, pack8(v0, v1));
            if (po) { const int he = (colt + cw + bj * 128) % 512; *(f32x4*)(po + he) = v0; *(f32x4*)(po + he + 4) = v1; }
        }
    }
};
struct EpiVT {
    rsrc_t vTg; const float* part; float* out; int g, d;
    __device__ __forceinline__ void operator()(f32x4 (&acc)[2][2][4][2], const Unit& u, int wr, int wc, int fr, int fq) const {
        const int dim0 = u.pm * 256 + wr * 64 + fr;
        const int W = 128 << (2 * g), q = 256 / d;
        const size_t o_p = kv_group_base(g) + (size_t)W * 512;
        const bool tail = (u.pn * 256 + 255 >= S - W);
        float rsa[2][8];
#pragma unroll
        for (int bj = 0; bj < 2; ++bj) { const int v0 = 128 * bj + 32 * wc + 8 * fq, r = v0 / q, ii0 = v0 % q, tok0 = u.pn * 256 + ii0 * d + r;
#pragma unroll
            for (int e = 0; e < 8; ++e) rsa[bj][e] = rstd_of(part, tok0 + e * d);
            __builtin_amdgcn_sched_barrier(0); }
#pragma unroll
        for (int bj = 0; bj < 2; ++bj) {
            const int v0 = 128 * bj + 32 * wc + 8 * fq, r = v0 / q, ii0 = v0 % q;
            const int tok0 = u.pn * 256 + ii0 * d + r;
            float rs[8];
#pragma unroll
            for (int e = 0; e < 8; ++e) rs[e] = rsa[bj][e];
            const size_t sidx = (size_t)r * (S / d) + (size_t)(u.pn * 256) / d + ii0;
            const unsigned vp = (unsigned)(((size_t)dim0 * MPV + 128 + sidx) * 2);
#pragma unroll
            for (int ai = 0; ai < 2; ++ai)
#pragma unroll
                for (int m = 0; m < 4; ++m) {
                    const f32x4 a0 = acc[ai][bj][m][0], a1 = acc[ai][bj][m][1];
                    u32x4 w; w.x = cvt_pk_bf16(a0[0] * rs[0], a0[1] * rs[1]); w.y = cvt_pk_bf16(a0[2] * rs[2], a0[3] * rs[3]); w.z = cvt_pk_bf16(a1[0] * rs[4], a1[1] * rs[5]); w.w = cvt_pk_bf16(a1[2] * rs[6], a1[3] * rs[7]);
                    ST16(vTg, vp + (unsigned)(ai * 128 + m * 16) * (unsigned)(MPV * 2), w);
                    asm volatile("" ::: "memory");
                }
            if (tail) {
#pragma unroll
                for (int e = 0; e < 8; ++e) { const int t = tok0 + e * d;
                    if (t >= S - W) { float* po = out + o_p + (size_t)(t - (S - W)) * 512 + dim0;
#pragma unroll
                        for (int ai = 0; ai < 2; ++ai)
#pragma unroll
                            for (int m = 0; m < 4; ++m) po[ai * 128 + m * 16] = acc[ai][bj][m][e >> 2][e & 3] * rs[e]; }
                    asm volatile("" ::: "memory"); }
            }
        }
    }
};

template <class Epi>
__device__ __forceinline__ void skinny_unit(LAS unsigned char* lds, const pg8::Gemm g, int pn, const Epi& E) {
    int tid = threadIdx.x; asm volatile("" : "+v"(tid));
    const int wid = __builtin_amdgcn_readfirstlane(tid >> 6), lane = tid & 63, kh = wid >> 2, wc = wid & 3, fr = lane & 15, fq = lane >> 4;
    const int Kh = g.K / 2;
    const bf16_t* ap = g.A + (size_t)(S + fr) * g.lda + (size_t)pn * g.a_pn + kh * Kh + 8 * fq;
    const bf16_t* bp = g.Bt + (size_t)(pn * 256 + wc * 32 + 8 * (fr >> 2) + (fr & 3)) * g.ldb + kh * Kh + 8 * fq;
    f32x4 acc[2][2][2];
#pragma unroll
    for (int a = 0; a < 2; ++a)
#pragma unroll
        for (int b = 0; b < 2; ++b)
#pragma unroll
            for (int c = 0; c < 2; ++c) acc[a][b][c] = (f32x4){0.f, 0.f, 0.f, 0.f};
#pragma unroll 4
    for (int k0 = 0; k0 < Kh; k0 += 32) {
        bf16x8 af[2], bf[2][2];
#pragma unroll
        for (int m = 0; m < 2; ++m) af[m] = *(const bf16x8*)(ap + (size_t)(16 * m) * g.lda + k0);
#pragma unroll
        for (int bj = 0; bj < 2; ++bj)
#pragma unroll
            for (int n = 0; n < 2; ++n) bf[bj][n] = *(const bf16x8*)(bp + (size_t)(128 * bj + 4 * n) * g.ldb + k0);
#pragma unroll
        for (int bj = 0; bj < 2; ++bj)
#pragma unroll
            for (int m = 0; m < 2; ++m)
#pragma unroll
                for (int n = 0; n < 2; ++n) acc[bj][m][n] = __builtin_amdgcn_mfma_f32_16x16x32_bf16(bf[bj][n], af[m], acc[bj][m][n], 0, 0, 0);
    }
    LAS f32x4* xs = (LAS f32x4*)lds + (wc * 64 + lane) * 8;
    __syncthreads();
    if (kh == 1) {
#pragma unroll
        for (int bj = 0; bj < 2; ++bj)
#pragma unroll
            for (int m = 0; m < 2; ++m)
#pragma unroll
                for (int n = 0; n < 2; ++n) xs[(bj * 2 + m) * 2 + n] = acc[bj][m][n];
    }
    __syncthreads();
    if (kh == 0) {
#pragma unroll
        for (int bj = 0; bj < 2; ++bj)
#pragma unroll
            for (int m = 0; m < 2; ++m)
#pragma unroll
                for (int n = 0; n < 2; ++n) acc[bj][m][n] += xs[(bj * 2 + m) * 2 + n];
    }
    E.small(acc, pn, wc, fr, fq, kh == 0);
}

typedef float f32x16 __attribute__((ext_vector_type(16)));
typedef __bf16 bf16v2 __attribute__((ext_vector_type(2)));
#define MFMA32(a, b, c) __builtin_amdgcn_mfma_f32_32x32x16_bf16((a), (b), (c), 0, 0, 0)
__device__ __forceinline__ unsigned cvt2(float a, float b) { const f32x2 v = {a, b}; return __builtin_bit_cast(unsigned, __builtin_convertvector(v, bf16v2)); }

template <int GI>
__device__ __forceinline__ void attn_job(const bf16_t* qk, const bf16_t* vTg, const LAS float* biasL, bf16_t* act, rsrc_t ob, int h, int r, int i0, int lane,
                                         const LAS unsigned char* lk = nullptr, const LAS unsigned char* lv = nullptr, int kl0 = 0) {
    constexpr int d = 1 << (2 * GI), SD = S / d;
    int r16 = lane & 15, g = lane >> 4;
    asm volatile("" : "+v"(r16), "+v"(g));
    bf16x8 qf[2][2];
#pragma unroll
    for (int qt = 0; qt < 2; ++qt) { const bf16_t* qp = qk + (size_t)((i0 + 16 * qt + r16) * d + r) * 3072 + GI * 1024 + h * 64 + 8 * g;
#pragma unroll
        for (int ks = 0; ks < 2; ++ks) qf[qt][ks] = *(const bf16x8*)(qp + 32 * ks); }
    f32x4 st[5][2][2];
    if constexpr (GI == 0) {
#pragma unroll
        for (int kb = 0; kb < 5; ++kb)
#pragma unroll
            for (int T = 0; T < 2; ++T) { const int kl = kl0 + 32 * kb + 8 * (r16 >> 2) + 4 * T + (r16 & 3); const LAS unsigned char* kp = lk + kl * 128; const int sw = (kl >> 1) & 7;
                const bf16x8 k0 = *(const LAS bf16x8*)(kp + ((g ^ sw) << 4)), k1 = *(const LAS bf16x8*)(kp + (((g + 4) ^ sw) << 4));
#pragma unroll
                for (int qt = 0; qt < 2; ++qt) { f32x4 a = {0.f, 0.f, 0.f, 0.f};
                    a = __builtin_amdgcn_mfma_f32_16x16x32_bf16(k0, qf[qt][0], a, 0, 0, 0); a = __builtin_amdgcn_mfma_f32_16x16x32_bf16(k1, qf[qt][1], a, 0, 0, 0); st[kb][T][qt] = a; } }
    } else {
    bf16x8 kf[5][2][2];
#pragma unroll
    for (int kb = 0; kb < 5; ++kb)
#pragma unroll
        for (int T = 0; T < 2; ++T) {
            int ik = i0 - 128 + 32 * kb + 8 * (r16 >> 2) + 4 * T + (r16 & 3); ik = ik < 0 ? 0 : ik;
            const bf16_t* kp = qk + (size_t)(ik * d + r) * 3072 + GI * 1024 + 512 + h * 64 + 8 * g;
            kf[kb][T][0] = *(const bf16x8*)kp; kf[kb][T][1] = *(const bf16x8*)(kp + 32);
        }
    __builtin_amdgcn_sched_barrier(0);
#pragma unroll
    for (int kb = 0; kb < 5; ++kb)
#pragma unroll
        for (int T = 0; T < 2; ++T)
#pragma unroll
            for (int qt = 0; qt < 2; ++qt) { f32x4 a = {0.f, 0.f, 0.f, 0.f};
                a = __builtin_amdgcn_mfma_f32_16x16x32_bf16(kf[kb][T][0], qf[qt][0], a, 0, 0, 0); a = __builtin_amdgcn_mfma_f32_16x16x32_bf16(kf[kb][T][1], qf[qt][1], a, 0, 0, 0); st[kb][T][qt] = a; }
    }
    const bf16_t* vbase = vTg + (size_t)(h * 64 + r16) * MPV + 128 + (r * SD + i0 - 128 + 8 * g);
    bf16x8 vf[5][4];
#pragma unroll
    for (int kb = 0; kb < 5; ++kb)
#pragma unroll
        for (int dt = 0; dt < 4; ++dt) { if constexpr (GI != 0) vf[kb][dt] = *(const bf16x8*)(vbase + (size_t)dt * 16 * MPV + 32 * kb); }
    __builtin_amdgcn_sched_barrier(0);
    float mx[2] = {-1e30f, -1e30f};
    const LAS float* bl = biasL + (r16 - 8 * g);
#pragma unroll
    for (int kb = 0; kb < 5; ++kb)
#pragma unroll
        for (int T = 0; T < 2; ++T)
#pragma unroll
            for (int qt = 0; qt < 2; ++qt)
#pragma unroll
                for (int i = 0; i < 4; ++i) {
                    const int jc0 = 128 - 32 * kb + 16 * qt - 4 * T - i;
                    if (kb >= 1 && kb <= 3) st[kb][T][qt][i] += bl[jc0];
                    else { const int jo = jc0 + r16 - 8 * g; const int jc = jo < 0 ? 0 : (jo > 128 ? 128 : jo); st[kb][T][qt][i] += biasL[jc]; }
                }
    __builtin_amdgcn_sched_barrier(0);
#pragma unroll
    for (int T = 0; T < 2; ++T)
#pragma unroll
        for (int qt = 0; qt < 2; ++qt)
#pragma unroll
            for (int i = 0; i < 4; ++i) {
                const int j0 = 128 + 16 * qt + r16 - 8 * g - 4 * T - i, j4 = j0 - 128;
                st[0][T][qt][i] = (j0 <= 128) ? st[0][T][qt][i] : -1e30f;
                st[4][T][qt][i] = (j4 >= 0) ? st[4][T][qt][i] : -1e30f;
            }
    if (i0 < 128) {
#pragma unroll
        for (int kb = 0; kb < 4; ++kb)
#pragma unroll
            for (int T = 0; T < 2; ++T)
#pragma unroll
                for (int qt = 0; qt < 2; ++qt)
#pragma unroll
                    for (int i = 0; i < 4; ++i) { const int ik = i0 - 128 + 32 * kb + 8 * g + 4 * T + i; st[kb][T][qt][i] = (ik >= 0) ? st[kb][T][qt][i] : -1e30f; }
    }
#pragma unroll
    for (int kb = 0; kb < 5; ++kb)
#pragma unroll
        for (int T = 0; T < 2; ++T)
#pragma unroll
            for (int qt = 0; qt < 2; ++qt)
#pragma unroll
                for (int i = 0; i < 4; ++i) mx[qt] = fmaxf(mx[qt], st[kb][T][qt][i]);
    float sum[2];
#pragma unroll
    for (int qt = 0; qt < 2; ++qt) { mx[qt] = fmaxf(mx[qt], __shfl_xor(mx[qt], 16)); mx[qt] = fmaxf(mx[qt], __shfl_xor(mx[qt], 32)); sum[qt] = 0.f; }
#pragma unroll
    for (int kb = 0; kb < 5; ++kb)
#pragma unroll
        for (int T = 0; T < 2; ++T)
#pragma unroll
            for (int qt = 0; qt < 2; ++qt)
#pragma unroll
                for (int i = 0; i < 4; ++i) { const float p = __builtin_amdgcn_exp2f(st[kb][T][qt][i] - mx[qt]); st[kb][T][qt][i] = p; sum[qt] += p; }
#pragma unroll
    for (int qt = 0; qt < 2; ++qt) { sum[qt] += __shfl_xor(sum[qt], 16); sum[qt] += __shfl_xor(sum[qt], 32); }
    f32x4 oa[4][2];
#pragma unroll
    for (int dt = 0; dt < 4; ++dt)
#pragma unroll
        for (int qt = 0; qt < 2; ++qt) oa[dt][qt] = (f32x4){0.f, 0.f, 0.f, 0.f};
#pragma unroll
    for (int kb = 0; kb < 5; ++kb) {
        bf16x8 pf[2];
#pragma unroll
        for (int qt = 0; qt < 2; ++qt) { u32x4 pw; pw.x = cvt2(st[kb][0][qt][0], st[kb][0][qt][1]); pw.y = cvt2(st[kb][0][qt][2], st[kb][0][qt][3]); pw.z = cvt2(st[kb][1][qt][0], st[kb][1][qt][1]); pw.w = cvt2(st[kb][1][qt][2], st[kb][1][qt][3]);
            pf[qt] = __builtin_bit_cast(bf16x8, pw); }
#pragma unroll
        for (int dt = 0; dt < 4; ++dt)
#pragma unroll
            for (int qt = 0; qt < 2; ++qt) {
                if constexpr (GI == 0) { if (qt == 0) vf[kb][dt] = *(const LAS bf16x8*)(lv + (16 * dt + r16) * 768 + ((((kl0 >> 3) + 4 * kb + g) ^ r16) << 4)); }
                oa[dt][qt] = __builtin_amdgcn_mfma_f32_16x16x32_bf16(vf[kb][dt], pf[qt], oa[dt][qt], 0, 0, 0); }
    }
#pragma unroll
    for (int qt = 0; qt < 2; ++qt) {
        const int tq = (i0 + 16 * qt + r16) * d + r;
        const float inv = 1.0f / sum[qt], lse = mx[qt] + __log2f(sum[qt]);
        float* scr = (float*)(act + (size_t)tq * FF);
        bf16_t* scb = act + (size_t)tq * FF;
        if (GI > 0) {
#pragma unroll
            for (int dt = 0; dt < 4; ++dt) { const f32x4 v = oa[dt][qt] * inv; u32x2 w; w.x = cvt2(v[0], v[1]); w.y = cvt2(v[2], v[3]); *(u32x2*)(scb + (GI - 1) * 512 + h * 64 + 16 * dt + 4 * g) = w; }
            if (g == 0) scr[1024 + (GI - 1) * 8 + h] = lse;
        } else {
            const float l1 = scr[1024 + h], l2 = scr[1024 + 8 + h];
            f32x4 o1[4], o2[4];
#pragma unroll
            for (int dt = 0; dt < 4; ++dt) { const int dim0 = h * 64 + 16 * dt + 4 * g; const u32x2 p1 = *(const u32x2*)(scb + dim0), p2 = *(const u32x2*)(scb + 512 + dim0);
                o1[dt] = (f32x4){bflo(p1.x), bfhi(p1.x), bflo(p1.y), bfhi(p1.y)}; o2[dt] = (f32x4){bflo(p2.x), bfhi(p2.x), bflo(p2.y), bfhi(p2.y)}; }
            const float mm = fmaxf(fmaxf(lse, l1), l2);
            const float w0 = __builtin_amdgcn_exp2f(lse - mm), w1 = __builtin_amdgcn_exp2f(l1 - mm), w2 = __builtin_amdgcn_exp2f(l2 - mm), iw = 1.0f / (w0 + w1 + w2);
            const float a0 = w0 * inv * iw, a1 = w1 * iw, a2 = w2 * iw;
#pragma unroll
            for (int dt = 0; dt < 4; ++dt) { const int dim0 = h * 64 + 16 * dt + 4 * g; const f32x4 v = oa[dt][qt] * a0 + o1[dt] * a1 + o2[dt] * a2;
                u32x2 w; w.x = cvt2(v[0], v[1]); w.y = cvt2(v[2], v[3]);
                ST8(ob, ((unsigned)tq * 512 + dim0) * 2u, w); }
        }
    }
}
__device__ __forceinline__ float wave_sum(float v) {
#pragma unroll
    for (int o = 1; o < 64; o <<= 1) v += __shfl_xor(v, o);
    return v;
}
__device__ __forceinline__ float wave_max(float v) {
#pragma unroll
    for (int o = 1; o < 64; o <<= 1) v = fmaxf(v, __shfl_xor(v, o));
    return v;
}
__device__ __forceinline__ void sample_attn_group(int g, int b, int h, const bf16_t* qk, const bf16_t* vnew, const float* ck, const float* cv, const float* biasT, LAS float* smp, int lane) {
    const int d = 1 << (2 * g), W = 128 << (2 * g), row = S + b, kq = lane >> 3, dc = lane & 7;
    float q[64];
    { const u32x4* qp = (const u32x4*)(qk + (size_t)row * 3072 + g * 1024 + h * 64);
#pragma unroll
      for (int c = 0; c < 8; ++c) { const u32x4 t = qp[c]; q[8 * c] = bflo(t.x); q[8 * c + 1] = bfhi(t.x); q[8 * c + 2] = bflo(t.y); q[8 * c + 3] = bfhi(t.y); q[8 * c + 4] = bflo(t.z); q[8 * c + 5] = bfhi(t.z); q[8 * c + 6] = bflo(t.w); q[8 * c + 7] = bfhi(t.w); } }
    float sc[3];
#pragma unroll
    for (int rnd = 0; rnd < 3; ++rnd) {
        const int j = lane + 64 * rnd; float s = -1e30f;
        if (j <= 128) { float a = 0.f;
            if (j == 0) { const u32x4* kp = (const u32x4*)(qk + (size_t)row * 3072 + g * 1024 + 512 + h * 64);
#pragma unroll
                for (int c = 0; c < 8; ++c) { const u32x4 t = kp[c]; a += q[8 * c] * bflo(t.x) + q[8 * c + 1] * bfhi(t.x) + q[8 * c + 2] * bflo(t.y) + q[8 * c + 3] * bfhi(t.y) + q[8 * c + 4] * bflo(t.z) + q[8 * c + 5] * bfhi(t.z) + q[8 * c + 6] * bflo(t.w) + q[8 * c + 7] * bfhi(t.w); } }
            else { const f32x4* kp = (const f32x4*)(ck + (((size_t)b * W + (W - j * d)) * 8 + h) * 64);
#pragma unroll
                for (int c = 0; c < 16; ++c) { const f32x4 t = __builtin_nontemporal_load(kp + c); a += q[4 * c] * t.x + q[4 * c + 1] * t.y + q[4 * c + 2] * t.z + q[4 * c + 3] * t.w; } }
            s = a + biasT[(g * 8 + h) * 132 + j]; }
        sc[rnd] = s;
    }
    const float mx = wave_max(fmaxf(fmaxf(sc[0], sc[1]), sc[2]));
    float p[3]; float sum = 0.f;
#pragma unroll
    for (int rnd = 0; rnd < 3; ++rnd) { p[rnd] = (sc[rnd] > -1e29f) ? __builtin_amdgcn_exp2f(sc[rnd] - mx) : 0.f; sum += p[rnd]; }
    sum = wave_sum(sum);
    const float inv = 1.0f / sum;
    float o[8] = {0.f, 0.f, 0.f, 0.f, 0.f, 0.f, 0.f, 0.f};
#pragma unroll
    for (int i = 0; i < 17; ++i) {
        const int j = kq + 8 * i, src = j & 63, rnd = j >> 6;
        const float p0 = __shfl(p[0], src), p1 = __shfl(p[1], src), p2 = __shfl(p[2], src);
        const float pj = (rnd == 0) ? p0 : ((rnd == 1) ? p1 : p2);
        if (j <= 128) {
            if (j == 0) { const u32x4 t = *(const u32x4*)(vnew + (size_t)b * 1536 + g * 512 + h * 64 + 8 * dc);
                o[0] += pj * bflo(t.x); o[1] += pj * bfhi(t.x); o[2] += pj * bflo(t.y); o[3] += pj * bfhi(t.y); o[4] += pj * bflo(t.z); o[5] += pj * bfhi(t.z); o[6] += pj * bflo(t.w); o[7] += pj * bfhi(t.w); }
            else { const f32x4* vp = (const f32x4*)(cv + (((size_t)b * W + (W - j * d)) * 8 + h) * 64 + 8 * dc); const f32x4 t0 = __builtin_nontemporal_load(vp), t1 = __builtin_nontemporal_load(vp + 1);
                o[0] += pj * t0.x; o[1] += pj * t0.y; o[2] += pj * t0.z; o[3] += pj * t0.w; o[4] += pj * t1.x; o[5] += pj * t1.y; o[6] += pj * t1.z; o[7] += pj * t1.w; }
        }
    }
#pragma unroll
    for (int e = 0; e < 8; ++e) { float v = o[e]; v += __shfl_xor(v, 8); v += __shfl_xor(v, 16); v += __shfl_xor(v, 32); if (kq == 0) smp[g * 72 + 8 * dc + e] = v * inv; }
    if (lane == 0) smp[g * 72 + 64] = mx + __log2f(sum);
}

template <int W>
__device__ __forceinline__ void pool_strip(const bf16_t* ub, const float* state_pool, rsrc_t rs_z, int r0, int ch) {
    if (r0 < S) {
        u32x4 raw[16 + W - 1];
#pragma unroll
        for (int i = 0; i < 16 + W - 1; ++i) { const int row = r0 - (W - 1) + i; raw[i] = (row >= 0) ? *(const u32x4*)(ub + (size_t)row * D + ch) : (u32x4){0u, 0u, 0u, 0u}; }
        float run[8] = {0.f, 0.f, 0.f, 0.f, 0.f, 0.f, 0.f, 0.f};
#pragma unroll
        for (int i = 0; i < W - 1; ++i) { run[0] += bflo(raw[i].x); run[1] += bfhi(raw[i].x); run[2] += bflo(raw[i].y); run[3] += bfhi(raw[i].y); run[4] += bflo(raw[i].z); run[5] += bfhi(raw[i].z); run[6] += bflo(raw[i].w); run[7] += bfhi(raw[i].w); }
#pragma unroll
        for (int i = 0; i < 16; ++i) {
            const u32x4 c = raw[i + W - 1]; const float cv[8] = {bflo(c.x), bfhi(c.x), bflo(c.y), bfhi(c.y), bflo(c.z), bfhi(c.z), bflo(c.w), bfhi(c.w)};
#pragma unroll
            for (int e = 0; e < 8; ++e) run[e] += cv[e];
            const int row = r0 + i; const float ic = 1.0f / (float)(W < row + 1 ? W : row + 1);
            u32x4 o; o.x = pk2(run[0] * ic - cv[0], run[1] * ic - cv[1]); o.y = pk2(run[2] * ic - cv[2], run[3] * ic - cv[3]); o.z = pk2(run[4] * ic - cv[4], run[5] * ic - cv[5]); o.w = pk2(run[6] * ic - cv[6], run[7] * ic - cv[7]);
            ST16(rs_z, ((unsigned)row * D + ch) * 2u, o);
            const u32x4 l = raw[i];
            run[0] -= bflo(l.x); run[1] -= bfhi(l.x); run[2] -= bflo(l.y); run[3] -= bfhi(l.y); run[4] -= bflo(l.z); run[5] -= bfhi(l.z); run[6] -= bflo(l.w); run[7] -= bfhi(l.w);
        }
    } else {
#pragma nounroll
        for (int i = 0; i < 16; ++i) {
            const int row = r0 + i; u32x4 o = {0u, 0u, 0u, 0u};
            if (row < MV) {
                const u32x4 c = *(const u32x4*)(ub + (size_t)row * D + ch); const float cv[8] = {bflo(c.x), bfhi(c.x), bflo(c.y), bfhi(c.y), bflo(c.z), bfhi(c.z), bflo(c.w), bfhi(c.w)};
                float a[8];
#pragma unroll
                for (int e = 0; e < 8; ++e) a[e] = cv[e];
                const float* sp = state_pool + (size_t)(row - S) * 15 * D + ch;
#pragma unroll
                for (int k = 1; k < W; ++k) { const f32x4 p0 = *(const f32x4*)(sp + (size_t)(15 - k) * D), p1 = *(const f32x4*)(sp + (size_t)(15 - k) * D + 4);
                    a[0] += p0.x; a[1] += p0.y; a[2] += p0.z; a[3] += p0.w; a[4] += p1.x; a[5] += p1.y; a[6] += p1.z; a[7] += p1.w; }
                const float ic = 1.0f / (float)W;
                o.x = pk2(a[0] * ic - cv[0], a[1] * ic - cv[1]); o.y = pk2(a[2] * ic - cv[2], a[3] * ic - cv[3]); o.z = pk2(a[4] * ic - cv[4], a[5] * ic - cv[5]); o.w = pk2(a[6] * ic - cv[6], a[7] * ic - cv[7]);
            }
            ST16(rs_z, ((unsigned)row * D + ch) * 2u, o);
        }
    }
}

struct Args { const float* in[26]; float* out; unsigned char* ws; };
enum { PH_GU0 = 0, PH_D0, PH_WIN, PH_POOL, PH_GRP, PH_WPO, PH_GU1, PH_D1, PH_GU2, PH_D2, PH_QKV, PH_ATT, PH_WAO, PH_GU3, PH_D3, NPHC };

constexpr int NWAVES = 8, NTHR = 512;
constexpr int LDS_BYTES = 147456;

__device__ __forceinline__ void tr_item(const float* W, int ldw, int k0, int n0, bf16_t* dst, int ldd, const float* kscale, const float* nscale, float f, LAS float* scr, int lane) {
    const rsrc_t rs = mkrs(dst, (size_t)1 << 30);
    float tv[32];
#pragma unroll
    for (int i = 0; i < 32; ++i) { const int kk = 2 * i + (lane >> 5); tv[i] = __builtin_nontemporal_load(W + (size_t)(k0 + kk) * ldw + n0 + (lane & 31)); }
#pragma unroll
    for (int i = 0; i < 32; ++i) { const int kk = 2 * i + (lane >> 5); float v = tv[i]; if (kscale) v *= kscale[k0 + kk]; scr[kk * 33 + (lane & 31)] = v; }
    LDS_WAIT(); asm volatile("" ::: "memory");
    const int c = lane & 7;
#pragma unroll
    for (int j = 0; j < 4; ++j) { const int n = (lane >> 3) + 8 * j; const LAS float* s = scr + (8 * c) * 33 + n; const float fn = nscale ? f * nscale[n0 + n] : f;
        u32x4 o; o.x = pk2(s[0 * 33] * fn, s[1 * 33] * fn); o.y = pk2(s[2 * 33] * fn, s[3 * 33] * fn); o.z = pk2(s[4 * 33] * fn, s[5 * 33] * fn); o.w = pk2(s[6 * 33] * fn, s[7 * 33] * fn);
        ST16(rs, (unsigned)(n * ldd + k0 + 8 * c) * 2u, o); }
    LDS_WAIT(); asm volatile("" ::: "memory");
}
__device__ __forceinline__ int t5_bucket(int dist) {
    if (dist < 16) return dist;
    const int b = 16 + (int)(log((double)dist / 16.0) / log(128.0) * 16.0);
    return b < 31 ? b : 31;
}

#ifndef PM
#define PM 0xffffff
#endif
#define ON(k) if ((PM >> (k)) & 1)
__global__ void __launch_bounds__(NTHR, 2) fwd_kernel(Args args) {
    extern __shared__ __attribute__((aligned(16))) unsigned char lds_raw[];
    LAS unsigned char* lds = (LAS unsigned char*)lds_raw;
    const int tid = threadIdx.x, lane = tid & 63, wave = __builtin_amdgcn_readfirstlane(tid >> 6);
    const int G = gridDim.x, bx = blockIdx.x;
    const int gw = bx * NWAVES + wave, NGW = G * NWAVES;
    const size_t gt = (size_t)bx * NTHR + tid, NGT = (size_t)G * NTHR;
    unsigned char* ws = args.ws; float* out = args.out;
    bf16_t* Wgu = (bf16_t*)(ws + WS_WGU); bf16_t* Wd = (bf16_t*)(ws + WS_WD); bf16_t* Win = (bf16_t*)(ws + WS_WIN); bf16_t* Wgrp = (bf16_t*)(ws + WS_WGRP);
    bf16_t* Wpo = (bf16_t*)(ws + WS_WPO); bf16_t* Wqkv = (bf16_t*)(ws + WS_WQKV); bf16_t* Wao = (bf16_t*)(ws + WS_WAO);
    float* biasT = (float*)(ws + WS_BIAS); float* part = (float*)(ws + WS_PART);
    bf16_t* xb = (bf16_t*)(ws + WS_XB); bf16_t* act = (bf16_t*)(ws + WS_ACT);
    bf16_t* ub = (bf16_t*)(ws + WS_U); bf16_t* zb = (bf16_t*)(ws + WS_Z); bf16_t* z2b = (bf16_t*)(ws + WS_Z2); bf16_t* qk = (bf16_t*)(ws + WS_QK); bf16_t* vT = (bf16_t*)(ws + WS_VT); bf16_t* ob = (bf16_t*)(ws + WS_O); bf16_t* vnew = (bf16_t*)(ws + WS_VNEW);
    const float* x_prompt = args.in[0]; const float* x_sample = args.in[1]; const float* state_pool = args.in[2];
    cg::grid_group grid = cg::this_grid();
    unsigned* ctl = (unsigned*)(ws + WS_CTL);
#define CNT(ph) (ctl + (size_t)(ph) * 72 * 64)
    constexpr size_t QOFF = (size_t)NPHC * 72 * 64 + 1024, QWORDS = (size_t)48 * 8 * 64;

    constexpr int I_GU = 16 * 88, I_D = 44 * 32, I_IN = 16 * 32, I_GRP = 4 * 8, I_QKV = 16 * 144, I_AO = 8 * 32;
#define TR_SCR ((LAS float*)(lds + wave * 16384))
#define CV_FOR(q, OFF_, CNT_) for (int q = gw - (OFF_) + (gw < (OFF_) ? NGW : 0); q < (CNT_); q += NGW)
#define CV_GU(f_, OFF_) CV_FOR(q2, OFF_, 2 * I_GU) { const int f = (f_), up = q2 / I_GU, q = q2 % I_GU, kb = q / 88, nb = q % 88, n0 = nb * 32, layer = f >> 1, second = f & 1; \
        tr_item(args.in[(second ? 22 : 10) + up] + (size_t)layer * D * FF, FF, kb * 64, n0, Wgu + (size_t)f * 2 * FF * D + (size_t)((n0 / 128) * 256 + (n0 % 128) + up * 128) * D, D, \
                args.in[second ? 21 : 9] + layer * D, nullptr, 1.0f, TR_SCR, lane_c); }
#define CV_D(f_, OFF_) CV_FOR(q, OFF_, I_D) { const int f = (f_), kb = q / 32, nb = q % 32, layer = f >> 1, second = f & 1; \
        tr_item(args.in[(second ? 22 : 10) + 2] + (size_t)layer * FF * D, D, kb * 64, nb * 32, Wd + (size_t)f * D * FF + (size_t)(nb * 32) * FF, FF, nullptr, nullptr, 0.5f, TR_SCR, lane_c); }
#define CV_IN(OFF_) CV_FOR(q, OFF_, I_IN) { const int kb = q / 32, nb = q % 32; tr_item(args.in[14], D, kb * 64, nb * 32, Win + (size_t)(nb * 32) * D, D, args.in[13], nullptr, 1.0f, TR_SCR, lane_c); }
#define CV_GRP(OFF_) CV_FOR(q2, OFF_, 4 * I_GRP) { const int gq = q2 / I_GRP, q = q2 % I_GRP, kb = q / 8, nb = q % 8; \
        tr_item(args.in[15] + (size_t)gq * 256 * 256, 256, kb * 64, nb * 32, Wgrp + (size_t)(gq * 256 + nb * 32) * 256, 256, nullptr, args.in[16] + gq * 256, 1.0f, TR_SCR, lane_c); }
#define CV_PO(OFF_) CV_FOR(q, OFF_, I_IN) { const int kb = q / 32, nb = q % 32; tr_item(args.in[17], D, kb * 64, nb * 32, Wpo + (size_t)(nb * 32) * D, D, nullptr, nullptr, 1.0f, TR_SCR, lane_c); }
#define CV_QKV(OFF_) CV_FOR(q, OFF_, I_QKV) { const int kb = q / 144, nb = q % 144, n0 = nb * 32; const float fs = ((n0 % 1536) < 512) ? 0.125f * 1.4426950408889634f : 1.0f; \
        const int gg = n0 / 1536, ss = (n0 % 1536) / 512, he = n0 % 512; const int drow = ss < 2 ? gg * 1024 + ss * 512 + he : 3072 + gg * 512 + he; \
        tr_item(args.in[18], QKVW, kb * 64, n0, Wqkv + (size_t)drow * D, D, args.in[13] + D, nullptr, fs, TR_SCR, lane_c); }
#define CV_AO(OFF_) CV_FOR(q, OFF_, I_AO) { const int kb = q / 32, nb = q % 32; tr_item(args.in[19], D, kb * 64, nb * 32, Wao + (size_t)(nb * 32) * 512, 512, nullptr, nullptr, 1.0f, TR_SCR, lane_c); }
#define WC(c) (ctl + (size_t)NPHC * 72 * 64 + (size_t)(c) * 64)
#define CONV_POINT(c, BODY) do { int lane_c = threadIdx.x; asm volatile("" : "+v"(lane_c)); lane_c &= 63; BODY VM_WAIT(); if (lane_c == 0) __hip_atomic_fetch_add(WC(c), 1u, RLX_AGENT); __syncthreads(); } while (0)
    ON(0) {
        LAS float* scr = (LAS float*)(lds + wave * 16384);
        { const int lane_c = lane; CV_GU(0, 0) CV_D(0, 768) }
        for (int row = gw; row < MP; row += NGW) {
            f32x4 v[4]; float s = 0.f;
            if (row < MV) { const f32x4* xr = (const f32x4*)(row < S ? x_prompt + (size_t)row * D : x_sample + (size_t)(row - S) * D) + lane;
#pragma unroll
                for (int j = 0; j < 4; ++j) { v[j] = __builtin_nontemporal_load(xr + 64 * j); s += (v[j].x * v[j].x + v[j].y * v[j].y) + (v[j].z * v[j].z + v[j].w * v[j].w); } }
            else {
#pragma unroll
                for (int j = 0; j < 4; ++j) v[j] = (f32x4){0.f, 0.f, 0.f, 0.f}; }
            s = wave_sum(s);
            u32x2* o8 = (u32x2*)(xb + (size_t)row * D) + lane;
#pragma unroll
            for (int j = 0; j < 4; ++j) { u32x2 w; w.x = pk2(v[j].x, v[j].y); w.y = pk2(v[j].z, v[j].w); o8[64 * j] = w; }
            if (lane < 4) part[(size_t)row * 4 + lane] = (lane == 0) ? s : 0.f;
        }
        for (size_t i = gt; i < 3 * 8 * 132; i += NGT) { const int j = (int)(i % 132), gh = (int)(i / 132), g = gh / 8, h = gh % 8;
            biasT[i] = (j <= 128) ? 1.4426950408889634f * args.in[20][t5_bucket(j * (1 << (2 * g))) * 24 + g * 8 + h] : 0.f; }
        for (size_t i = gt; i < (size_t)NS * 14 * (D / 4); i += NGT) { const size_t b = i / (14 * (D / 4)), rem = i % (14 * (D / 4));
            ((f32x4*)(out + O_PSS + b * 15 * D))[rem] = ((const f32x4*)(state_pool + b * 15 * D + D))[rem]; }
        for (size_t i = gt; i < QOFF + QWORDS; i += NGT) ctl[i] = 0u;
        for (size_t i = gt; i < (size_t)(MP - MV) * 64; i += NGT) ((u32x4*)(ob + (size_t)MV * 512))[i] = (u32x4){0u, 0u, 0u, 0u};
    }
    grid.sync();

    const int xcd = bx % 8;
    unsigned* qbase = ctl + QOFF; int qi = 0; int sk_id = 0; LAS unsigned* qslot = (LAS unsigned*)(lds + 131072 + 4096);
    CopyJob cjob{args.in, out, bx};
    const rsrc_t rs_act = mkrs(act, (size_t)MP * FF * 2), rs_xb = mkrs(xb, (size_t)MP * D * 2), rs_part = mkrs(part, (size_t)MP * 16);
    LAS float* red = (LAS float*)(lds + 131072);
    const unsigned* wdep_next = nullptr;
#define FLOW_GEMM(EPI_T, EPI_INIT, Aptr, LDA_, Bptr, LDB_, K_, NM_, NN_, APN_, BSIG_, DEP_, NEED_, DEPPN_, DEPSH_, PUB_, PUBPN_) do { \
        pg8::Gemm g{(const bf16_t*)(Aptr), (const bf16_t*)(Bptr), (LDA_), (LDB_), (K_), (APN_), (BSIG_)}; pg8::FlowOrder So; So.init((NM_), (NN_), 2, xcd, qbase, qi, qslot); \
        So.dep = (DEP_); So.need = (NEED_); So.need64 = (NEED_); So.dep_pn = (DEPPN_); So.dep_shift = (DEPSH_); So.pub = (PUB_); So.pub_pn = (PUBPN_); So.wdep = wdep_next; So.wneed = (unsigned)NGW; wdep_next = nullptr; \
        EPI_T E EPI_INIT; pg8::gemm_phase<EPI_T, pg8::FlowOrder>(lds, g, So, E); } while (0)
#define SKINNY(EPI_T, EPI_INIT, Aptr, LDA_, Bptr, LDB_, K_, NN_, APN_, DEP_, NEED_, PUB_) do { \
        const pg8::Gemm g{(const bf16_t*)(Aptr), (const bf16_t*)(Bptr), (LDA_), (LDB_), (K_), (APN_), 1}; \
        ++sk_id; \
        for (int j = 0; j < (NN_); ++j) if ((sk_id * 29 + j * 13 + 7) % G == bx) {        \
            EPI_T E EPI_INIT; const unsigned* dp = (DEP_); \
            if (dp) { if (tid < 64) { flow_poll1(dp + (size_t)64 * 64, (NEED_)); __builtin_amdgcn_fence(__ATOMIC_ACQUIRE, "agent"); VM_WAIT(); } } \
            __syncthreads(); skinny_unit<EPI_T>(lds, g, j, E); flow_publish((PUB_) + (size_t)64 * 64); __syncthreads(); } \
        } while (0)
#define SKINNY_Q(EPI_T, EPI_INIT, Aptr, LDA_, Bptr, LDB_, K_, NN_, APN_, DEP_, NEED_, PUB_) do { \
        const pg8::Gemm g{(const bf16_t*)(Aptr), (const bf16_t*)(Bptr), (LDA_), (LDB_), (K_), (APN_), 1}; pg8::FlowOrder So; So.init(1, (NN_), 1, xcd, qbase, qi, qslot); \
        EPI_T E EPI_INIT; Unit u; \
        while (So.next_blocking(u)) { const unsigned* dp = (DEP_); \
            if (dp) { if (tid < 64) { flow_poll1(dp + (size_t)64 * 64, (NEED_)); __builtin_amdgcn_fence(__ATOMIC_ACQUIRE, "agent"); VM_WAIT(); } } \
            __syncthreads(); skinny_unit<EPI_T>(lds, g, u.pn, E); flow_publish((PUB_) + (size_t)64 * 64); } \
        __syncthreads(); } while (0)
#define GU_PHASE(f, DEP_, PH_) do { FLOW_GEMM(EpiGU, ({{}, rs_act, part, &cjob}), xb, D, Wgu + (size_t)(f) * 2 * FF * D, D, D, 64, 22, 0, 1, DEP_, 32u, 0, 0, CNT(PH_), 0); \
        SKINNY(EpiGU, ({{}, rs_act, part, &cjob}), xb, D, Wgu + (size_t)(f) * 2 * FF * D, D, D, 22, 0, DEP_, 32u, CNT(PH_)); } while (0)
#define DN_PHASE(LAST_, RSXO_, f, DEP_, PH_) do { FLOW_GEMM(EpiRes<LAST_>, ({{}, xb, RSXO_, rs_xb, rs_part, red}), act, FF, Wd + (size_t)(f) * D * FF, FF, FF, 64, 4, 0, 1, DEP_, 176u, 0, 0, CNT(PH_), 0); \
        SKINNY(EpiRes<LAST_>, ({{}, xb, RSXO_, rs_xb, rs_part, red}), act, FF, Wd + (size_t)(f) * D * FF, FF, FF, 4, 0, DEP_, 176u, CNT(PH_)); } while (0)

#ifndef PM
#define PM 0xffffff
#endif
    ON(1) GU_PHASE(0, nullptr, PH_GU0);
    CONV_POINT(1, CV_IN(0) CV_GRP(512) CV_PO(640));
    ON(2) DN_PHASE(false, rs_xb, 0, CNT(PH_GU0), PH_D0);
    CONV_POINT(2, CV_GU(1, 0));
    wdep_next = WC(1);
    ON(3) { FLOW_GEMM(EpiU, ({{}, mkrs(ub, (size_t)MP * D * 2), part, out + O_PSP, out + O_PSS}), xb, D, Win, D, D, 64, 4, 0, 1, CNT(PH_D0), 32u, 0, 0, CNT(PH_WIN), 0);
            SKINNY(EpiU, ({{}, mkrs(ub, (size_t)MP * D * 2), part, out + O_PSP, out + O_PSS}), xb, D, Win, D, D, 4, 0, CNT(PH_D0), 32u, CNT(PH_WIN)); }
    ON(4)
    for (int sm = 0; sm < 2; ++sm) {
        pg8::FlowOrder So; So.init(sm ? 1 : 64, 4, sm ? 1 : 2, xcd, qbase, qi, qslot);
        const rsrc_t rs_z = mkrs(zb, (size_t)MP * D * 2);
        Unit u;
        while (So.next_blocking(u)) {
            const int pm = sm ? 64 : u.pm;
            if (tid < 64) { flow_poll1(CNT(PH_WIN) + (size_t)pm * 64, 32u); if (pm > 0 && pm < 64) flow_poll1(CNT(PH_WIN) + (size_t)(pm - 1) * 64, 32u);
                __builtin_amdgcn_fence(__ATOMIC_ACQUIRE, "agent"); VM_WAIT(); }
            __syncthreads();
            {
                const int chunk = tid & 31, strip = tid >> 5, ch = u.pn * 256 + chunk * 8, r0 = pm * 256 + strip * 16;
                if (u.pn == 0) pool_strip<2>(ub, state_pool, rs_z, r0, ch);
                else if (u.pn == 1) pool_strip<4>(ub, state_pool, rs_z, r0, ch);
                else if (u.pn == 2) pool_strip<8>(ub, state_pool, rs_z, r0, ch);
                else pool_strip<16>(ub, state_pool, rs_z, r0, ch);
            }
            flow_publish(CNT(PH_POOL) + (size_t)pm * 64);
        }
    }
    CONV_POINT(3, CV_D(1, 0));
    wdep_next = WC(1);
    ON(5) { FLOW_GEMM(EpiPlain, ({{}, mkrs(z2b, (size_t)MP * D * 2)}), zb, D, Wgrp, 256, 256, 64, 4, 256, 1, CNT(PH_POOL), 32u, 0, 0, CNT(PH_GRP), 0);
            SKINNY(EpiPlain, ({{}, mkrs(z2b, (size_t)MP * D * 2)}), zb, D, Wgrp, 256, 256, 4, 256, CNT(PH_POOL), 32u, CNT(PH_GRP)); }
    wdep_next = WC(1);
    ON(6) { FLOW_GEMM(EpiRes<false>, ({{}, xb, rs_xb, rs_xb, rs_part, red}), z2b, D, Wpo, D, D, 64, 4, 0, 1, CNT(PH_GRP), 32u, 0, 0, CNT(PH_WPO), 0);
            SKINNY(EpiRes<false>, ({{}, xb, rs_xb, rs_xb, rs_part, red}), z2b, D, Wpo, D, D, 4, 0, CNT(PH_GRP), 32u, CNT(PH_WPO)); }
    CONV_POINT(4, CV_GU(2, 0));
    wdep_next = WC(2);
    ON(7) GU_PHASE(1, CNT(PH_WPO), PH_GU1);
    CONV_POINT(5, CV_D(2, 0));
    wdep_next = WC(3);
    ON(8) DN_PHASE(false, rs_xb, 1, CNT(PH_GU1), PH_D1);
    CONV_POINT(6, CV_QKV(0));
    wdep_next = WC(4);
    ON(9) GU_PHASE(2, CNT(PH_D1), PH_GU2);
    CONV_POINT(7, CV_AO(0) CV_GU(3, 256));
    wdep_next = WC(5);
    ON(10) DN_PHASE(false, rs_xb, 2, CNT(PH_GU2), PH_D2);
    CONV_POINT(8, CV_D(3, 0));
    wdep_next = WC(6);
    ON(11) { FLOW_GEMM(EpiQK, ({{}, mkrs(qk, (size_t)MP * 3072 * 2), part, out, mkrs(vnew, (size_t)NS * 1536 * 2)}), xb, D, Wqkv, D, D, 64, 12, 0, 1, CNT(PH_D2), 32u, 0, 0, CNT(PH_QKV), 0);
             SKINNY(EpiQK, ({{}, mkrs(qk, (size_t)MP * 3072 * 2), part, out, mkrs(vnew, (size_t)NS * 1536 * 2)}), xb, D, Wqkv, D, D, 18, 0, CNT(PH_D2), 32u, CNT(PH_QKV)); }
    ON(12)
#pragma unroll
    for (int gi = 0; gi < 3; ++gi)
        FLOW_GEMM(EpiVT, ({mkrs(vT + (size_t)gi * 512 * MPV, (size_t)512 * MPV * 2), part, out, gi, 1 << (2 * gi)}), Wqkv + (size_t)(3072 + gi * 512) * D, D, xb, D, D, 2, 64, 0, 1 << (2 * gi), CNT(PH_D2), 32u, 1, 0, CNT(PH_QKV), 1);
    ON(13) {
        LAS float* biasL = (LAS float*)(lds + 131072);
        LAS float* smp = (LAS float*)(lds + 131072 + 2048);
        const rsrc_t rs_o = mkrs(ob, (size_t)MP * 512 * 2);
#define STAGE_G0(k_) do { const int key0 = 512 * sp + 256 * (k_) - 128; \
            _Pragma("unroll") for (int j = 0; j < 6; ++j) { const int p = (wave * 6 + j) * 1024 + lane * 16; \
                { const int key = p >> 7, c = ((p >> 4) & 7) ^ ((key >> 1) & 7); int tok = key0 + key; tok = tok < 0 ? 0 : tok; \
                  __builtin_amdgcn_global_load_lds((const unsigned*)(qk + (size_t)tok * 3072 + 512 + h * 64 + c * 8), (LAS unsigned*)(lds + (wave * 6 + j) * 1024), 16, 0, 0); } \
                { const int dim = p / 768, c = ((p % 768) >> 4) ^ (dim & 15); \
                  __builtin_amdgcn_global_load_lds((const unsigned*)(vT + (size_t)(h * 64 + dim) * MPV + 128 + key0 + c * 8), (LAS unsigned*)(lds + 49152 + (wave * 6 + j) * 1024), 16, 0, 0); } } } while (0)
        pg8::FlowOrder So; So.init(32, 8, 1, xcd, qbase, qi, qslot);
        Unit u;
        while (So.next_blocking(u)) {
            const int sp = u.pm, h = u.pn;
            if (tid < 64) { const int p0 = 2 * sp - 8 < 0 ? 0 : 2 * sp - 8, idx = p0 + lane; unsigned spn = 0;
                for (;;) { const unsigned v = (idx <= 2 * sp + 1) ? __hip_atomic_load(CNT(PH_QKV) + (size_t)idx * 64, RLX_AGENT) : 144u;
                    if (__all(v >= 144u)) break; __builtin_amdgcn_s_sleep(2); if (++spn > FLOW_SPIN_CAP) break; }
                            __builtin_amdgcn_fence(__ATOMIC_ACQUIRE, "agent"); VM_WAIT(); }
            __syncthreads();
            for (int j = tid; j < 3 * 132; j += NTHR) biasL[j] = biasT[((j / 132) * 8 + h) * 132 + (j % 132)];
            __syncthreads();
            STAGE_G0(0);
#pragma nounroll
            for (int k = 0; k < 2; ++k) attn_job<2>(qk, vT + (size_t)2 * 512 * MPV, biasL + 2 * 132, act, rs_o, h, wave + 8 * k, 32 * sp, lane);
#pragma nounroll
            for (int k = 0; k < 2; ++k) attn_job<1>(qk, vT + (size_t)1 * 512 * MPV, biasL + 1 * 132, act, rs_o, h, wave & 3, 128 * sp + 32 * ((wave >> 2) + 2 * k), lane);
            __syncthreads();
#pragma nounroll
            for (int k = 0; k < 2; ++k) {
                if (k) { __syncthreads(); STAGE_G0(1); }
                VM_WAIT(); __syncthreads();
                attn_job<0>(qk, vT, biasL, act, rs_o, h, 0, 512 * sp + 32 * (wave + 8 * k), lane, lds, lds + 49152, 32 * wave);
            }
            flow_publish(CNT(PH_ATT) + (size_t)sp * 64);
        }
        pg8::FlowOrder Ss; Ss.init(NS, 8, 1, xcd, qbase, qi, qslot);
        while (Ss.next_blocking(u)) {
            const int b = u.pm, h = u.pn;
            if (tid < 64) { flow_poll1(CNT(PH_QKV) + (size_t)64 * 64, 144u); __builtin_amdgcn_fence(__ATOMIC_ACQUIRE, "agent"); VM_WAIT(); }
            __syncthreads();
            if (wave < 3) sample_attn_group(wave, b, h, qk, vnew, args.in[3 + 2 * wave], args.in[4 + 2 * wave], biasT, smp, lane);
            __syncthreads();
            if (wave == 0 && lane < 32) { const float l0 = smp[64], l1 = smp[72 + 64], l2 = smp[144 + 64], mm = fmaxf(fmaxf(l0, l1), l2);
                const float w0 = __builtin_amdgcn_exp2f(l0 - mm), w1 = __builtin_amdgcn_exp2f(l1 - mm), w2 = __builtin_amdgcn_exp2f(l2 - mm), iw = 1.0f / (w0 + w1 + w2);
                const float r0 = (w0 * smp[2 * lane] + w1 * smp[72 + 2 * lane] + w2 * smp[144 + 2 * lane]) * iw, r1 = (w0 * smp[2 * lane + 1] + w1 * smp[72 + 2 * lane + 1] + w2 * smp[144 + 2 * lane + 1]) * iw;
                ST4(rs_o, ((unsigned)(S + b) * 512 + h * 64 + 2 * lane) * 2u, pk2(r0, r1)); }
            flow_publish(CNT(PH_ATT) + (size_t)32 * 64);
        }
        __syncthreads();
    }
    wdep_next = WC(7);
    ON(14) { FLOW_GEMM(EpiRes<false>, ({{}, xb, rs_xb, rs_xb, rs_part, red}), ob, 512, Wao, 512, 512, 64, 4, 0, 1, CNT(PH_ATT), 64u, 0, 1, CNT(PH_WAO), 0);
             SKINNY(EpiRes<false>, ({{}, xb, rs_xb, rs_xb, rs_part, red}), ob, 512, Wao, 512, 512, 4, 0, CNT(PH_ATT) - (size_t)32 * 64, (unsigned)(NS * 8 * 8), CNT(PH_WAO)); }
    wdep_next = WC(7);
    ON(15) { FLOW_GEMM(EpiGU, ({{}, rs_act, part, &cjob}), xb, D, Wgu + (size_t)3 * 2 * FF * D, D, D, 64, 22, 0, 1, CNT(PH_WAO), 32u, 0, 0, CNT(PH_GU3), 0);
             SKINNY_Q(EpiGU, ({{}, rs_act, part, &cjob}), xb, D, Wgu + (size_t)3 * 2 * FF * D, D, D, 22, 0, CNT(PH_WAO), 32u, CNT(PH_GU3)); }
    wdep_next = WC(8);
    ON(16) { FLOW_GEMM(EpiRes<false>, ({{}, xb, rs_xb, rs_xb, rs_part, red}), act, FF, Wd + (size_t)3 * D * FF, FF, FF, 64, 4, 0, 1, CNT(PH_GU3), 176u, 0, 0, CNT(PH_D3), 0);
             SKINNY_Q(EpiRes<false>, ({{}, xb, rs_xb, rs_xb, rs_part, red}), act, FF, Wd + (size_t)3 * D * FF, FF, FF, 4, 0, CNT(PH_GU3), 176u, CNT(PH_D3)); }
    ON(17) {
        pg8::FlowOrder So; So.init(NPANEL, 4, 1, xcd, qbase, qi, qslot);
        const float* gf = args.in[25]; Unit u;
        while (So.next_blocking(u)) {
            if (tid < 64) { flow_poll1(CNT(PH_D3) + (size_t)u.pm * 64, 32u); __builtin_amdgcn_fence(__ATOMIC_ACQUIRE, "agent"); VM_WAIT(); }
            __syncthreads();
            u32x2 xw[8][4]; float rsv[8];
#pragma unroll
            for (int k = 0; k < 8; ++k) { int row = u.pm * 256 + u.pn * 64 + wave + 8 * k; if (row >= MV) row = MV - 1;
                rsv[k] = rstd_of(part, row); const u32x2* xr = (const u32x2*)(xb + (size_t)row * D) + lane;
#pragma unroll
                for (int j = 0; j < 4; ++j) xw[k][j] = xr[64 * j]; }
            f32x4 gg[4];
#pragma unroll
            for (int j = 0; j < 4; ++j) gg[j] = ((const f32x4*)gf + lane)[64 * j];
#pragma unroll
            for (int k = 0; k < 8; ++k) { const int row = u.pm * 256 + u.pn * 64 + wave + 8 * k;
                if (row < MV) { f32x4* xr = (f32x4*)(out + (size_t)row * D) + lane;
#pragma unroll
                    for (int j = 0; j < 4; ++j) { const f32x4 xv = {bflo(xw[k][j].x), bfhi(xw[k][j].x), bflo(xw[k][j].y), bfhi(xw[k][j].y)}; __builtin_nontemporal_store(xv * rsv[k] * gg[j], xr + 64 * j); } } }
        }
    }
    for (int chunk = cjob.next; chunk < CP_CHUNKS; chunk += 256) {
#pragma unroll
        for (int q = 0; q < 4; ++q) { const f32x4* src; f32x4* dst; if (cp_addr(args.in, out, chunk * 32 + wave * 4 + q, lane, src, dst)) { const f32x4 a0 = __builtin_nontemporal_load(src), a1 = __builtin_nontemporal_load(src + 64); __builtin_nontemporal_store(a0, dst); __builtin_nontemporal_store(a1, dst + 64); } }
    }
}

extern "C" void kernel_launch(void* const* d_in, const int* in_sizes, int n_in, void* d_out, int out_size, void* d_ws, size_t ws_size, hipStream_t stream) {
    static int grid = 0;
    if (grid == 0) {
        if (n_in != 26 || (size_t)out_size != OUT_TOTAL || ws_size < WS_END) { fprintf(stderr, "kernel_launch: unexpected shapes: n_in %d out %d (want %zu) ws %zu (need %zu)\n", n_in, out_size, (size_t)OUT_TOTAL, ws_size, (size_t)WS_END); grid = -1; return; }
        int dev = 0, cus = 0, per_cu = 0;
        hipGetDevice(&dev); hipDeviceGetAttribute(&cus, hipDeviceAttributeMultiprocessorCount, dev);
        hipFuncSetAttribute((const void*)fwd_kernel, hipFuncAttributeMaxDynamicSharedMemorySize, LDS_BYTES);
        hipOccupancyMaxActiveBlocksPerMultiprocessor(&per_cu, (const void*)fwd_kernel, NTHR, LDS_BYTES);
        if (per_cu < 1) { fprintf(stderr, "kernel_launch: occupancy query says %d blocks per CU\n", per_cu); per_cu = 1; }
        grid = cus;
        (void)hipGetLastError();
    }
    if (grid < 0) return;
    Args a{};
    for (int i = 0; i < 26; ++i) a.in[i] = (const float*)d_in[i];
    a.out = (float*)d_out; a.ws = (unsigned char*)d_ws;
    void* kargs[] = {&a};
    hipError_t e = hipLaunchCooperativeKernel((const void*)fwd_kernel, dim3(grid), dim3(NTHR), kargs, LDS_BYTES, stream);
    if (e != hipSuccess) fprintf(stderr, "cooperative launch failed: %s (grid %d)\n", hipGetErrorString(e), grid);
}
```

```cpp
#include <hip/hip_runtime.h>
#include <hip/hip_cooperative_groups.h>
#include <cstdio>
#include <cstdint>
namespace cg = cooperative_groups;


#define LAS __attribute__((address_space(3)))
typedef unsigned short bf16_t;
typedef short bf16x8 __attribute__((ext_vector_type(8)));
typedef float f32x4 __attribute__((ext_vector_type(4)));
typedef float f32x2 __attribute__((ext_vector_type(2)));
typedef unsigned u32x4 __attribute__((ext_vector_type(4)));
typedef unsigned u32x2 __attribute__((ext_vector_type(2)));

constexpr int D = 1024, S = 16384, NS = 32, FF = 2816, MP = 16640, NPANEL = 65, MV = S + NS;
constexpr int QKVW = 4608;
constexpr int MPV = MP + 128;
constexpr float EPS = 1e-6f;

__device__ __forceinline__ unsigned f2bf(float f) { unsigned u = __builtin_bit_cast(unsigned, f); return (u + 0x7fffu + ((u >> 16) & 1u)) >> 16; }
__device__ __forceinline__ unsigned pk2(float lo, float hi) { return f2bf(lo) | (f2bf(hi) << 16); }
__device__ __forceinline__ float bf2f(unsigned short b) { return __builtin_bit_cast(float, ((unsigned)b) << 16); }
__device__ __forceinline__ float bflo(unsigned w) { return __builtin_bit_cast(float, w << 16); }
__device__ __forceinline__ float bfhi(unsigned w) { return __builtin_bit_cast(float, w & 0xffff0000u); }
#define LDS_WAIT() asm volatile("s_waitcnt lgkmcnt(0)" ::: "memory")
#define VM_WAIT() asm volatile("s_waitcnt vmcnt(0)" ::: "memory")
typedef __amdgpu_buffer_rsrc_t rsrc_t;
__device__ __forceinline__ rsrc_t mkrs(const void* p, size_t bytes) { return __builtin_amdgcn_make_buffer_rsrc((void*)p, 0, (int)bytes, 0x00020000); }
#define ST16(rs, off, v) __builtin_amdgcn_raw_buffer_store_b128((v), (rs), (unsigned)(off), 0, 16)
#define ST8(rs, off, v) __builtin_amdgcn_raw_buffer_store_b64((v), (rs), (unsigned)(off), 0, 16)
#define ST4(rs, off, v) __builtin_amdgcn_raw_buffer_store_b32((v), (rs), (unsigned)(off), 0, 16)
#define F4U(v) __builtin_bit_cast(u32x4, (v))
#define RLX_AGENT __ATOMIC_RELAXED, __HIP_MEMORY_SCOPE_AGENT

namespace pg8 {
constexpr int BM = 256, BK = 64, HALF = 128, HTB = HALF * BK * 2, STAGE_BYTES = 8 * HTB, NXCD = 8, WGM = 8;
__host__ __device__ __forceinline__ int lds_byte(int r, int c) { const int st = (r >> 4) * 2 + (c >> 5), rr = r & 15, cc = c & 31, ob = rr * 64 + cc * 2; return st * 1024 + (ob ^ (((ob >> 9) & 1) << 5)); }
__host__ __device__ __forceinline__ void stage_rc(int b, int& R, int& C) { const int st = b / 1024, sb = b % 1024, swz = sb ^ (((sb >> 9) & 1) << 5); R = (st >> 1) * 16 + swz / 64; C = (st & 1) * 32 + (swz % 64) / 2; }
__host__ __device__ __forceinline__ int perm32(int rho) { const int n = rho >> 4, i = rho & 15; return 8 * (i >> 2) + 4 * n + (i & 3); }
__host__ __device__ __forceinline__ int sigma_row(int d, int v) { const int q = 256 / d; return (v % q) * d + v / q; }

struct Unit { int pm, pn; };
struct Gemm { const bf16_t* A; const bf16_t* Bt; int lda, ldb, K, a_pn, bsig; };

#define FLOW_SPIN_CAP (1u << 21)
__device__ __forceinline__ void flow_poll1(const unsigned* c, unsigned need) {
    unsigned sp = 0;
    while ((unsigned)__builtin_amdgcn_readfirstlane(__hip_atomic_load(c, RLX_AGENT)) < need) { __builtin_amdgcn_s_sleep(2); if (++sp > FLOW_SPIN_CAP) break; }
}
__device__ __forceinline__ void flow_publish(unsigned* c) {
    asm volatile("s_waitcnt vmcnt(0)" ::: "memory");
    if ((threadIdx.x & 63) == 0) __hip_atomic_fetch_add(c, 1u, RLX_AGENT);
}
struct FlowOrder {
    int nM, nN, wgm, base, nx;
    unsigned* head;
    LAS unsigned* slot;
    unsigned claimed;
    const unsigned* wdep; unsigned wneed;
    const unsigned* dep; unsigned need, need64; int dep_pn, dep_shift;
    unsigned* pub; int pub_pn;
    __device__ __forceinline__ void init(int nM_, int nN_, int wgm_, int xcd, unsigned* qbase, int& qi, LAS unsigned* slot_) {
        nM = nM_; nN = nN_; wgm = wgm_;
        const int nwg = nM * nN, q = nwg / NXCD, r = nwg % NXCD;
        nx = q + (xcd < r ? 1 : 0); base = xcd < r ? xcd * (q + 1) : r * (q + 1) + (xcd - r) * q;
        head = qbase + (size_t)(qi * NXCD + xcd) * 64; ++qi; slot = slot_; claimed = 0u;
        wdep = nullptr; wneed = 0; dep = nullptr; need = 0; need64 = 0; dep_pn = 0; dep_shift = 0; pub = nullptr; pub_pn = 0;
    }
    __device__ __forceinline__ bool decode(unsigned l, Unit& u) const {
        if (l >= (unsigned)nx) return false;
        const int wgid = base + (int)l, nig = wgm * nN, gid = wgid / nig, fm = gid * wgm, gsz = (nM - fm) < wgm ? (nM - fm) : wgm;
        u.pm = fm + ((wgid % nig) % gsz); u.pn = (wgid % nig) / gsz; return true;
    }
    __device__ __forceinline__ bool next_blocking(Unit& u) {
        __syncthreads();
        if (threadIdx.x == 0) { const unsigned tk = __hip_atomic_fetch_add(head, 1u, RLX_AGENT);
            if (wdep) { unsigned sp = 0; while (__hip_atomic_load(wdep, RLX_AGENT) < wneed) { __builtin_amdgcn_s_sleep(2); if (++sp > FLOW_SPIN_CAP) break; } }
            *slot = tk; }
        __syncthreads();
        return decode(*slot, u);
    }
    __device__ __forceinline__ void claim_issue() { if (threadIdx.x == 0) claimed = __hip_atomic_fetch_add(head, 1u, RLX_AGENT); }
    __device__ __forceinline__ bool ready_next(Unit& u) {
        if (threadIdx.x < 64) {
            const unsigned l = (unsigned)__builtin_amdgcn_readfirstlane((int)claimed);
            Unit t; const bool ok = decode(l, t);
            if (ok && dep) { const int panel = dep_pn ? t.pn : t.pm;
                flow_poll1(dep + (size_t)(panel >> dep_shift) * 64, panel == 64 ? need64 : need);
                __builtin_amdgcn_fence(__ATOMIC_ACQUIRE, "agent");
                asm volatile("s_waitcnt vmcnt(0)" ::: "memory"); }
            if (threadIdx.x == 0) *slot = l;
        }
        asm volatile("s_waitcnt lgkmcnt(0)" ::: "memory"); __builtin_amdgcn_s_barrier(); asm volatile("" ::: "memory");
        return decode(*slot, u);
    }
    __device__ __forceinline__ void a_ready(const Unit& u) const {
        if (dep) {
            if (threadIdx.x < 64) { const int panel = dep_pn ? u.pn : u.pm;
                flow_poll1(dep + (size_t)(panel >> dep_shift) * 64, panel == 64 ? need64 : need);
                __builtin_amdgcn_fence(__ATOMIC_ACQUIRE, "agent");
                asm volatile("s_waitcnt vmcnt(0)" ::: "memory"); }
            asm volatile("" ::: "memory"); __builtin_amdgcn_s_barrier(); asm volatile("" ::: "memory");
        }
    }
    __device__ __forceinline__ void done(const Unit& u) const { if (pub) flow_publish(pub + (size_t)(pub_pn ? u.pn : u.pm) * 64); }
};

__device__ __forceinline__ unsigned cvt_pk_bf16(float lo, float hi) { unsigned r; asm volatile("v_cvt_pk_bf16_f32 %0, %1, %2" : "=v"(r) : "v"(lo), "v"(hi)); return r; }

template <class Epi, class Sched>
__device__ __forceinline__ void gemm_phase(LAS unsigned char* lds, const Gemm g, Sched& S, const Epi& E) {
    int tid = threadIdx.x; asm volatile("" : "+v"(tid));
    const int wid = __builtin_amdgcn_readfirstlane(tid >> 6), lane = tid & 63, wr = wid >> 2, wc = wid & 3, fr = lane & 15, fq = lane >> 4;
    const int K = g.K, nt = K / BK;
    unsigned voffA[2], voffB[2];
#pragma unroll
    for (int i = 0; i < 2; ++i) { int R, C; stage_rc(tid * 16 + i * 8192, R, C); const int Rb = sigma_row(g.bsig, (R & ~31) + perm32(R & 31));
        voffA[i] = (unsigned)(R * g.lda + C) * 2u; voffB[i] = (unsigned)(Rb * g.ldb + C) * 2u; }
    const size_t kstep = (size_t)(BK * 2);
    const size_t hstepA = (size_t)HALF * g.lda * 2, hstepB = (size_t)sigma_row(g.bsig, HALF) * g.ldb * 2;
    const size_t tstepA = 2 * hstepA, tstepB = (size_t)BM * g.ldb * 2;
    const unsigned ldsw = (unsigned)wid * 1024u;
    const int aoff = lds_byte(wr * 64 + fr, fq * 8), boff = lds_byte(wc * 32 + fr, fq * 8);
#define PG8_SA(b, h) (((b) * 2 + (h)) * HTB)
#define PG8_SB(b, h) ((4 + (b) * 2 + (h)) * HTB)
#define PG8_STAGE(bufoff, gbase, voff) do { _Pragma("unroll") for (int _i = 0; _i < 2; ++_i) \
        __builtin_amdgcn_global_load_lds((const unsigned*)((const char*)(gbase) + (voff)[_i]), (LAS unsigned*)(lds + (bufoff) + ldsw + _i * 8192), 16, 0, 0); } while (0)
#define PG8_LDA(dst, b, h) do { _Pragma("unroll") for (int m = 0; m < 4; ++m) _Pragma("unroll") for (int k = 0; k < 2; ++k) dst[m][k] = *(const LAS bf16x8*)(lds + PG8_SA(b, h) + aoff + m * 2048 + k * 1024); } while (0)
#define PG8_LDB(dst, b, h) do { _Pragma("unroll") for (int n = 0; n < 2; ++n) _Pragma("unroll") for (int k = 0; k < 2; ++k) dst[n][k] = *(const LAS bf16x8*)(lds + PG8_SB(b, h) + boff + n * 2048 + k * 1024); } while (0)
#define PG8_MMA(ai, bj, At, Bt) do { __builtin_amdgcn_s_setprio(1); _Pragma("unroll") for (int m = 0; m < 4; ++m) _Pragma("unroll") for (int n = 0; n < 2; ++n) _Pragma("unroll") for (int k = 0; k < 2; ++k) \
        acc[ai][bj][m][n] = __builtin_amdgcn_mfma_f32_16x16x32_bf16(Bt[n][k], At[m][k], acc[ai][bj][m][n], 0, 0, 0); __builtin_amdgcn_s_setprio(0); } while (0)
#define PG8_WAIT_V(n) asm volatile("s_waitcnt vmcnt(" #n ")" ::: "memory")
#define PG8_WAIT_L(n) asm volatile("s_waitcnt lgkmcnt(" #n ")" ::: "memory")
#define PG8_BAR __builtin_amdgcn_s_barrier()
#define PG8_SCHED __builtin_amdgcn_sched_barrier(0)
    Unit cur, nxt; int ui = 0;
    if (!S.next_blocking(cur)) return;
    f32x4 acc[2][2][4][2];
#pragma unroll
    for (int a = 0; a < 2; ++a)
#pragma unroll
        for (int b = 0; b < 2; ++b)
#pragma unroll
            for (int m = 0; m < 4; ++m)
#pragma unroll
                for (int n = 0; n < 2; ++n) acc[a][b][m][n] = (f32x4){0.f, 0.f, 0.f, 0.f};
    bf16x8 At[4][2], B0[2][2], B1[2][2];
    const char* cA = (const char*)g.A + (size_t)cur.pm * tstepA + (size_t)cur.pn * g.a_pn * 2; const char* cB = (const char*)g.Bt + (size_t)cur.pn * tstepB;
    PG8_STAGE(PG8_SB(0, 0), cB, voffB); PG8_STAGE(PG8_SB(0, 1), cB + hstepB, voffB);
    S.a_ready(cur);
    PG8_STAGE(PG8_SA(0, 0), cA, voffA); PG8_STAGE(PG8_SA(0, 1), cA + hstepA, voffA);
    if (wr == 1) PG8_BAR;
    PG8_WAIT_V(2); PG8_BAR;
    PG8_STAGE(PG8_SB(1, 0), cB + kstep, voffB); PG8_STAGE(PG8_SA(1, 0), cA + kstep, voffA); PG8_STAGE(PG8_SB(1, 1), cB + hstepB + kstep, voffB);
    PG8_WAIT_V(6); PG8_BAR;
    for (;;) {
        bool has_next = false; const char* nA = cA; const char* nB = cB;
        const int t_claim = nt >= 4 ? nt - 4 : 0;
#pragma nounroll
        for (int t = 0; t < nt; t += 2) {
            const bool last = (t == nt - 2);
            const char* a1 = cA + (size_t)(t + 1) * kstep;
            if (t == t_claim) S.claim_issue();
            if (last) { has_next = S.ready_next(nxt);
                if (has_next) { nA = (const char*)g.A + (size_t)nxt.pm * tstepA + (size_t)nxt.pn * g.a_pn * 2; nB = (const char*)g.Bt + (size_t)nxt.pn * tstepB; } }
            const char* a2 = last ? nA : cA + (size_t)(t + 2) * kstep; const char* b2 = last ? nB : cB + (size_t)(t + 2) * kstep;
            const char* a3 = a2 + kstep; const char* b3 = b2 + kstep;
            PG8_LDB(B0, 0, 0); PG8_LDB(B1, 0, 1); PG8_SCHED; PG8_LDA(At, 0, 0); PG8_STAGE(PG8_SA(1, 1), a1 + hstepA, voffA);
            PG8_WAIT_V(8); PG8_WAIT_L(0); PG8_BAR; PG8_MMA(0, 0, At, B0); PG8_MMA(0, 1, At, B1); PG8_BAR; PG8_SCHED;
            PG8_LDA(At, 0, 1); PG8_STAGE(PG8_SB(0, 0), b2, voffB); PG8_STAGE(PG8_SB(0, 1), b2 + hstepB, voffB); PG8_STAGE(PG8_SA(0, 0), a2, voffA);
            PG8_WAIT_V(8); PG8_WAIT_L(0); PG8_BAR; PG8_MMA(1, 0, At, B0); PG8_MMA(1, 1, At, B1); PG8_BAR; PG8_SCHED;
            PG8_LDB(B0, 1, 0); PG8_LDB(B1, 1, 1); PG8_SCHED; PG8_LDA(At, 1, 0); PG8_STAGE(PG8_SA(0, 1), a2 + hstepA, voffA);
            PG8_WAIT_V(8); PG8_WAIT_L(0); PG8_BAR; PG8_MMA(0, 0, At, B0); PG8_MMA(0, 1, At, B1); PG8_BAR; PG8_SCHED;
            PG8_LDA(At, 1, 1); PG8_STAGE(PG8_SB(1, 0), b3, voffB); PG8_STAGE(PG8_SB(1, 1), b3 + hstepB, voffB); PG8_STAGE(PG8_SA(1, 0), a3, voffA);
            PG8_WAIT_V(8); PG8_WAIT_L(0); PG8_BAR; PG8_MMA(1, 0, At, B0); PG8_MMA(1, 1, At, B1); PG8_BAR; PG8_SCHED;
        }
        if (wr == 0) PG8_BAR;
        E(acc, cur, wr, wc, fr, fq); S.done(cur);
        if (!has_next) break;
#pragma unroll
        for (int a = 0; a < 2; ++a)
#pragma unroll
            for (int b = 0; b < 2; ++b)
#pragma unroll
                for (int m = 0; m < 4; ++m)
#pragma unroll
                    for (int n = 0; n < 2; ++n) acc[a][b][m][n] = (f32x4){0.f, 0.f, 0.f, 0.f};
        cur = nxt; cA = nA; cB = nB; ++ui;
        if (wr == 1) PG8_BAR;
    }
    PG8_WAIT_V(0);
    PG8_BAR;
#undef PG8_SA
#undef PG8_SB
#undef PG8_STAGE
#undef PG8_LDA
#undef PG8_LDB
#undef PG8_MMA
#undef PG8_WAIT_V
#undef PG8_WAIT_L
#undef PG8_BAR
#undef PG8_SCHED
}
}
using pg8::Unit;
using pg8::cvt_pk_bf16;
using pg8::flow_poll1;
using pg8::flow_publish;

constexpr size_t MiB = 1u << 20;
constexpr size_t al(size_t x) { return (x + 4095) & ~(size_t)4095; }
constexpr size_t WS_CTL = 0;
constexpr size_t WS_WGU = 1 * MiB;
constexpr size_t SZ_WGU = (size_t)2 * FF * D * 2;
constexpr size_t WS_WD = WS_WGU + 4 * SZ_WGU;
constexpr size_t SZ_WD = (size_t)D * FF * 2;
constexpr size_t WS_WIN = WS_WD + 4 * SZ_WD;
constexpr size_t WS_WGRP = WS_WIN + (size_t)D * D * 2;
constexpr size_t WS_WPO = WS_WGRP + (size_t)D * 256 * 2;
constexpr size_t WS_WQKV = WS_WPO + (size_t)D * D * 2;
constexpr size_t WS_WAO = WS_WQKV + (size_t)QKVW * D * 2;
constexpr size_t WS_BIAS = WS_WAO + (size_t)D * 512 * 2;
constexpr size_t WS_PART = al(WS_BIAS + 3 * 8 * 132 * 4);
constexpr size_t WS_XB = al(WS_PART + (size_t)MP * 4 * 4);
constexpr size_t WS_XF = WS_XB + (size_t)MP * D * 2;
constexpr size_t WS_ACT = WS_XF + (size_t)MP * D * 4;
constexpr size_t WS_U = WS_ACT + (size_t)MP * FF * 2;
constexpr size_t WS_Z = WS_U + (size_t)MP * D * 2;
constexpr size_t WS_Z2 = WS_Z + (size_t)MP * D * 2;
constexpr size_t WS_QK = WS_Z2 + (size_t)MP * D * 2;
constexpr size_t WS_VT = WS_QK + (size_t)MP * 3072 * 2;
constexpr size_t WS_O = WS_VT + (size_t)3 * 512 * MPV * 2;
constexpr size_t WS_VNEW = WS_O + (size_t)MP * 512 * 2;
constexpr size_t WS_END = WS_VNEW + (size_t)NS * 1536 * 2;

constexpr size_t O_YP = 0, O_YS = (size_t)S * D, O_PSP = O_YS + (size_t)NS * D, O_PSS = O_PSP + 15 * D, O_KV0 = O_PSS + (size_t)NS * 15 * D;
__host__ __device__ constexpr size_t kv_group_base(int g) {
    size_t o = O_KV0;
    for (int i = 0; i < g; ++i) { const size_t W = (size_t)128 << (2 * i); o += 2 * W * 512 + 2 * (size_t)NS * W * 512; }
    return o;
}
constexpr size_t OUT_TOTAL = kv_group_base(3);

constexpr int CP_ROWS_TOTAL = 2 * NS * (127 + 511 + 2047);
constexpr int CP_CHUNKS = (CP_ROWS_TOTAL + 31) / 32;
__device__ __forceinline__ bool cp_addr(const float* const* in, float* out, int rho, int lane, const f32x4*& src, f32x4*& dst) {
    if (rho >= CP_ROWS_TOTAL) return false;
    int g = 0, kv = 0, rem = rho;
    if (rem >= 2 * NS * 127) { rem -= 2 * NS * 127; g = 1; if (rem >= 2 * NS * 511) { rem -= 2 * NS * 511; g = 2; } }
    const int W = 128 << (2 * g), per = NS * (W - 1);
    if (rem >= per) { rem -= per; kv = 1; }
    const int b = rem / (W - 1), t = rem % (W - 1);
    src = (const f32x4*)in[3 + 2 * g + kv] + ((size_t)b * W + t + 1) * 128 + lane;
    dst = (f32x4*)(out + kv_group_base(g) + 2 * (size_t)W * 512 + (size_t)kv * NS * W * 512) + ((size_t)b * W + t) * 128 + lane;
    return true;
}
struct CopyJob { const float* const* in; float* out; int next; };

__device__ __forceinline__ float rstd_of(const float* part, int row) {
    const f32x4 a = *(const f32x4*)(part + (size_t)row * 4);
    return __builtin_amdgcn_rsqf(((a.x + a.y) + (a.z + a.w)) * (1.0f / D) + EPS);
}
__device__ __forceinline__ float silu_mul(float g, float u) { return g * __builtin_amdgcn_rcpf(1.0f + __expf(-g)) * u; }
__device__ __forceinline__ u32x4 pack8(const f32x4 v0, const f32x4 v1) { u32x4 w; w.x = cvt_pk_bf16(v0[0], v0[1]); w.y = cvt_pk_bf16(v0[2], v0[3]); w.z = cvt_pk_bf16(v1[0], v1[1]); w.w = cvt_pk_bf16(v1[2], v1[3]); return w; }

template <class Derived> struct EpiBase {
    __device__ __forceinline__ void operator()(f32x4 (&acc)[2][2][4][2], const Unit& u, int wr, int wc, int fr, int fq) const {
        const Derived& self = *static_cast<const Derived*>(this);
        const int row0 = u.pm * 256 + wr * 64 + fr;
        float ctx[2][4];
#pragma unroll
        for (int ai = 0; ai < 2; ++ai)
#pragma unroll
            for (int m = 0; m < 4; ++m) ctx[ai][m] = self.pre_row(acc[ai][0][m], acc[ai][1][m], row0 + ai * 128 + m * 16, u.pn, wc, fq);
        __builtin_amdgcn_sched_barrier(0);
#pragma unroll
        for (int ai = 0; ai < 2; ++ai)
#pragma unroll
            for (int m = 0; m < 4; ++m) { const f32x4 v[2][2] = {{acc[ai][0][m][0], acc[ai][0][m][1]}, {acc[ai][1][m][0], acc[ai][1][m][1]}};
                self.row_op(v, row0 + ai * 128 + m * 16, u.pn, wc, fq, ai * 128 + wr * 64 + m * 16 + fr, ctx[ai][m]); }
        self.finish(u.pm, u.pn, 256);
    }
    __device__ __forceinline__ void small(f32x4 (&accS)[2][2][2], int pn, int wc, int fr, int fq, bool active) const {
        const Derived& self = *static_cast<const Derived*>(this);
        if (active) {
            float ctx[2];
#pragma unroll
            for (int m = 0; m < 2; ++m) ctx[m] = self.pre_row(accS[0][m], accS[1][m], S + m * 16 + fr, pn, wc, fq);
            __builtin_amdgcn_sched_barrier(0);
#pragma unroll
            for (int m = 0; m < 2; ++m) { const f32x4 v[2][2] = {{accS[0][m][0], accS[0][m][1]}, {accS[1][m][0], accS[1][m][1]}};
                self.row_op(v, S + m * 16 + fr, pn, wc, fq, m * 16 + fr, ctx[m]); }
        }
        self.finish(64, pn, 32);
    }
    __device__ __forceinline__ void finish(int, int, int) const {}
};

struct EpiGU : EpiBase<EpiGU> {
    rsrc_t act; const float* part; CopyJob* cj;
    __device__ __forceinline__ float pre_row(f32x4 (&)[2], f32x4 (&)[2], int row, int, int, int) const { return rstd_of(part, row); }
    __device__ __forceinline__ u32x4 silu_pack(const f32x4 (&v)[2][2], float rs) const {
        const float c = -1.4426950408889634f * rs, r2 = rs * rs;
        f32x4 o0, o1;
#pragma unroll
        for (int e = 0; e < 4; ++e) { o0[e] = (v[0][0][e] * v[1][0][e]) * (r2 * __builtin_amdgcn_rcpf(1.0f + __builtin_amdgcn_exp2f(v[0][0][e] * c))); o1[e] = (v[0][1][e] * v[1][1][e]) * (r2 * __builtin_amdgcn_rcpf(1.0f + __builtin_amdgcn_exp2f(v[0][1][e] * c))); }
        return pack8(o0, o1);
    }
    __device__ __forceinline__ void row_op(const f32x4 (&v)[2][2], int row, int pn, int wc, int fq, int, float rs) const {
        ST16(act, ((unsigned)row * FF + pn * 128 + wc * 32 + 8 * fq) * 2u, silu_pack(v, rs));
    }
    __device__ __forceinline__ void operator()(f32x4 (&acc)[2][2][4][2], const Unit& u, int wr, int wc, int fr, int fq) const {
        const int row0 = u.pm * 256 + wr * 64 + fr, lane = fr + 16 * fq, wave = wr * 4 + wc;
        float rs[2][4];
#pragma unroll
        for (int ai = 0; ai < 2; ++ai)
#pragma unroll
            for (int m = 0; m < 4; ++m) rs[ai][m] = rstd_of(part, row0 + ai * 128 + m * 16);
        f32x4 cv[4][2]; f32x4* cd[4]; const int chunk = cj->next;
        if (chunk < CP_CHUNKS) {
#pragma unroll
            for (int q = 0; q < 4; ++q) { const f32x4* src; cd[q] = nullptr; if (cp_addr(cj->in, cj->out, chunk * 32 + wave * 4 + q, lane, src, cd[q])) { cv[q][0] = __builtin_nontemporal_load(src); cv[q][1] = __builtin_nontemporal_load(src + 64); } }
        }
        __builtin_amdgcn_sched_barrier(0);
        u32x4 w[2][4];
#pragma unroll
        for (int ai = 0; ai < 2; ++ai)
#pragma unroll
            for (int m = 0; m < 4; ++m) { const f32x4 v[2][2] = {{acc[ai][0][m][0], acc[ai][0][m][1]}, {acc[ai][1][m][0], acc[ai][1][m][1]}}; w[ai][m] = silu_pack(v, rs[ai][m]); }
        __builtin_amdgcn_sched_barrier(0);
        if (chunk < CP_CHUNKS) {
#pragma unroll
            for (int q = 0; q < 4; ++q) if (cd[q]) { __builtin_nontemporal_store(cv[q][0], cd[q]); __builtin_nontemporal_store(cv[q][1], cd[q] + 64); }
            cj->next = chunk + 256;
        }
#pragma unroll
        for (int ai = 0; ai < 2; ++ai)
#pragma unroll
            for (int m = 0; m < 4; ++m) ST16(act, ((unsigned)(row0 + ai * 128 + m * 16) * FF + u.pn * 128 + wc * 32 + 8 * fq) * 2u, w[ai][m]);
    }
};
template <bool LAST> struct EpiRes : EpiBase<EpiRes<LAST>> {
    const bf16_t* xr; rsrc_t xo; rsrc_t xb; rsrc_t part; LAS float* red;
    __device__ __forceinline__ void operator()(f32x4 (&acc)[2][2][4][2], const Unit& u, int wr, int wc, int fr, int fq) const {
        const int row0 = u.pm * 256 + wr * 64 + fr, coff = u.pn * 256 + wc * 32 + 8 * fq;
        u32x4 xn[2][4][2];
#pragma unroll
        for (int ai = 0; ai < 2; ++ai)
#pragma unroll
            for (int m = 0; m < 4; ++m) { const bf16_t* xi = xr + (size_t)(row0 + ai * 128 + m * 16) * D + coff; xn[ai][m][0] = *(const u32x4*)xi; xn[ai][m][1] = *(const u32x4*)(xi + 128); }
        __builtin_amdgcn_sched_barrier(0);
#pragma unroll
        for (int ai = 0; ai < 2; ++ai)
#pragma unroll
            for (int m = 0; m < 4; ++m) {
                f32x4 v[2][2];
#pragma unroll
                for (int bj = 0; bj < 2; ++bj) { const u32x4 t = xn[ai][m][bj];
                    v[bj][0] = acc[ai][bj][m][0] + (f32x4){bflo(t.x), bfhi(t.x), bflo(t.y), bfhi(t.y)}; v[bj][1] = acc[ai][bj][m][1] + (f32x4){bflo(t.z), bfhi(t.z), bflo(t.w), bfhi(t.w)}; }
                row_op(v, row0 + ai * 128 + m * 16, u.pn, wc, fq, ai * 128 + wr * 64 + m * 16 + fr, 0.f);
            }
        finish(u.pm, u.pn, 256);
    }
    __device__ __forceinline__ float pre_row(f32x4 (&a0)[2], f32x4 (&a1)[2], int row, int pn, int wc, int fq) const {
        const bf16_t* xi = xr + (size_t)row * D + pn * 256 + wc * 32 + 8 * fq;
        const u32x4 t0 = *(const u32x4*)xi, t1 = *(const u32x4*)(xi + 128);
        a0[0] += (f32x4){bflo(t0.x), bfhi(t0.x), bflo(t0.y), bfhi(t0.y)}; a0[1] += (f32x4){bflo(t0.z), bfhi(t0.z), bflo(t0.w), bfhi(t0.w)};
        a1[0] += (f32x4){bflo(t1.x), bfhi(t1.x), bflo(t1.y), bfhi(t1.y)}; a1[1] += (f32x4){bflo(t1.z), bfhi(t1.z), bflo(t1.w), bfhi(t1.w)};
        return 0.f;
    }
    __device__ __forceinline__ void row_op(const f32x4 (&v)[2][2], int row, int pn, int wc, int fq, int lrow, float) const {
        const int col0 = pn * 256 + wc * 32 + 8 * fq;
        float ss = 0.f;
#pragma unroll
        for (int bj = 0; bj < 2; ++bj) {
            const f32x4 v0 = v[bj][0], v1 = v[bj][1];
            ss += (v0[0] * v0[0] + v0[1] * v0[1]) + (v0[2] * v0[2] + v0[3] * v0[3]) + (v1[0] * v1[0] + v1[1] * v1[1]) + (v1[2] * v1[2] + v1[3] * v1[3]);
            if (LAST) { const unsigned o = ((unsigned)row * D + col0 + bj * 128) * 4u; ST16(xo, o, F4U(v0)); ST16(xo, o + 16u, F4U(v1)); }
            else ST16(xb, ((unsigned)row * D + col0 + bj * 128) * 2u, pack8(v0, v1));
        }
        ss += __shfl_xor(ss, 16); ss += __shfl_xor(ss, 32);
        if (fq == 0) red[lrow * 4 + wc] = ss;
    }
    __device__ __forceinline__ void finish(int pm, int pn, int nrows) const {
        asm volatile("s_waitcnt lgkmcnt(0)" ::: "memory"); __builtin_amdgcn_s_barrier(); asm volatile("" ::: "memory");
        if ((int)threadIdx.x < nrows) { const f32x4 v = *(const LAS f32x4*)(red + threadIdx.x * 4); ST4(part, ((unsigned)(pm * 256 + threadIdx.x) * 4 + pn) * 4u, __builtin_bit_cast(unsigned, (v.x + v.y) + (v.z + v.w))); }
    }
};
struct EpiU : EpiBase<EpiU> {
    rsrc_t ub; const float* part; float* psp; float* pss;
    __device__ __forceinline__ float pre_row(f32x4 (&)[2], f32x4 (&)[2], int row, int, int, int) const { return rstd_of(part, row); }
    __device__ __forceinline__ void row_op(const f32x4 (&v)[2][2], int row, int pn, int wc, int fq, int, float rs) const {
        const int col0 = pn * 256 + wc * 32 + 8 * fq;
        float* po = nullptr;
        if (row >= S - 15 && row < S) po = psp + (size_t)(row - (S - 15)) * D; else if (row >= S && row < MV) po = pss + ((size_t)(row - S) * 15 + 14) * D;
#pragma unroll
        for (int bj = 0; bj < 2; ++bj) {
            const f32x4 v0 = v[bj][0] * rs, v1 = v[bj][1] * rs;
            ST16(ub, ((unsigned)row * D + col0 + bj * 128) * 2u, pack8(v0, v1));
            if (po) { *(f32x4*)(po + col0 + bj * 128) = v0; *(f32x4*)(po + col0 + bj * 128 + 4) = v1; }
        }
    }
};
struct EpiPlain : EpiBase<EpiPlain> {
    rsrc_t o;
    __device__ __forceinline__ float pre_row(f32x4 (&)[2], f32x4 (&)[2], int, int, int, int) const { return 0.f; }
    __device__ __forceinline__ void row_op(const f32x4 (&v)[2][2], int row, int pn, int wc, int fq, int, float) const {
        const int col0 = pn * 256 + wc * 32 + 8 * fq;
#pragma unroll
        for (int bj = 0; bj < 2; ++bj) ST16(o, ((unsigned)row * D + col0 + bj * 128) * 2u, pack8(v[bj][0], v[bj][1]));
    }
};
struct EpiQK : EpiBase<EpiQK> {
    rsrc_t qk; const float* part; float* out; rsrc_t vnew;
    __device__ __forceinline__ float pre_row(f32x4 (&)[2], f32x4 (&)[2], int row, int, int, int) const { return rstd_of(part, row); }
    __device__ __forceinline__ void row_op(const f32x4 (&v)[2][2], int row, int pn, int wc, int fq, int, float rs) const {
        const int colt = pn * 256, cw = wc * 32 + 8 * fq;
        const bool isv = colt >= 3072;
        const int g = isv ? (colt - 3072) / 512 : colt / 1024, s = isv ? 2 : (colt % 1024) / 512;
        const int W = 128 << (2 * g);
        const size_t gb = kv_group_base(g);
        const size_t o_p = gb, o_s = gb + 2 * (size_t)W * 512 + (isv ? (size_t)NS * W * 512 : 0);
        float* po = nullptr;
        if (s != 0) { if (row >= S - W && row < S) po = out + o_p + (size_t)(row - (S - W)) * 512; else if (row >= S && row < MV) po = out + o_s + ((size_t)(row - S) * W + (W - 1)) * 512; }
#pragma unroll
        for (int bj = 0; bj < 2; ++bj) {
            const f32x4 v0 = v[bj][0] * rs, v1 = v[bj][1] * rs;
            if (!isv) ST16(qk, ((unsigned)row * 3072 + colt + cw + bj * 128) * 2u, pack8(v0, v1));
            else ST16(vnew, ((unsigned)(row - S) * 1536 + (colt - 3072) + cw + bj * 128) * 2u, pack8(v0, v1));
            if (po) { const int he = (colt + cw + bj * 128) % 512; *(f32x4*)(po + he) = v0; *(f32x4*)(po + he + 4) = v1; }
        }
    }
};
struct EpiVT {
    rsrc_t vTg; const float* part; float* out; int g, d;
    __device__ __forceinline__ void operator()(f32x4 (&acc)[2][2][4][2], const Unit& u, int wr, int wc, int fr, int fq) const {
        const int dim0 = u.pm * 256 + wr * 64 + fr;
        const int W = 128 << (2 * g), q = 256 / d;
        const size_t o_p = kv_group_base(g) + (size_t)W * 512;
        const bool tail = (u.pn * 256 + 255 >= S - W);
        float rsa[2][8];
#pragma unroll
        for (int bj = 0; bj < 2; ++bj) { const int v0 = 128 * bj + 32 * wc + 8 * fq, r = v0 / q, ii0 = v0 % q, tok0 = u.pn * 256 + ii0 * d + r;
#pragma unroll
            for (int e = 0; e < 8; ++e) rsa[bj][e] = rstd_of(part, tok0 + e * d);
            __builtin_amdgcn_sched_barrier(0); }
#pragma unroll
        for (int bj = 0; bj < 2; ++bj) {
            const int v0 = 128 * bj + 32 * wc + 8 * fq, r = v0 / q, ii0 = v0 % q;
            const int tok0 = u.pn * 256 + ii0 * d + r;
            float rs[8];
#pragma unroll
            for (int e = 0; e < 8; ++e) rs[e] = rsa[bj][e];
            const size_t sidx = (size_t)r * (S / d) + (size_t)(u.pn * 256) / d + ii0;
            const unsigned vp = (unsigned)(((size_t)dim0 * MPV + 128 + sidx) * 2);
#pragma unroll
            for (int ai = 0; ai < 2; ++ai)
#pragma unroll
                for (int m = 0; m < 4; ++m) {
                    const f32x4 a0 = acc[ai][bj][m][0], a1 = acc[ai][bj][m][1];
                    u32x4 w; w.x = cvt_pk_bf16(a0[0] * rs[0], a0[1] * rs[1]); w.y = cvt_pk_bf16(a0[2] * rs[2], a0[3] * rs[3]); w.z = cvt_pk_bf16(a1[0] * rs[4], a1[1] * rs[5]); w.w = cvt_pk_bf16(a1[2] * rs[6], a1[3] * rs[7]);
                    ST16(vTg, vp + (unsigned)(ai * 128 + m * 16) * (unsigned)(MPV * 2), w);
                    asm volatile("" ::: "memory");
                }
            if (tail) {
#pragma unroll
                for (int e = 0; e < 8; ++e) { const int t = tok0 + e * d;
                    if (t >= S - W) { float* po = out + o_p + (size_t)(t - (S - W)) * 512 + dim0;
#pragma unroll
                        for (int ai = 0; ai < 2; ++ai)
#pragma unroll
                            for (int m = 0; m < 4; ++m) po[ai * 128 + m * 16] = acc[ai][bj][m][e >> 2][e & 3] * rs[e]; }
                    asm volatile("" ::: "memory"); }
            }
        }
    }
};

template <class Epi>
__device__ __forceinline__ void skinny_unit(LAS unsigned char* lds, const pg8::Gemm g, int pn, const Epi& E) {
    int tid = threadIdx.x; asm volatile("" : "+v"(tid));
    const int wid = __builtin_amdgcn_readfirstlane(tid >> 6), lane = tid & 63, kh = wid >> 2, wc = wid & 3, fr = lane & 15, fq = lane >> 4;
    const int Kh = g.K / 2;
    const bf16_t* ap = g.A + (size_t)(S + fr) * g.lda + (size_t)pn * g.a_pn + kh * Kh + 8 * fq;
    const bf16_t* bp = g.Bt + (size_t)(pn * 256 + wc * 32 + 8 * (fr >> 2) + (fr & 3)) * g.ldb + kh * Kh + 8 * fq;
    f32x4 acc[2][2][2];
#pragma unroll
    for (int a = 0; a < 2; ++a)
#pragma unroll
        for (int b = 0; b < 2; ++b)
#pragma unroll
            for (int c = 0; c < 2; ++c) acc[a][b][c] = (f32x4){0.f, 0.f, 0.f, 0.f};
#pragma unroll 4
    for (int k0 = 0; k0 < Kh; k0 += 32) {
        bf16x8 af[2], bf[2][2];
#pragma unroll
        for (int m = 0; m < 2; ++m) af[m] = *(const bf16x8*)(ap + (size_t)(16 * m) * g.lda + k0);
#pragma unroll
        for (int bj = 0; bj < 2; ++bj)
#pragma unroll
            for (int n = 0; n < 2; ++n) bf[bj][n] = *(const bf16x8*)(bp + (size_t)(128 * bj + 4 * n) * g.ldb + k0);
#pragma unroll
        for (int bj = 0; bj < 2; ++bj)
#pragma unroll
            for (int m = 0; m < 2; ++m)
#pragma unroll
                for (int n = 0; n < 2; ++n) acc[bj][m][n] = __builtin_amdgcn_mfma_f32_16x16x32_bf16(bf[bj][n], af[m], acc[bj][m][n], 0, 0, 0);
    }
    LAS f32x4* xs = (LAS f32x4*)lds + (wc * 64 + lane) * 8;
    __syncthreads();
    if (kh == 1) {
#pragma unroll
        for (int bj = 0; bj < 2; ++bj)
#pragma unroll
            for (int m = 0; m < 2; ++m)
#pragma unroll
                for (int n = 0; n < 2; ++n) xs[(bj * 2 + m) * 2 + n] = acc[bj][m][n];
    }
    __syncthreads();
    if (kh == 0) {
#pragma unroll
        for (int bj = 0; bj < 2; ++bj)
#pragma unroll
            for (int m = 0; m < 2; ++m)
#pragma unroll
                for (int n = 0; n < 2; ++n) acc[bj][m][n] += xs[(bj * 2 + m) * 2 + n];
    }
    E.small(acc, pn, wc, fr, fq, kh == 0);
}

typedef float f32x16 __attribute__((ext_vector_type(16)));
typedef __bf16 bf16v2 __attribute__((ext_vector_type(2)));
#define MFMA32(a, b, c) __builtin_amdgcn_mfma_f32_32x32x16_bf16((a), (b), (c), 0, 0, 0)
__device__ __forceinline__ unsigned cvt2(float a, float b) { const f32x2 v = {a, b}; return __builtin_bit_cast(unsigned, __builtin_convertvector(v, bf16v2)); }

template <int GI>
__device__ __forceinline__ void attn_job(const bf16_t* qk, const bf16_t* vTg, const LAS float* biasL, bf16_t* act, rsrc_t ob, int h, int r, int i0, int lane,
                                         const LAS unsigned char* lk = nullptr, const LAS unsigned char* lv = nullptr, int kl0 = 0) {
    constexpr int d = 1 << (2 * GI), SD = S / d;
    int r16 = lane & 15, g = lane >> 4;
    asm volatile("" : "+v"(r16), "+v"(g));
    bf16x8 qf[2][2];
#pragma unroll
    for (int qt = 0; qt < 2; ++qt) { const bf16_t* qp = qk + (size_t)((i0 + 16 * qt + r16) * d + r) * 3072 + GI * 1024 + h * 64 + 8 * g;
#pragma unroll
        for (int ks = 0; ks < 2; ++ks) qf[qt][ks] = __builtin_nontemporal_load((const bf16x8*)(qp + 32 * ks)); }
    f32x4 st[5][2][2];
    if constexpr (GI == 0) {
#pragma unroll
        for (int kb = 0; kb < 5; ++kb)
#pragma unroll
            for (int T = 0; T < 2; ++T) { const int kl = kl0 + 32 * kb + 8 * (r16 >> 2) + 4 * T + (r16 & 3); const LAS unsigned char* kp = lk + kl * 128; const int sw = (kl >> 1) & 7;
                const bf16x8 k0 = *(const LAS bf16x8*)(kp + ((g ^ sw) << 4)), k1 = *(const LAS bf16x8*)(kp + (((g + 4) ^ sw) << 4));
#pragma unroll
                for (int qt = 0; qt < 2; ++qt) { f32x4 a = {0.f, 0.f, 0.f, 0.f};
                    a = __builtin_amdgcn_mfma_f32_16x16x32_bf16(k0, qf[qt][0], a, 0, 0, 0); a = __builtin_amdgcn_mfma_f32_16x16x32_bf16(k1, qf[qt][1], a, 0, 0, 0); st[kb][T][qt] = a; } }
    } else {
    bf16x8 kf[5][2][2];
#pragma unroll
    for (int kb = 0; kb < 5; ++kb)
#pragma unroll
        for (int T = 0; T < 2; ++T) {
            int ik = i0 - 128 + 32 * kb + 8 * (r16 >> 2) + 4 * T + (r16 & 3); ik = ik < 0 ? 0 : ik;
            const bf16_t* kp = qk + (size_t)(ik * d + r) * 3072 + GI * 1024 + 512 + h * 64 + 8 * g;
            kf[kb][T][0] = *(const bf16x8*)kp; kf[kb][T][1] = *(const bf16x8*)(kp + 32);
        }
    __builtin_amdgcn_sched_barrier(0);
#pragma unroll
    for (int kb = 0; kb < 5; ++kb)
#pragma unroll
        for (int T = 0; T < 2; ++T)
#pragma unroll
            for (int qt = 0; qt < 2; ++qt) { f32x4 a = {0.f, 0.f, 0.f, 0.f};
                a = __builtin_amdgcn_mfma_f32_16x16x32_bf16(kf[kb][T][0], qf[qt][0], a, 0, 0, 0); a = __builtin_amdgcn_mfma_f32_16x16x32_bf16(kf[kb][T][1], qf[qt][1], a, 0, 0, 0); st[kb][T][qt] = a; }
    }
    const bf16_t* vbase = vTg + (size_t)(h * 64 + r16) * MPV + 128 + (r * SD + i0 - 128 + 8 * g);
    bf16x8 vf[5][4];
#pragma unroll
    for (int kb = 0; kb < 5; ++kb)
#pragma unroll
        for (int dt = 0; dt < 4; ++dt) { if constexpr (GI != 0) vf[kb][dt] = *(const bf16x8*)(vbase + (size_t)dt * 16 * MPV + 32 * kb); }
    __builtin_amdgcn_sched_barrier(0);
    float mx[2] = {-1e30f, -1e30f};
    const LAS float* bl = biasL + (r16 - 8 * g);
#pragma unroll
    for (int kb = 0; kb < 5; ++kb)
#pragma unroll
        for (int T = 0; T < 2; ++T)
#pragma unroll
            for (int qt = 0; qt < 2; ++qt)
#pragma unroll
                for (int i = 0; i < 4; ++i) {
                    const int jc0 = 128 - 32 * kb + 16 * qt - 4 * T - i;
                    if (kb >= 1 && kb <= 3) st[kb][T][qt][i] += bl[jc0];
                    else { const int jo = jc0 + r16 - 8 * g; const int jc = jo < 0 ? 0 : (jo > 128 ? 128 : jo); st[kb][T][qt][i] += biasL[jc]; }
                }
    __builtin_amdgcn_sched_barrier(0);
#pragma unroll
    for (int T = 0; T < 2; ++T)
#pragma unroll
        for (int qt = 0; qt < 2; ++qt)
#pragma unroll
            for (int i = 0; i < 4; ++i) {
                const int j0 = 128 + 16 * qt + r16 - 8 * g - 4 * T - i, j4 = j0 - 128;
                st[0][T][qt][i] = (j0 <= 128) ? st[0][T][qt][i] : -1e30f;
                st[4][T][qt][i] = (j4 >= 0) ? st[4][T][qt][i] : -1e30f;
            }
    if (i0 < 128) {
#pragma unroll
        for (int kb = 0; kb < 4; ++kb)
#pragma unroll
            for (int T = 0; T < 2; ++T)
#pragma unroll
                for (int qt = 0; qt < 2; ++qt)
#pragma unroll
                    for (int i = 0; i < 4; ++i) { const int ik = i0 - 128 + 32 * kb + 8 * g + 4 * T + i; st[kb][T][qt][i] = (ik >= 0) ? st[kb][T][qt][i] : -1e30f; }
    }
#pragma unroll
    for (int kb = 0; kb < 5; ++kb)
#pragma unroll
        for (int T = 0; T < 2; ++T)
#pragma unroll
            for (int qt = 0; qt < 2; ++qt)
#pragma unroll
                for (int i = 0; i < 4; ++i) mx[qt] = fmaxf(mx[qt], st[kb][T][qt][i]);
    float sum[2];
#pragma unroll
    for (int qt = 0; qt < 2; ++qt) { mx[qt] = fmaxf(mx[qt], __shfl_xor(mx[qt], 16)); mx[qt] = fmaxf(mx[qt], __shfl_xor(mx[qt], 32)); sum[qt] = 0.f; }
#pragma unroll
    for (int kb = 0; kb < 5; ++kb)
#pragma unroll
        for (int T = 0; T < 2; ++T)
#pragma unroll
            for (int qt = 0; qt < 2; ++qt)
#pragma unroll
                for (int i = 0; i < 4; ++i) { const float p = __builtin_amdgcn_exp2f(st[kb][T][qt][i] - mx[qt]); st[kb][T][qt][i] = p; sum[qt] += p; }
#pragma unroll
    for (int qt = 0; qt < 2; ++qt) { sum[qt] += __shfl_xor(sum[qt], 16); sum[qt] += __shfl_xor(sum[qt], 32); }
    f32x4 oa[4][2];
#pragma unroll
    for (int dt = 0; dt < 4; ++dt)
#pragma unroll
        for (int qt = 0; qt < 2; ++qt) oa[dt][qt] = (f32x4){0.f, 0.f, 0.f, 0.f};
#pragma unroll
    for (int kb = 0; kb < 5; ++kb) {
        bf16x8 pf[2];
#pragma unroll
        for (int qt = 0; qt < 2; ++qt) { u32x4 pw; pw.x = cvt2(st[kb][0][qt][0], st[kb][0][qt][1]); pw.y = cvt2(st[kb][0][qt][2], st[kb][0][qt][3]); pw.z = cvt2(st[kb][1][qt][0], st[kb][1][qt][1]); pw.w = cvt2(st[kb][1][qt][2], st[kb][1][qt][3]);
            pf[qt] = __builtin_bit_cast(bf16x8, pw); }
#pragma unroll
        for (int dt = 0; dt < 4; ++dt)
#pragma unroll
            for (int qt = 0; qt < 2; ++qt) {
                if constexpr (GI == 0) { if (qt == 0) vf[kb][dt] = *(const LAS bf16x8*)(lv + (16 * dt + r16) * 768 + ((((kl0 >> 3) + 4 * kb + g) ^ r16) << 4)); }
                oa[dt][qt] = __builtin_amdgcn_mfma_f32_16x16x32_bf16(vf[kb][dt], pf[qt], oa[dt][qt], 0, 0, 0); }
    }
#pragma unroll
    for (int qt = 0; qt < 2; ++qt) {
        const int tq = (i0 + 16 * qt + r16) * d + r;
        const float inv = 1.0f / sum[qt], lse = mx[qt] + __log2f(sum[qt]);
        float* scr = (float*)(act + (size_t)tq * FF);
        bf16_t* scb = act + (size_t)tq * FF;
        if (GI > 0) {
#pragma unroll
            for (int dt = 0; dt < 4; ++dt) { const f32x4 v = oa[dt][qt] * inv; u32x2 w; w.x = cvt2(v[0], v[1]); w.y = cvt2(v[2], v[3]); *(u32x2*)(scb + (GI - 1) * 512 + h * 64 + 16 * dt + 4 * g) = w; }
            if (g == 0) scr[1024 + (GI - 1) * 8 + h] = lse;
        } else {
            const float l1 = scr[1024 + h], l2 = scr[1024 + 8 + h];
            f32x4 o1[4], o2[4];
#pragma unroll
            for (int dt = 0; dt < 4; ++dt) { const int dim0 = h * 64 + 16 * dt + 4 * g; const u32x2 p1 = *(const u32x2*)(scb + dim0), p2 = *(const u32x2*)(scb + 512 + dim0);
                o1[dt] = (f32x4){bflo(p1.x), bfhi(p1.x), bflo(p1.y), bfhi(p1.y)}; o2[dt] = (f32x4){bflo(p2.x), bfhi(p2.x), bflo(p2.y), bfhi(p2.y)}; }
            const float mm = fmaxf(fmaxf(lse, l1), l2);
            const float w0 = __builtin_amdgcn_exp2f(lse - mm), w1 = __builtin_amdgcn_exp2f(l1 - mm), w2 = __builtin_amdgcn_exp2f(l2 - mm), iw = 1.0f / (w0 + w1 + w2);
            const float a0 = w0 * inv * iw, a1 = w1 * iw, a2 = w2 * iw;
#pragma unroll
            for (int dt = 0; dt < 4; ++dt) { const int dim0 = h * 64 + 16 * dt + 4 * g; const f32x4 v = oa[dt][qt] * a0 + o1[dt] * a1 + o2[dt] * a2;
                u32x2 w; w.x = cvt2(v[0], v[1]); w.y = cvt2(v[2], v[3]);
                ST8(ob, ((unsigned)tq * 512 + dim0) * 2u, w); }
        }
    }
}
__device__ __forceinline__ float wave_sum(float v) {
#pragma unroll
    for (int o = 1; o < 64; o <<= 1) v += __shfl_xor(v, o);
    return v;
}
__device__ __forceinline__ float wave_max(float v) {
#pragma unroll
    for (int o = 1; o < 64; o <<= 1) v = fmaxf(v, __shfl_xor(v, o));
    return v;
}
__device__ __forceinline__ void sample_attn_group(int g, int b, int h, const bf16_t* qk, const bf16_t* vnew, const float* ck, const float* cv, const float* biasT, LAS float* smp, int lane) {
    const int d = 1 << (2 * g), W = 128 << (2 * g), row = S + b, kq = lane >> 3, dc = lane & 7;
    float q[64];
    { const u32x4* qp = (const u32x4*)(qk + (size_t)row * 3072 + g * 1024 + h * 64);
#pragma unroll
      for (int c = 0; c < 8; ++c) { const u32x4 t = qp[c]; q[8 * c] = bflo(t.x); q[8 * c + 1] = bfhi(t.x); q[8 * c + 2] = bflo(t.y); q[8 * c + 3] = bfhi(t.y); q[8 * c + 4] = bflo(t.z); q[8 * c + 5] = bfhi(t.z); q[8 * c + 6] = bflo(t.w); q[8 * c + 7] = bfhi(t.w); } }
    float sc[3];
#pragma unroll
    for (int rnd = 0; rnd < 3; ++rnd) {
        const int j = lane + 64 * rnd; float s = -1e30f;
        if (j <= 128) { float a = 0.f;
            if (j == 0) { const u32x4* kp = (const u32x4*)(qk + (size_t)row * 3072 + g * 1024 + 512 + h * 64);
#pragma unroll
                for (int c = 0; c < 8; ++c) { const u32x4 t = kp[c]; a += q[8 * c] * bflo(t.x) + q[8 * c + 1] * bfhi(t.x) + q[8 * c + 2] * bflo(t.y) + q[8 * c + 3] * bfhi(t.y) + q[8 * c + 4] * bflo(t.z) + q[8 * c + 5] * bfhi(t.z) + q[8 * c + 6] * bflo(t.w) + q[8 * c + 7] * bfhi(t.w); } }
            else { const f32x4* kp = (const f32x4*)(ck + (((size_t)b * W + (W - j * d)) * 8 + h) * 64);
#pragma unroll
                for (int c = 0; c < 16; ++c) { const f32x4 t = __builtin_nontemporal_load(kp + c); a += q[4 * c] * t.x + q[4 * c + 1] * t.y + q[4 * c + 2] * t.z + q[4 * c + 3] * t.w; } }
            s = a + biasT[(g * 8 + h) * 132 + j]; }
        sc[rnd] = s;
    }
    const float mx = wave_max(fmaxf(fmaxf(sc[0], sc[1]), sc[2]));
    float p[3]; float sum = 0.f;
#pragma unroll
    for (int rnd = 0; rnd < 3; ++rnd) { p[rnd] = (sc[rnd] > -1e29f) ? __builtin_amdgcn_exp2f(sc[rnd] - mx) : 0.f; sum += p[rnd]; }
    sum = wave_sum(sum);
    const float inv = 1.0f / sum;
    float o[8] = {0.f, 0.f, 0.f, 0.f, 0.f, 0.f, 0.f, 0.f};
#pragma unroll
    for (int i = 0; i < 17; ++i) {
        const int j = kq + 8 * i, src = j & 63, rnd = j >> 6;
        const float p0 = __shfl(p[0], src), p1 = __shfl(p[1], src), p2 = __shfl(p[2], src);
        const float pj = (rnd == 0) ? p0 : ((rnd == 1) ? p1 : p2);
        if (j <= 128) {
            if (j == 0) { const u32x4 t = *(const u32x4*)(vnew + (size_t)b * 1536 + g * 512 + h * 64 + 8 * dc);
                o[0] += pj * bflo(t.x); o[1] += pj * bfhi(t.x); o[2] += pj * bflo(t.y); o[3] += pj * bfhi(t.y); o[4] += pj * bflo(t.z); o[5] += pj * bfhi(t.z); o[6] += pj * bflo(t.w); o[7] += pj * bfhi(t.w); }
            else { const f32x4* vp = (const f32x4*)(cv + (((size_t)b * W + (W - j * d)) * 8 + h) * 64 + 8 * dc); const f32x4 t0 = __builtin_nontemporal_load(vp), t1 = __builtin_nontemporal_load(vp + 1);
                o[0] += pj * t0.x; o[1] += pj * t0.y; o[2] += pj * t0.z; o[3] += pj * t0.w; o[4] += pj * t1.x; o[5] += pj * t1.y; o[6] += pj * t1.z; o[7] += pj * t1.w; }
        }
    }
#pragma unroll
    for (int e = 0; e < 8; ++e) { float v = o[e]; v += __shfl_xor(v, 8); v += __shfl_xor(v, 16); v += __shfl_xor(v, 32); if (kq == 0) smp[g * 72 + 8 * dc + e] = v * inv; }
    if (lane == 0) smp[g * 72 + 64] = mx + __log2f(sum);
}

template <int W>
__device__ __forceinline__ void pool_strip(const bf16_t* ub, const float* state_pool, rsrc_t rs_z, int r0, int ch) {
    if (r0 < S) {
        u32x4 raw[16 + W - 1];
#pragma unroll
        for (int i = 0; i < 16 + W - 1; ++i) { const int row = r0 - (W - 1) + i; raw[i] = (row >= 0) ? *(const u32x4*)(ub + (size_t)row * D + ch) : (u32x4){0u, 0u, 0u, 0u}; }
        float run[8] = {0.f, 0.f, 0.f, 0.f, 0.f, 0.f, 0.f, 0.f};
#pragma unroll
        for (int i = 0; i < W - 1; ++i) { run[0] += bflo(raw[i].x); run[1] += bfhi(raw[i].x); run[2] += bflo(raw[i].y); run[3] += bfhi(raw[i].y); run[4] += bflo(raw[i].z); run[5] += bfhi(raw[i].z); run[6] += bflo(raw[i].w); run[7] += bfhi(raw[i].w); }
#pragma unroll
        for (int i = 0; i < 16; ++i) {
            const u32x4 c = raw[i + W - 1]; const float cv[8] = {bflo(c.x), bfhi(c.x), bflo(c.y), bfhi(c.y), bflo(c.z), bfhi(c.z), bflo(c.w), bfhi(c.w)};
#pragma unroll
            for (int e = 0; e < 8; ++e) run[e] += cv[e];
            const int row = r0 + i; const float ic = 1.0f / (float)(W < row + 1 ? W : row + 1);
            u32x4 o; o.x = pk2(run[0] * ic - cv[0], run[1] * ic - cv[1]); o.y = pk2(run[2] * ic - cv[2], run[3] * ic - cv[3]); o.z = pk2(run[4] * ic - cv[4], run[5] * ic - cv[5]); o.w = pk2(run[6] * ic - cv[6], run[7] * ic - cv[7]);
            ST16(rs_z, ((unsigned)row * D + ch) * 2u, o);
            const u32x4 l = raw[i];
            run[0] -= bflo(l.x); run[1] -= bfhi(l.x); run[2] -= bflo(l.y); run[3] -= bfhi(l.y); run[4] -= bflo(l.z); run[5] -= bfhi(l.z); run[6] -= bflo(l.w); run[7] -= bfhi(l.w);
        }
    } else {
#pragma nounroll
        for (int i = 0; i < 16; ++i) {
            const int row = r0 + i; u32x4 o = {0u, 0u, 0u, 0u};
            if (row < MV) {
                const u32x4 c = *(const u32x4*)(ub + (size_t)row * D + ch); const float cv[8] = {bflo(c.x), bfhi(c.x), bflo(c.y), bfhi(c.y), bflo(c.z), bfhi(c.z), bflo(c.w), bfhi(c.w)};
                float a[8];
#pragma unroll
                for (int e = 0; e < 8; ++e) a[e] = cv[e];
                const float* sp = state_pool + (size_t)(row - S) * 15 * D + ch;
#pragma unroll
                for (int k = 1; k < W; ++k) { const f32x4 p0 = *(const f32x4*)(sp + (size_t)(15 - k) * D), p1 = *(const f32x4*)(sp + (size_t)(15 - k) * D + 4);
                    a[0] += p0.x; a[1] += p0.y; a[2] += p0.z; a[3] += p0.w; a[4] += p1.x; a[5] += p1.y; a[6] += p1.z; a[7] += p1.w; }
                const float ic = 1.0f / (float)W;
                o.x = pk2(a[0] * ic - cv[0], a[1] * ic - cv[1]); o.y = pk2(a[2] * ic - cv[2], a[3] * ic - cv[3]); o.z = pk2(a[4] * ic - cv[4], a[5] * ic - cv[5]); o.w = pk2(a[6] * ic - cv[6], a[7] * ic - cv[7]);
            }
            ST16(rs_z, ((unsigned)row * D + ch) * 2u, o);
        }
    }
}

struct Args { const float* in[26]; float* out; unsigned char* ws; };
enum { PH_GU0 = 0, PH_D0, PH_WIN, PH_POOL, PH_GRP, PH_WPO, PH_GU1, PH_D1, PH_GU2, PH_D2, PH_QKV, PH_ATT, PH_WAO, PH_GU3, PH_D3, NPHC };

constexpr int NWAVES = 8, NTHR = 512;
constexpr int LDS_BYTES = 147456;

__device__ __forceinline__ void tr_item(const float* W, int ldw, int k0, int n0, bf16_t* dst, int ldd, const float* kscale, const float* nscale, float f, LAS float* scr, int lane) {
    const rsrc_t rs = mkrs(dst, (size_t)1 << 30);
    float tv[32];
#pragma unroll
    for (int i = 0; i < 32; ++i) { const int kk = 2 * i + (lane >> 5); tv[i] = __builtin_nontemporal_load(W + (size_t)(k0 + kk) * ldw + n0 + (lane & 31)); }
#pragma unroll
    for (int i = 0; i < 32; ++i) { const int kk = 2 * i + (lane >> 5); float v = tv[i]; if (kscale) v *= kscale[k0 + kk]; scr[kk * 33 + (lane & 31)] = v; }
    LDS_WAIT(); asm volatile("" ::: "memory");
    const int c = lane & 7;
#pragma unroll
    for (int j = 0; j < 4; ++j) { const int n = (lane >> 3) + 8 * j; const LAS float* s = scr + (8 * c) * 33 + n; const float fn = nscale ? f * nscale[n0 + n] : f;
        u32x4 o; o.x = pk2(s[0 * 33] * fn, s[1 * 33] * fn); o.y = pk2(s[2 * 33] * fn, s[3 * 33] * fn); o.z = pk2(s[4 * 33] * fn, s[5 * 33] * fn); o.w = pk2(s[6 * 33] * fn, s[7 * 33] * fn);
        ST16(rs, (unsigned)(n * ldd + k0 + 8 * c) * 2u, o); }
    LDS_WAIT(); asm volatile("" ::: "memory");
}
__device__ __forceinline__ int t5_bucket(int dist) {
    if (dist < 16) return dist;
    const int b = 16 + (int)(log((double)dist / 16.0) / log(128.0) * 16.0);
    return b < 31 ? b : 31;
}

#ifndef PM
#define PM 0xffffff
#endif
#define ON(k) if ((PM >> (k)) & 1)
__global__ void __launch_bounds__(NTHR, 2) fwd_kernel(Args args) {
    extern __shared__ __attribute__((aligned(16))) unsigned char lds_raw[];
    LAS unsigned char* lds = (LAS unsigned char*)lds_raw;
    const int tid = threadIdx.x, lane = tid & 63, wave = __builtin_amdgcn_readfirstlane(tid >> 6);
    const int G = gridDim.x, bx = blockIdx.x;
    const int gw = bx * NWAVES + wave, NGW = G * NWAVES;
    const size_t gt = (size_t)bx * NTHR + tid, NGT = (size_t)G * NTHR;
    unsigned char* ws = args.ws; float* out = args.out;
    bf16_t* Wgu = (bf16_t*)(ws + WS_WGU); bf16_t* Wd = (bf16_t*)(ws + WS_WD); bf16_t* Win = (bf16_t*)(ws + WS_WIN); bf16_t* Wgrp = (bf16_t*)(ws + WS_WGRP);
    bf16_t* Wpo = (bf16_t*)(ws + WS_WPO); bf16_t* Wqkv = (bf16_t*)(ws + WS_WQKV); bf16_t* Wao = (bf16_t*)(ws + WS_WAO);
    float* biasT = (float*)(ws + WS_BIAS); float* part = (float*)(ws + WS_PART);
    bf16_t* xb = (bf16_t*)(ws + WS_XB); bf16_t* act = (bf16_t*)(ws + WS_ACT);
    bf16_t* ub = (bf16_t*)(ws + WS_U); bf16_t* zb = (bf16_t*)(ws + WS_Z); bf16_t* z2b = (bf16_t*)(ws + WS_Z2); bf16_t* qk = (bf16_t*)(ws + WS_QK); bf16_t* vT = (bf16_t*)(ws + WS_VT); bf16_t* ob = (bf16_t*)(ws + WS_O); bf16_t* vnew = (bf16_t*)(ws + WS_VNEW);
    const float* x_prompt = args.in[0]; const float* x_sample = args.in[1]; const float* state_pool = args.in[2];
    cg::grid_group grid = cg::this_grid();
    unsigned* ctl = (unsigned*)(ws + WS_CTL);
#define CNT(ph) (ctl + (size_t)(ph) * 72 * 64)
    constexpr size_t QOFF = (size_t)NPHC * 72 * 64 + 1024, QWORDS = (size_t)48 * 8 * 64;

    constexpr int I_GU = 16 * 88, I_D = 44 * 32, I_IN = 16 * 32, I_GRP = 4 * 8, I_QKV = 16 * 144, I_AO = 8 * 32;
#define TR_SCR ((LAS float*)(lds + wave * 16384))
#define CV_FOR(q, OFF_, CNT_) for (int q = gw - (OFF_) + (gw < (OFF_) ? NGW : 0); q < (CNT_); q += NGW)
#define CV_GU(f_, OFF_) CV_FOR(q2, OFF_, 2 * I_GU) { const int f = (f_), up = q2 / I_GU, q = q2 % I_GU, kb = q / 88, nb = q % 88, n0 = nb * 32, layer = f >> 1, second = f & 1; \
        tr_item(args.in[(second ? 22 : 10) + up] + (size_t)layer * D * FF, FF, kb * 64, n0, Wgu + (size_t)f * 2 * FF * D + (size_t)((n0 / 128) * 256 + (n0 % 128) + up * 128) * D, D, \
                args.in[second ? 21 : 9] + layer * D, nullptr, 1.0f, TR_SCR, lane_c); }
#define CV_D(f_, OFF_) CV_FOR(q, OFF_, I_D) { const int f = (f_), kb = q / 32, nb = q % 32, layer = f >> 1, second = f & 1; \
        tr_item(args.in[(second ? 22 : 10) + 2] + (size_t)layer * FF * D, D, kb * 64, nb * 32, Wd + (size_t)f * D * FF + (size_t)(nb * 32) * FF, FF, nullptr, nullptr, 0.5f, TR_SCR, lane_c); }
#define CV_IN(OFF_) CV_FOR(q, OFF_, I_IN) { const int kb = q / 32, nb = q % 32; tr_item(args.in[14], D, kb * 64, nb * 32, Win + (size_t)(nb * 32) * D, D, args.in[13], nullptr, 1.0f, TR_SCR, lane_c); }
#define CV_GRP(OFF_) CV_FOR(q2, OFF_, 4 * I_GRP) { const int gq = q2 / I_GRP, q = q2 % I_GRP, kb = q / 8, nb = q % 8; \
        tr_item(args.in[15] + (size_t)gq * 256 * 256, 256, kb * 64, nb * 32, Wgrp + (size_t)(gq * 256 + nb * 32) * 256, 256, nullptr, args.in[16] + gq * 256, 1.0f, TR_SCR, lane_c); }
#define CV_PO(OFF_) CV_FOR(q, OFF_, I_IN) { const int kb = q / 32, nb = q % 32; tr_item(args.in[17], D, kb * 64, nb * 32, Wpo + (size_t)(nb * 32) * D, D, nullptr, nullptr, 1.0f, TR_SCR, lane_c); }
#define CV_QKV(OFF_) CV_FOR(q, OFF_, I_QKV) { const int kb = q / 144, nb = q % 144, n0 = nb * 32; const float fs = ((n0 % 1536) < 512) ? 0.125f * 1.4426950408889634f : 1.0f; \
        const int gg = n0 / 1536, ss = (n0 % 1536) / 512, he = n0 % 512; const int drow = ss < 2 ? gg * 1024 + ss * 512 + he : 3072 + gg * 512 + he; \
        tr_item(args.in[18], QKVW, kb * 64, n0, Wqkv + (size_t)drow * D, D, args.in[13] + D, nullptr, fs, TR_SCR, lane_c); }
#define CV_AO(OFF_) CV_FOR(q, OFF_, I_AO) { const int kb = q / 32, nb = q % 32; tr_item(args.in[19], D, kb * 64, nb * 32, Wao + (size_t)(nb * 32) * 512, 512, nullptr, nullptr, 1.0f, TR_SCR, lane_c); }
#define WC(c) (ctl + (size_t)NPHC * 72 * 64 + (size_t)(c) * 64)
#define CONV_POINT(c, BODY) do { int lane_c = threadIdx.x; asm volatile("" : "+v"(lane_c)); lane_c &= 63; BODY VM_WAIT(); if (lane_c == 0) __hip_atomic_fetch_add(WC(c), 1u, RLX_AGENT); __syncthreads(); } while (0)
    ON(0) {
        LAS float* scr = (LAS float*)(lds + wave * 16384);
        { const int lane_c = lane; CV_GU(0, 0) CV_D(0, 768) }
        for (int row = gw; row < MP; row += NGW) {
            f32x4 v[4]; float s = 0.f;
            if (row < MV) { const f32x4* xr = (const f32x4*)(row < S ? x_prompt + (size_t)row * D : x_sample + (size_t)(row - S) * D) + lane;
#pragma unroll
                for (int j = 0; j < 4; ++j) { v[j] = __builtin_nontemporal_load(xr + 64 * j); s += (v[j].x * v[j].x + v[j].y * v[j].y) + (v[j].z * v[j].z + v[j].w * v[j].w); } }
            else {
#pragma unroll
                for (int j = 0; j < 4; ++j) v[j] = (f32x4){0.f, 0.f, 0.f, 0.f}; }
            s = wave_sum(s);
            u32x2* o8 = (u32x2*)(xb + (size_t)row * D) + lane;
#pragma unroll
            for (int j = 0; j < 4; ++j) { u32x2 w; w.x = pk2(v[j].x, v[j].y); w.y = pk2(v[j].z, v[j].w); o8[64 * j] = w; }
            if (lane < 4) part[(size_t)row * 4 + lane] = (lane == 0) ? s : 0.f;
        }
        for (size_t i = gt; i < 3 * 8 * 132; i += NGT) { const int j = (int)(i % 132), gh = (int)(i / 132), g = gh / 8, h = gh % 8;
            biasT[i] = (j <= 128) ? 1.4426950408889634f * args.in[20][t5_bucket(j * (1 << (2 * g))) * 24 + g * 8 + h] : 0.f; }
        for (size_t i = gt; i < (size_t)NS * 14 * (D / 4); i += NGT) { const size_t b = i / (14 * (D / 4)), rem = i % (14 * (D / 4));
            ((f32x4*)(out + O_PSS + b * 15 * D))[rem] = ((const f32x4*)(state_pool + b * 15 * D + D))[rem]; }
        for (size_t i = gt; i < QOFF + QWORDS; i += NGT) ctl[i] = 0u;
        for (size_t i = gt; i < (size_t)(MP - MV) * 64; i += NGT) ((u32x4*)(ob + (size_t)MV * 512))[i] = (u32x4){0u, 0u, 0u, 0u};
    }
    grid.sync();

    const int xcd = bx % 8;
    unsigned* qbase = ctl + QOFF; int qi = 0; int sk_id = 0; LAS unsigned* qslot = (LAS unsigned*)(lds + 131072 + 4096);
    CopyJob cjob{args.in, out, bx};
    const rsrc_t rs_act = mkrs(act, (size_t)MP * FF * 2), rs_xb = mkrs(xb, (size_t)MP * D * 2), rs_part = mkrs(part, (size_t)MP * 16);
    LAS float* red = (LAS float*)(lds + 131072);
    const unsigned* wdep_next = nullptr;
#define FLOW_GEMM(EPI_T, EPI_INIT, Aptr, LDA_, Bptr, LDB_, K_, NM_, NN_, APN_, BSIG_, DEP_, NEED_, DEPPN_, DEPSH_, PUB_, PUBPN_) do { \
        pg8::Gemm g{(const bf16_t*)(Aptr), (const bf16_t*)(Bptr), (LDA_), (LDB_), (K_), (APN_), (BSIG_)}; pg8::FlowOrder So; So.init((NM_), (NN_), 2, xcd, qbase, qi, qslot); \
        So.dep = (DEP_); So.need = (NEED_); So.need64 = (NEED_); So.dep_pn = (DEPPN_); So.dep_shift = (DEPSH_); So.pub = (PUB_); So.pub_pn = (PUBPN_); So.wdep = wdep_next; So.wneed = (unsigned)NGW; wdep_next = nullptr; \
        EPI_T E EPI_INIT; pg8::gemm_phase<EPI_T, pg8::FlowOrder>(lds, g, So, E); } while (0)
#define SKINNY(EPI_T, EPI_INIT, Aptr, LDA_, Bptr, LDB_, K_, NN_, APN_, DEP_, NEED_, PUB_) do { \
        const pg8::Gemm g{(const bf16_t*)(Aptr), (const bf16_t*)(Bptr), (LDA_), (LDB_), (K_), (APN_), 1}; \
        ++sk_id; \
        for (int j = 0; j < (NN_); ++j) if ((sk_id * 29 + j * 13 + 7) % G == bx) {        \
            EPI_T E EPI_INIT; const unsigned* dp = (DEP_); \
            if (dp) { if (tid < 64) { flow_poll1(dp + (size_t)64 * 64, (NEED_)); __builtin_amdgcn_fence(__ATOMIC_ACQUIRE, "agent"); VM_WAIT(); } } \
            __syncthreads(); skinny_unit<EPI_T>(lds, g, j, E); flow_publish((PUB_) + (size_t)64 * 64); __syncthreads(); } \
        } while (0)
#define SKINNY_Q(EPI_T, EPI_INIT, Aptr, LDA_, Bptr, LDB_, K_, NN_, APN_, DEP_, NEED_, PUB_) do { \
        const pg8::Gemm g{(const bf16_t*)(Aptr), (const bf16_t*)(Bptr), (LDA_), (LDB_), (K_), (APN_), 1}; pg8::FlowOrder So; So.init(1, (NN_), 1, xcd, qbase, qi, qslot); \
        EPI_T E EPI_INIT; Unit u; \
        while (So.next_blocking(u)) { const unsigned* dp = (DEP_); \
            if (dp) { if (tid < 64) { flow_poll1(dp + (size_t)64 * 64, (NEED_)); __builtin_amdgcn_fence(__ATOMIC_ACQUIRE, "agent"); VM_WAIT(); } } \
            __syncthreads(); skinny_unit<EPI_T>(lds, g, u.pn, E); flow_publish((PUB_) + (size_t)64 * 64); } \
        __syncthreads(); } while (0)
#define GU_PHASE(f, DEP_, PH_) do { FLOW_GEMM(EpiGU, ({{}, rs_act, part, &cjob}), xb, D, Wgu + (size_t)(f) * 2 * FF * D, D, D, 64, 22, 0, 1, DEP_, 32u, 0, 0, CNT(PH_), 0); \
        SKINNY(EpiGU, ({{}, rs_act, part, &cjob}), xb, D, Wgu + (size_t)(f) * 2 * FF * D, D, D, 22, 0, DEP_, 32u, CNT(PH_)); } while (0)
#define DN_PHASE(LAST_, RSXO_, f, DEP_, PH_) do { FLOW_GEMM(EpiRes<LAST_>, ({{}, xb, RSXO_, rs_xb, rs_part, red}), act, FF, Wd + (size_t)(f) * D * FF, FF, FF, 64, 4, 0, 1, DEP_, 176u, 0, 0, CNT(PH_), 0); \
        SKINNY(EpiRes<LAST_>, ({{}, xb, RSXO_, rs_xb, rs_part, red}), act, FF, Wd + (size_t)(f) * D * FF, FF, FF, 4, 0, DEP_, 176u, CNT(PH_)); } while (0)

#ifndef PM
#define PM 0xffffff
#endif
    ON(1) GU_PHASE(0, nullptr, PH_GU0);
    CONV_POINT(1, CV_IN(0) CV_GRP(512) CV_PO(640));
    ON(2) DN_PHASE(false, rs_xb, 0, CNT(PH_GU0), PH_D0);
    CONV_POINT(2, CV_GU(1, 0));
    wdep_next = WC(1);
    ON(3) { FLOW_GEMM(EpiU, ({{}, mkrs(ub, (size_t)MP * D * 2), part, out + O_PSP, out + O_PSS}), xb, D, Win, D, D, 64, 4, 0, 1, CNT(PH_D0), 32u, 0, 0, CNT(PH_WIN), 0);
            SKINNY(EpiU, ({{}, mkrs(ub, (size_t)MP * D * 2), part, out + O_PSP, out + O_PSS}), xb, D, Win, D, D, 4, 0, CNT(PH_D0), 32u, CNT(PH_WIN)); }
    ON(4)
    for (int sm = 0; sm < 2; ++sm) {
        pg8::FlowOrder So; So.init(sm ? 1 : 64, 4, sm ? 1 : 2, xcd, qbase, qi, qslot);
        const rsrc_t rs_z = mkrs(zb, (size_t)MP * D * 2);
        Unit u;
        while (So.next_blocking(u)) {
            const int pm = sm ? 64 : u.pm;
            if (tid < 64) { flow_poll1(CNT(PH_WIN) + (size_t)pm * 64, 32u); if (pm > 0 && pm < 64) flow_poll1(CNT(PH_WIN) + (size_t)(pm - 1) * 64, 32u);
                __builtin_amdgcn_fence(__ATOMIC_ACQUIRE, "agent"); VM_WAIT(); }
            __syncthreads();
            {
                const int chunk = tid & 31, strip = tid >> 5, ch = u.pn * 256 + chunk * 8, r0 = pm * 256 + strip * 16;
                if (u.pn == 0) pool_strip<2>(ub, state_pool, rs_z, r0, ch);
                else if (u.pn == 1) pool_strip<4>(ub, state_pool, rs_z, r0, ch);
                else if (u.pn == 2) pool_strip<8>(ub, state_pool, rs_z, r0, ch);
                else pool_strip<16>(ub, state_pool, rs_z, r0, ch);
            }
            flow_publish(CNT(PH_POOL) + (size_t)pm * 64);
        }
    }
    CONV_POINT(3, CV_D(1, 0));
    wdep_next = WC(1);
    ON(5) { FLOW_GEMM(EpiPlain, ({{}, mkrs(z2b, (size_t)MP * D * 2)}), zb, D, Wgrp, 256, 256, 64, 4, 256, 1, CNT(PH_POOL), 32u, 0, 0, CNT(PH_GRP), 0);
            SKINNY(EpiPlain, ({{}, mkrs(z2b, (size_t)MP * D * 2)}), zb, D, Wgrp, 256, 256, 4, 256, CNT(PH_POOL), 32u, CNT(PH_GRP)); }
    wdep_next = WC(1);
    ON(6) { FLOW_GEMM(EpiRes<false>, ({{}, xb, rs_xb, rs_xb, rs_part, red}), z2b, D, Wpo, D, D, 64, 4, 0, 1, CNT(PH_GRP), 32u, 0, 0, CNT(PH_WPO), 0);
            SKINNY(EpiRes<false>, ({{}, xb, rs_xb, rs_xb, rs_part, red}), z2b, D, Wpo, D, D, 4, 0, CNT(PH_GRP), 32u, CNT(PH_WPO)); }
    CONV_POINT(4, CV_GU(2, 0));
    wdep_next = WC(2);
    ON(7) GU_PHASE(1, CNT(PH_WPO), PH_GU1);
    CONV_POINT(5, CV_D(2, 0));
    wdep_next = WC(3);
    ON(8) DN_PHASE(false, rs_xb, 1, CNT(PH_GU1), PH_D1);
    CONV_POINT(6, CV_QKV(0));
    wdep_next = WC(4);
    ON(9) GU_PHASE(2, CNT(PH_D1), PH_GU2);
    CONV_POINT(7, CV_AO(0) CV_GU(3, 256));
    wdep_next = WC(5);
    ON(10) DN_PHASE(false, rs_xb, 2, CNT(PH_GU2), PH_D2);
    CONV_POINT(8, CV_D(3, 0));
    wdep_next = WC(6);
    ON(11) { FLOW_GEMM(EpiQK, ({{}, mkrs(qk, (size_t)MP * 3072 * 2), part, out, mkrs(vnew, (size_t)NS * 1536 * 2)}), xb, D, Wqkv, D, D, 64, 12, 0, 1, CNT(PH_D2), 32u, 0, 0, CNT(PH_QKV), 0);
             SKINNY(EpiQK, ({{}, mkrs(qk, (size_t)MP * 3072 * 2), part, out, mkrs(vnew, (size_t)NS * 1536 * 2)}), xb, D, Wqkv, D, D, 18, 0, CNT(PH_D2), 32u, CNT(PH_QKV)); }
    ON(12)
#pragma unroll
    for (int gi = 0; gi < 3; ++gi)
        FLOW_GEMM(EpiVT, ({mkrs(vT + (size_t)gi * 512 * MPV, (size_t)512 * MPV * 2), part, out, gi, 1 << (2 * gi)}), Wqkv + (size_t)(3072 + gi * 512) * D, D, xb, D, D, 2, 64, 0, 1 << (2 * gi), CNT(PH_D2), 32u, 1, 0, CNT(PH_QKV), 1);
    ON(13) {
        LAS float* biasL = (LAS float*)(lds + 131072);
        LAS float* smp = (LAS float*)(lds + 131072 + 2048);
        const rsrc_t rs_o = mkrs(ob, (size_t)MP * 512 * 2);
#define STAGE_G0(k_) do { const int key0 = 512 * sp + 256 * (k_) - 128; \
            _Pragma("unroll") for (int j = 0; j < 6; ++j) { const int p = (wave * 6 + j) * 1024 + lane * 16; \
                { const int key = p >> 7, c = ((p >> 4) & 7) ^ ((key >> 1) & 7); int tok = key0 + key; tok = tok < 0 ? 0 : tok; \
                  __builtin_amdgcn_global_load_lds((const unsigned*)(qk + (size_t)tok * 3072 + 512 + h * 64 + c * 8), (LAS unsigned*)(lds + (wave * 6 + j) * 1024), 16, 0, 0); } \
                { const int dim = p / 768, c = ((p % 768) >> 4) ^ (dim & 15); \
                  __builtin_amdgcn_global_load_lds((const unsigned*)(vT + (size_t)(h * 64 + dim) * MPV + 128 + key0 + c * 8), (LAS unsigned*)(lds + 49152 + (wave * 6 + j) * 1024), 16, 0, 0); } } } while (0)
        pg8::FlowOrder So; So.init(32, 8, 1, xcd, qbase, qi, qslot);
        Unit u;
        while (So.next_blocking(u)) {
            const int sp = u.pm, h = u.pn;
            if (tid < 64) { const int p0 = 2 * sp - 8 < 0 ? 0 : 2 * sp - 8, idx = p0 + lane; unsigned spn = 0;
                for (;;) { const unsigned v = (idx <= 2 * sp + 1) ? __hip_atomic_load(CNT(PH_QKV) + (size_t)idx * 64, RLX_AGENT) : 144u;
                    if (__all(v >= 144u)) break; __builtin_amdgcn_s_sleep(2); if (++spn > FLOW_SPIN_CAP) break; }
                            __builtin_amdgcn_fence(__ATOMIC_ACQUIRE, "agent"); VM_WAIT(); }
            __syncthreads();
            for (int j = tid; j < 3 * 132; j += NTHR) biasL[j] = biasT[((j / 132) * 8 + h) * 132 + (j % 132)];
            __syncthreads();
            STAGE_G0(0);
#pragma nounroll
            for (int k = 0; k < 2; ++k) attn_job<2>(qk, vT + (size_t)2 * 512 * MPV, biasL + 2 * 132, act, rs_o, h, wave + 8 * k, 32 * sp, lane);
#pragma nounroll
            for (int k = 0; k < 2; ++k) attn_job<1>(qk, vT + (size_t)1 * 512 * MPV, biasL + 1 * 132, act, rs_o, h, wave & 3, 128 * sp + 32 * ((wave >> 2) + 2 * k), lane);
            __syncthreads();
#pragma nounroll
            for (int k = 0; k < 2; ++k) {
                if (k) { __syncthreads(); STAGE_G0(1); }
                VM_WAIT(); __syncthreads();
                attn_job<0>(qk, vT, biasL, act, rs_o, h, 0, 512 * sp + 32 * (wave + 8 * k), lane, lds, lds + 49152, 32 * wave);
            }
            flow_publish(CNT(PH_ATT) + (size_t)sp * 64);
        }
        pg8::FlowOrder Ss; Ss.init(NS, 8, 1, xcd, qbase, qi, qslot);
        while (Ss.next_blocking(u)) {
            const int b = u.pm, h = u.pn;
            if (tid < 64) { flow_poll1(CNT(PH_QKV) + (size_t)64 * 64, 144u); __builtin_amdgcn_fence(__ATOMIC_ACQUIRE, "agent"); VM_WAIT(); }
            __syncthreads();
            if (wave < 3) sample_attn_group(wave, b, h, qk, vnew, args.in[3 + 2 * wave], args.in[4 + 2 * wave], biasT, smp, lane);
            __syncthreads();
            if (wave == 0 && lane < 32) { const float l0 = smp[64], l1 = smp[72 + 64], l2 = smp[144 + 64], mm = fmaxf(fmaxf(l0, l1), l2);
                const float w0 = __builtin_amdgcn_exp2f(l0 - mm), w1 = __builtin_amdgcn_exp2f(l1 - mm), w2 = __builtin_amdgcn_exp2f(l2 - mm), iw = 1.0f / (w0 + w1 + w2);
                const float r0 = (w0 * smp[2 * lane] + w1 * smp[72 + 2 * lane] + w2 * smp[144 + 2 * lane]) * iw, r1 = (w0 * smp[2 * lane + 1] + w1 * smp[72 + 2 * lane + 1] + w2 * smp[144 + 2 * lane + 1]) * iw;
                ST4(rs_o, ((unsigned)(S + b) * 512 + h * 64 + 2 * lane) * 2u, pk2(r0, r1)); }
            flow_publish(CNT(PH_ATT) + (size_t)32 * 64);
        }
        __syncthreads();
    }
    wdep_next = WC(7);
    ON(14) { FLOW_GEMM(EpiRes<false>, ({{}, xb, rs_xb, rs_xb, rs_part, red}), ob, 512, Wao, 512, 512, 64, 4, 0, 1, CNT(PH_ATT), 64u, 0, 1, CNT(PH_WAO), 0);
             SKINNY(EpiRes<false>, ({{}, xb, rs_xb, rs_xb, rs_part, red}), ob, 512, Wao, 512, 512, 4, 0, CNT(PH_ATT) - (size_t)32 * 64, (unsigned)(NS * 8 * 8), CNT(PH_WAO)); }
    wdep_next = WC(7);
    ON(15) { FLOW_GEMM(EpiGU, ({{}, rs_act, part, &cjob}), xb, D, Wgu + (size_t)3 * 2 * FF * D, D, D, 64, 22, 0, 1, CNT(PH_WAO), 32u, 0, 0, CNT(PH_GU3), 0);
             SKINNY_Q(EpiGU, ({{}, rs_act, part, &cjob}), xb, D, Wgu + (size_t)3 * 2 * FF * D, D, D, 22, 0, CNT(PH_WAO), 32u, CNT(PH_GU3)); }
    wdep_next = WC(8);
    ON(16) { FLOW_GEMM(EpiRes<false>, ({{}, xb, rs_xb, rs_xb, rs_part, red}), act, FF, Wd + (size_t)3 * D * FF, FF, FF, 64, 4, 0, 1, CNT(PH_GU3), 176u, 0, 0, CNT(PH_D3), 0);
             SKINNY_Q(EpiRes<false>, ({{}, xb, rs_xb, rs_xb, rs_part, red}), act, FF, Wd + (size_t)3 * D * FF, FF, FF, 4, 0, CNT(PH_GU3), 176u, CNT(PH_D3)); }
    ON(17) {
        pg8::FlowOrder So; So.init(NPANEL, 4, 1, xcd, qbase, qi, qslot);
        const float* gf = args.in[25]; Unit u;
        while (So.next_blocking(u)) {
            if (tid < 64) { flow_poll1(CNT(PH_D3) + (size_t)u.pm * 64, 32u); __builtin_amdgcn_fence(__ATOMIC_ACQUIRE, "agent"); VM_WAIT(); }
            __syncthreads();
            u32x2 xw[8][4]; float rsv[8];
#pragma unroll
            for (int k = 0; k < 8; ++k) { int row = u.pm * 256 + u.pn * 64 + wave + 8 * k; if (row >= MV) row = MV - 1;
                rsv[k] = rstd_of(part, row); const u32x2* xr = (const u32x2*)(xb + (size_t)row * D) + lane;
#pragma unroll
                for (int j = 0; j < 4; ++j) xw[k][j] = xr[64 * j]; }
            f32x4 gg[4];
#pragma unroll
            for (int j = 0; j < 4; ++j) gg[j] = ((const f32x4*)gf + lane)[64 * j];
#pragma unroll
            for (int k = 0; k < 8; ++k) { const int row = u.pm * 256 + u.pn * 64 + wave + 8 * k;
                if (row < MV) { f32x4* xr = (f32x4*)(out + (size_t)row * D) + lane;
#pragma unroll
                    for (int j = 0; j < 4; ++j) { const f32x4 xv = {bflo(xw[k][j].x), bfhi(xw[k][j].x), bflo(xw[k][j].y), bfhi(xw[k][j].y)}; __builtin_nontemporal_store(xv * rsv[k] * gg[j], xr + 64 * j); } } }
        }
    }
    for (int chunk = cjob.next; chunk < CP_CHUNKS; chunk += 256) {
#pragma unroll
        for (int q = 0; q < 4; ++q) { const f32x4* src; f32x4* dst; if (cp_addr(args.in, out, chunk * 32 + wave * 4 + q, lane, src, dst)) { const f32x4 a0 = __builtin_nontemporal_load(src), a1 = __builtin_nontemporal_load(src + 64); __builtin_nontemporal_store(a0, dst); __builtin_nontemporal_store(a1, dst + 64); } }
    }
}

extern "C" void kernel_launch(void* const* d_in, const int* in_sizes, int n_in, void* d_out, int out_size, void* d_ws, size_t ws_size, hipStream_t stream) {
    static int grid = 0;
    if (grid == 0) {
        if (n_in != 26 || (size_t)out_size != OUT_TOTAL || ws_size < WS_END) { fprintf(stderr, "kernel_launch: unexpected shapes: n_in %d out %d (want %zu) ws %zu (need %zu)\n", n_in, out_size, (size_t)OUT_TOTAL, ws_size, (size_t)WS_END); grid = -1; return; }
        int dev = 0, cus = 0, per_cu = 0;
        hipGetDevice(&dev); hipDeviceGetAttribute(&cus, hipDeviceAttributeMultiprocessorCount, dev);
        hipFuncSetAttribute((const void*)fwd_kernel, hipFuncAttributeMaxDynamicSharedMemorySize, LDS_BYTES);
        hipOccupancyMaxActiveBlocksPerMultiprocessor(&per_cu, (const void*)fwd_kernel, NTHR, LDS_BYTES);
        if (per_cu < 1) { fprintf(stderr, "kernel_launch: occupancy query says %d blocks per CU\n", per_cu); per_cu = 1; }
        grid = cus;
        (void)hipGetLastError();
    }
    if (grid < 0) return;
    Args a{};
    for (int i = 0; i < 26; ++i) a.in[i] = (const float*)d_in[i];
    a.out = (float*)d_out; a.ws = (unsigned char*)d_ws;
    void* kargs[] = {&a};
    hipError_t e = hipLaunchCooperativeKernel((const void*)fwd_kernel, dim3(grid), dim3(NTHR), kargs, LDS_BYTES, stream);
    if (e != hipSuccess) fprintf(stderr, "cooperative launch failed: %s (grid %d)\n", hipGetErrorString(e), grid);
}
```
